# Optimizing an MI355X kernel written in HIP

```python
import math
import jax, jax.numpy as jnp
from jax import lax
import numpy as np

D_MODEL = 1024
BATCH = 8
SEQ = 2048
DEPTH = 1

ATT_HEADS = 8
HEAD_DIM = 64
ATT_WIDTH = ATT_HEADS * HEAD_DIM
SSM_WIDTH = D_MODEL // 2
D_MIX = ATT_WIDTH + SSM_WIDTH
SSM_CH = 16
SSM_GROUPS = SSM_WIDTH // SSM_CH
SSM_STATE = 64
DT_MIN = 1e-3
DT_MAX = 1e-1
ROPE_THETA = 500000.0
ROT_DIM = HEAD_DIM // 4
DILATED_CONFIGS = ((128, 1), (512, 4), (2048, 16))
ATT_BLOCK = 128
N_EXPERTS = 256
TOP_K = 8
N_EXPERT_GROUPS = 8
TOPK_GROUPS = 4
EXPERT_FF = D_MODEL // 4
SHARED_FF = EXPERT_FF
ROUTED_SCALE = 2.5
MOE_BLOCK = 128
DEEPNORM_ALPHA = (2 * DEPTH) ** 0.25
DEEPNORM_BETA = (8 * DEPTH) ** -0.25
LN_EPS = 1e-5
RMS_EPS = 1e-6

kernel_name = 'hybrid_dilated_attn_s5_moe_deepnorm'


def layer_norm(x, g, b):
    xf = x.astype(jnp.float32)
    mu = xf.mean(-1, keepdims=True)
    var = jnp.square(xf - mu).mean(-1, keepdims=True)
    return ((xf - mu) * lax.rsqrt(var + LN_EPS) * g.astype(jnp.float32) + b.astype(jnp.float32)).astype(x.dtype)


def rms_norm(x, g):
    xf = x.astype(jnp.float32)
    return (xf * lax.rsqrt(jnp.square(xf).mean(-1, keepdims=True) + RMS_EPS) * g.astype(jnp.float32)).astype(x.dtype)


def rope_tables(seq_len):
    half = ROT_DIM // 2
    inv_freq = jnp.power(jnp.float32(ROPE_THETA), -jnp.arange(half, dtype=jnp.float32) / half)
    ang = jnp.arange(seq_len, dtype=jnp.float32)[:, None] * inv_freq[None, :]
    return jnp.cos(ang), jnp.sin(ang)


def partial_rope(t, cos, sin):
    half = ROT_DIM // 2
    tf = t.astype(jnp.float32)
    c = cos[None, :, None, :]
    s = sin[None, :, None, :]
    x1 = tf[..., :half]
    x2 = tf[..., half:ROT_DIM]
    out = jnp.concatenate([x1 * c - x2 * s, x2 * c + x1 * s, tf[..., ROT_DIM:]], axis=-1)
    return out.astype(t.dtype)


def dilated_branch(q, k, v, window, dilation):
    bsz, seq, heads, hd = q.shape
    w_sub = window // dilation
    n_sub = seq // dilation
    nb = -(-n_sub // ATT_BLOCK)
    pad = nb * ATT_BLOCK - n_sub

    def blocks(t):
        t = t.reshape(bsz, n_sub, dilation, heads, hd).transpose(0, 2, 3, 1, 4)
        t = jnp.pad(t, ((0, 0), (0, 0), (0, 0), (0, pad), (0, 0)))
        return t.reshape(bsz, dilation, heads, nb, ATT_BLOCK, hd)

    def with_prev(t):
        prev = jnp.pad(t, ((0, 0), (0, 0), (0, 0), (1, 0), (0, 0), (0, 0)))[:, :, :, :-1]
        return jnp.concatenate([prev, t], axis=4)

    qb = blocks(q)
    kk = with_prev(blocks(k))
    vv = with_prev(blocks(v))
    s = jnp.einsum('bdhnqe,bdhnke->bdhnqk', qb, kk, preferred_element_type=jnp.float32) * (hd ** -0.5)
    i = jnp.arange(ATT_BLOCK)[:, None]
    j = jnp.arange(2 * ATT_BLOCK)[None, :]
    dist = i + ATT_BLOCK - j
    band = (dist >= 0) & (dist <= w_sub)
    has_prev = (jnp.arange(nb) > 0)[:, None, None] | (j >= ATT_BLOCK)[None]
    valid = band[None] & has_prev
    s = jnp.where(valid, s, -jnp.inf)
    m = s.max(-1, keepdims=True)
    p = jnp.exp(s - m)
    den = p.sum(-1, keepdims=True)
    o = jnp.einsum('bdhnqk,bdhnke->bdhnqe', p, vv.astype(jnp.float32)) / den
    lse = (m + jnp.log(den))[..., 0]
    o = o.reshape(bsz, dilation, heads, nb * ATT_BLOCK, hd)[:, :, :, :n_sub]
    o = o.transpose(0, 3, 1, 2, 4).reshape(bsz, seq, heads, hd)
    lse = lse.reshape(bsz, dilation, heads, nb * ATT_BLOCK)[..., :n_sub]
    lse = lse.transpose(0, 3, 1, 2).reshape(bsz, seq, heads)
    return o, lse


def dilated_attention(q, k, v):
    outs = []
    lses = []
    for window, dilation in DILATED_CONFIGS:
        o, lse = dilated_branch(q, k, v, window, dilation)
        outs.append(o)
        lses.append(lse)
    w = jax.nn.softmax(jnp.stack(lses), axis=0)
    o = jnp.einsum('cblh,cblhe->blhe', w, jnp.stack(outs))
    return o.astype(q.dtype)


def s5_mixer(u, lam_re, lam_im, log_step, b_re, b_im, c_re, c_im, d_skip, w_glu, b_glu):
    bsz, seq, _ = u.shape
    f32 = jnp.float32
    uf = u.astype(f32).reshape(bsz, seq, SSM_GROUPS, SSM_CH)
    lam = lax.complex(lam_re.astype(f32), lam_im.astype(f32))
    step = jnp.exp(log_step.astype(f32))[:, None]
    lam_bar = jnp.exp(lam * step)
    bmat = lax.complex(b_re.astype(f32), b_im.astype(f32))
    b_bar = ((lam_bar - 1.0) / lam)[..., None] * bmat
    bu = jnp.einsum('gpc,blgc->blgp', b_bar, uf.astype(jnp.complex64))
    a = jnp.broadcast_to(lam_bar, bu.shape)

    def combine(left, right):
        a1, b1 = left
        a2, b2 = right
        return a1 * a2, a2 * b1 + b2

    _, states = lax.associative_scan(combine, (a, bu), axis=1)
    cmat = lax.complex(c_re.astype(f32), c_im.astype(f32))
    y = jnp.einsum('gcp,blgp->blgc', cmat, states).real + d_skip.astype(f32) * uf
    y = jax.nn.gelu(y.reshape(bsz, seq, SSM_WIDTH)).astype(u.dtype)
    return y * jax.nn.sigmoid(y @ w_glu + b_glu)


def hybrid_mixer(h, cos, sin, w_in, att_norm_g, lam_re, lam_im, log_step, b_re, b_im, c_re, c_im,
                 d_skip, w_glu, b_glu, ssm_norm_g, w_out):
    bsz, seq, _ = h.shape
    proj = h @ w_in
    q, k, v, u = jnp.split(proj, [ATT_WIDTH, 2 * ATT_WIDTH, 3 * ATT_WIDTH], axis=-1)
    q = partial_rope(q.reshape(bsz, seq, ATT_HEADS, HEAD_DIM), cos, sin)
    k = partial_rope(k.reshape(bsz, seq, ATT_HEADS, HEAD_DIM), cos, sin)
    v = v.reshape(bsz, seq, ATT_HEADS, HEAD_DIM)
    o_att = dilated_attention(q, k, v).reshape(bsz, seq, ATT_WIDTH)
    o_ssm = s5_mixer(u, lam_re, lam_im, log_step, b_re, b_im, c_re, c_im, d_skip, w_glu, b_glu)
    y = jnp.concatenate([rms_norm(o_att, att_norm_g), rms_norm(o_ssm, ssm_norm_g)], axis=-1)
    return y @ w_out


def routed_experts(h, top_e, gate, w_gu, w_down):
    n_tok, d = h.shape
    nk = n_tok * TOP_K
    flat_e = top_e.reshape(-1).astype(jnp.int32)
    flat_tok = jnp.repeat(jnp.arange(n_tok, dtype=jnp.int32), TOP_K)
    flat_w = gate.reshape(-1)
    order = jnp.argsort(flat_e)
    e_s = flat_e[order]
    tok_s = flat_tok[order]
    w_s = flat_w[order]
    counts = jnp.bincount(flat_e, length=N_EXPERTS).astype(jnp.int32)
    start = jnp.cumsum(counts) - counts
    padded = (counts + MOE_BLOCK - 1) // MOE_BLOCK * MOE_BLOCK
    pad_end = jnp.cumsum(padded)
    pad_start = pad_end - padded
    dest = pad_start[e_s] + (jnp.arange(nk, dtype=jnp.int32) - start[e_s])
    total = -(-(nk + N_EXPERTS * MOE_BLOCK) // MOE_BLOCK) * MOE_BLOCK
    n_blocks = total // MOE_BLOCK
    tok_buf = jnp.full((total,), n_tok, jnp.int32).at[dest].set(tok_s)
    w_buf = jnp.zeros((total,), h.dtype).at[dest].set(w_s)
    block_e = jnp.minimum(jnp.searchsorted(pad_end, jnp.arange(n_blocks, dtype=jnp.int32) * MOE_BLOCK, side='right'),
                          N_EXPERTS - 1).astype(jnp.int32)
    h_pad = jnp.concatenate([h, jnp.zeros((1, d), h.dtype)], axis=0)

    def one_block(args):
        tok, wgt, e = args
        xb = h_pad[tok]
        g, up = jnp.split(xb @ w_gu[e], 2, axis=-1)
        return ((jax.nn.silu(g) * up) @ w_down[e]) * wgt[:, None]

    y = lax.map(one_block, (tok_buf.reshape(n_blocks, MOE_BLOCK), w_buf.reshape(n_blocks, MOE_BLOCK), block_e))
    y = y.reshape(total, d)
    return jax.ops.segment_sum(y, tok_buf, num_segments=n_tok + 1)[:n_tok]


def moe_ffn(h, router_w, router_bias, w_gu, w_down, shared_w_gu, shared_w_down):
    n_tok = h.shape[0]
    scores = jax.nn.sigmoid(h.astype(jnp.float32) @ router_w.astype(jnp.float32))
    choice = scores + router_bias.astype(jnp.float32)
    grp_score = lax.top_k(choice.reshape(n_tok, N_EXPERT_GROUPS, -1), 2)[0].sum(-1)
    _, top_grp = lax.top_k(grp_score, TOPK_GROUPS)
    grp_mask = jnp.any(top_grp[..., None] == jnp.arange(N_EXPERT_GROUPS)[None, None, :], axis=1)
    masked = jnp.where(jnp.repeat(grp_mask, N_EXPERTS // N_EXPERT_GROUPS, axis=-1), choice, -jnp.inf)
    _, top_e = lax.top_k(masked, TOP_K)
    gate = jnp.take_along_axis(scores, top_e, axis=-1)
    gate = ROUTED_SCALE * gate / (gate.sum(-1, keepdims=True) + 1e-20)
    routed = routed_experts(h, top_e, gate.astype(h.dtype), w_gu, w_down)
    g, up = jnp.split(h @ shared_w_gu, 2, axis=-1)
    shared = (jax.nn.silu(g) * up) @ shared_w_down
    return routed + shared


def setup_inputs(seed: int = 0) -> dict:
    key = jax.random.key(seed)
    ks = jax.random.split(key, 24)
    f32 = jnp.float32

    def nrm(k, shape, scale):
        return scale * jax.random.normal(k, shape, f32)

    G, P, CH = SSM_GROUPS, SSM_STATE, SSM_CH
    x = jax.random.normal(ks[0], (BATCH, SEQ, D_MODEL), f32)
    w_in = nrm(ks[1], (DEPTH, D_MODEL, 3 * ATT_WIDTH + SSM_WIDTH), D_MODEL ** -0.5)
    att_norm_g = 1.0 + nrm(ks[2], (DEPTH, ATT_WIDTH), 0.02)
    lam_re = -0.5 * jnp.exp(nrm(ks[3], (DEPTH, G, P), 0.02))
    lam_im = jnp.broadcast_to(math.pi * jnp.arange(P, dtype=f32), (DEPTH, G, P))
    log_step = jax.random.uniform(ks[4], (DEPTH, G), f32, math.log(DT_MIN), math.log(DT_MAX))
    b_re = nrm(ks[5], (DEPTH, G, P, CH), (2 * CH) ** -0.5)
    b_im = nrm(ks[6], (DEPTH, G, P, CH), (2 * CH) ** -0.5)
    c_re = nrm(ks[7], (DEPTH, G, CH, P), 0.5)
    c_im = nrm(ks[8], (DEPTH, G, CH, P), 0.5)
    d_skip = nrm(ks[9], (DEPTH, G, CH), 1.0)
    w_glu = nrm(ks[10], (DEPTH, SSM_WIDTH, SSM_WIDTH), SSM_WIDTH ** -0.5)
    b_glu = nrm(ks[11], (DEPTH, SSM_WIDTH), 0.02)
    ssm_norm_g = 1.0 + nrm(ks[12], (DEPTH, SSM_WIDTH), 0.02)
    w_out = nrm(ks[13], (DEPTH, D_MIX, D_MODEL), DEEPNORM_BETA * D_MIX ** -0.5)
    ln1_g = 1.0 + nrm(ks[14], (DEPTH, D_MODEL), 0.02)
    ln1_b = nrm(ks[15], (DEPTH, D_MODEL), 0.02)
    router_w = nrm(ks[16], (DEPTH, D_MODEL, N_EXPERTS), D_MODEL ** -0.5)
    router_bias = nrm(ks[17], (DEPTH, N_EXPERTS), 0.01)
    w_gu = nrm(ks[18], (DEPTH, N_EXPERTS, D_MODEL, 2 * EXPERT_FF), D_MODEL ** -0.5)
    w_down = nrm(ks[19], (DEPTH, N_EXPERTS, EXPERT_FF, D_MODEL), DEEPNORM_BETA * EXPERT_FF ** -0.5)
    shared_w_gu = nrm(ks[20], (DEPTH, D_MODEL, 2 * SHARED_FF), D_MODEL ** -0.5)
    shared_w_down = nrm(ks[21], (DEPTH, SHARED_FF, D_MODEL), DEEPNORM_BETA * SHARED_FF ** -0.5)
    ln2_g = 1.0 + nrm(ks[22], (DEPTH, D_MODEL), 0.02)
    ln2_b = nrm(ks[23], (DEPTH, D_MODEL), 0.02)
    return {'x': x, 'w_in': w_in, 'att_norm_g': att_norm_g, 'lam_re': lam_re, 'lam_im': lam_im,
            'log_step': log_step, 'b_re': b_re, 'b_im': b_im, 'c_re': c_re, 'c_im': c_im, 'd_skip': d_skip,
            'w_glu': w_glu, 'b_glu': b_glu, 'ssm_norm_g': ssm_norm_g, 'w_out': w_out, 'ln1_g': ln1_g,
            'ln1_b': ln1_b, 'router_w': router_w, 'router_bias': router_bias, 'w_gu': w_gu, 'w_down': w_down,
            'shared_w_gu': shared_w_gu, 'shared_w_down': shared_w_down, 'ln2_g': ln2_g, 'ln2_b': ln2_b}


def reference(x, w_in, att_norm_g, lam_re, lam_im, log_step, b_re, b_im, c_re, c_im, d_skip, w_glu, b_glu,
              ssm_norm_g, w_out, ln1_g, ln1_b, router_w, router_bias, w_gu, w_down, shared_w_gu,
              shared_w_down, ln2_g, ln2_b):
    bsz, seq, d = x.shape
    cos, sin = rope_tables(seq)
    h = x
    for i in range(DEPTH):
        mix = hybrid_mixer(h, cos, sin, w_in[i], att_norm_g[i], lam_re[i], lam_im[i], log_step[i], b_re[i],
                           b_im[i], c_re[i], c_im[i], d_skip[i], w_glu[i], b_glu[i], ssm_norm_g[i], w_out[i])
        h = layer_norm(DEEPNORM_ALPHA * h + mix, ln1_g[i], ln1_b[i])
        ffn = moe_ffn(h.reshape(bsz * seq, d), router_w[i], router_bias[i], w_gu[i], w_down[i],
                      shared_w_gu[i], shared_w_down[i]).reshape(bsz, seq, d)
        h = layer_norm(DEEPNORM_ALPHA * h + ffn, ln2_g[i], ln2_b[i])
    return h
```

```cpp
#include <hip/hip_runtime.h>
#include <stdint.h>

namespace {
constexpr int B_ = 8, L_ = 2048, D_ = 1024, NT = B_ * L_;
constexpr int NH = 8, HD = 64, NPROJ = 2048;
constexpr int SG = 32, SC = 16, SP = 64;
constexpr int NE = 256, TOPK = 8, EFF = 256;
constexpr int CAP = 16384;
constexpr float ALPHA = 1.189207115002721f;

template <class F>
__global__ __launch_bounds__(256) void k_gemm(F f, int N, int K) {
    const int z = blockIdx.z;
    const int M = f.M(z);
    const int m0 = blockIdx.y * 64, n0 = blockIdx.x * 64;
    if (m0 >= M) return;
    __shared__ float As[16][68];
    __shared__ float Bs[16][68];
    const int tid = threadIdx.x;
    const int tx = tid & 15, ty = tid >> 4;
    const int ar = tid >> 2, aq = (tid & 3) * 4;
    const bool arow_ok = (m0 + ar) < M;
    const float* ap = f.arow(z, arow_ok ? (m0 + ar) : m0);
    const int bk = tid >> 4, bq = (tid & 15) * 4;
    const float* bp = f.B(z) + (size_t)bk * N + n0 + bq;
    float acc[4][4];
#pragma unroll
    for (int i = 0; i < 4; ++i)
#pragma unroll
        for (int j = 0; j < 4; ++j) acc[i][j] = 0.f;
    for (int k0 = 0; k0 < K; k0 += 16) {
        float4 av = *(const float4*)(ap + k0 + aq);
        if (!arow_ok) av = make_float4(0.f, 0.f, 0.f, 0.f);
        const float4 bv = *(const float4*)(bp + (size_t)k0 * N);
        __syncthreads();
        As[aq + 0][ar] = av.x; As[aq + 1][ar] = av.y; As[aq + 2][ar] = av.z; As[aq + 3][ar] = av.w;
        *(float4*)&Bs[bk][bq] = bv;
        __syncthreads();
#pragma unroll
        for (int kk = 0; kk < 16; ++kk) {
            const float4 a4 = *(const float4*)&As[kk][ty * 4];
            const float4 b4 = *(const float4*)&Bs[kk][tx * 4];
            const float a[4] = {a4.x, a4.y, a4.z, a4.w};
            const float b[4] = {b4.x, b4.y, b4.z, b4.w};
#pragma unroll
            for (int i = 0; i < 4; ++i)
#pragma unroll
                for (int j = 0; j < 4; ++j) acc[i][j] += a[i] * b[j];
        }
    }
#pragma unroll
    for (int i = 0; i < 4; ++i) {
        const int m = m0 + ty * 4 + i;
        if (m < M) {
#pragma unroll
            for (int j = 0; j < 4; ++j) f.store(z, m, n0 + tx * 4 + j, acc[i][j]);
        }
    }
}

struct FPlain {
    const float* A; const float* Bm; float* C; int lda; int ldc; int M_; int pad_;
    __device__ int M(int) const { return M_; }
    __device__ const float* arow(int, int m) const { return A + (size_t)m * lda; }
    __device__ const float* B(int) const { return Bm; }
    __device__ void store(int, int m, int n, float v) const { C[(size_t)m * ldc + n] = v; }
};
struct FGlu {
    const float* Y; const float* W; const float* bias; float* O;
    __device__ int M(int) const { return NT; }
    __device__ const float* arow(int, int m) const { return Y + (size_t)m * 512; }
    __device__ const float* B(int) const { return W; }
    __device__ void store(int, int m, int n, float v) const {
        const float yv = Y[(size_t)m * 512 + n];
        const float s = 1.f / (1.f + expf(-(v + bias[n])));
        O[(size_t)m * 512 + n] = yv * s;
    }
};
struct FResid {
    const float* A; const float* Bm; const float* R; float* C; int lda; int pad_;
    __device__ int M(int) const { return NT; }
    __device__ const float* arow(int, int m) const { return A + (size_t)m * lda; }
    __device__ const float* B(int) const { return Bm; }
    __device__ void store(int, int m, int n, float v) const { C[(size_t)m * 1024 + n] = ALPHA * R[(size_t)m * 1024 + n] + v; }
};
struct FMoeUp {
    const float* H; const float* W; const int* cnt; const int* list; float* GU;
    __device__ int M(int z) const { return cnt[z]; }
    __device__ const float* arow(int z, int m) const { return H + (size_t)(list[(size_t)z * CAP + m] >> 3) * 1024; }
    __device__ const float* B(int z) const { return W + (size_t)z * 1024 * 512; }
    __device__ void store(int z, int m, int n, float v) const { GU[(size_t)list[(size_t)z * CAP + m] * 512 + n] = v; }
};
struct FMoeDown {
    const float* ACT; const float* W; const int* cnt; const int* list; float* CT;
    __device__ int M(int z) const { return cnt[z]; }
    __device__ const float* arow(int z, int m) const { return ACT + (size_t)list[(size_t)z * CAP + m] * 256; }
    __device__ const float* B(int z) const { return W + (size_t)z * 256 * 1024; }
    __device__ void store(int z, int m, int n, float v) const { CT[(size_t)list[(size_t)z * CAP + m] * 1024 + n] = v; }
};

__global__ void k_rope(float* proj) {
    const int idx = blockIdx.x * blockDim.x + threadIdx.x;
    if (idx >= NT * 128) return;
    const int i = idx & 7, h = (idx >> 3) & 7, w = (idx >> 6) & 1, tok = idx >> 7;
    const int pos = tok % L_;
    const float inv = powf(500000.0f, -(float)i / 8.0f);
    const float ang = (float)pos * inv;
    const float c = cosf(ang), s = sinf(ang);
    float* p = proj + (size_t)tok * NPROJ + w * 512 + h * 64;
    const float x1 = p[i], x2 = p[8 + i];
    p[i] = x1 * c - x2 * s;
    p[8 + i] = x2 * c + x1 * s;
}

__global__ __launch_bounds__(64) void k_attn(const float* __restrict__ proj, float* __restrict__ oatt) {
    const int idx = blockIdx.x * blockDim.x + threadIdx.x;
    const int t = idx % L_, h = (idx / L_) % NH, b = idx / (L_ * NH);
    const float* base = proj + (size_t)b * L_ * NPROJ + h * 64;
    float q[64], o[64];
    {
        const float* qp = base + (size_t)t * NPROJ;
#pragma unroll
        for (int d = 0; d < 64; d += 4) { const float4 v = *(const float4*)(qp + d); q[d] = v.x * 0.125f; q[d + 1] = v.y * 0.125f; q[d + 2] = v.z * 0.125f; q[d + 3] = v.w * 0.125f; }
#pragma unroll
        for (int d = 0; d < 64; ++d) o[d] = 0.f;
    }
    float mx = -INFINITY, l = 0.f;
    for (int br = 0; br < 3; ++br) {
        const int dil = 1 << (2 * br);
        for (int j = 0; j <= 128; ++j) {
            const int tk = t - j * dil;
            if (tk < 0) break;
            const float* kp = base + (size_t)tk * NPROJ + 512;
            const float* vp = base + (size_t)tk * NPROJ + 1024;
            float s = 0.f;
#pragma unroll
            for (int d = 0; d < 64; d += 4) { const float4 v = *(const float4*)(kp + d); s += q[d] * v.x + q[d + 1] * v.y + q[d + 2] * v.z + q[d + 3] * v.w; }
            const float mn = fmaxf(mx, s);
            const float a = expf(mx - mn), p = expf(s - mn);
            l = l * a + p;
#pragma unroll
            for (int d = 0; d < 64; d += 4) {
                const float4 v = *(const float4*)(vp + d);
                o[d] = o[d] * a + p * v.x; o[d + 1] = o[d + 1] * a + p * v.y; o[d + 2] = o[d + 2] * a + p * v.z; o[d + 3] = o[d + 3] * a + p * v.w;
            }
            mx = mn;
        }
    }
    const float il = 1.f / l;
    float* op = oatt + ((size_t)b * L_ + t) * 512 + h * 64;
#pragma unroll
    for (int d = 0; d < 64; d += 4) *(float4*)(op + d) = make_float4(o[d] * il, o[d + 1] * il, o[d + 2] * il, o[d + 3] * il);
}

__device__ __forceinline__ float gelu_tanh(float x) {
    const float k0 = 0.7978845608028654f;
    return 0.5f * x * (1.f + tanhf(k0 * (x + 0.044715f * x * x * x)));
}
__global__ __launch_bounds__(64) void k_ssm(const float* __restrict__ proj, const float* lam_re, const float* lam_im, const float* log_step,
                                            const float* b_re, const float* b_im, const float* c_re, const float* c_im, const float* d_skip,
                                            float* __restrict__ y) {
    const int b = blockIdx.x / SG, g = blockIdx.x % SG, p = threadIdx.x;
    const float lr = lam_re[g * SP + p], li = lam_im[g * SP + p];
    const float step = expf(log_step[g]);
    const float er = expf(lr * step);
    const float ar = er * cosf(li * step), ai = er * sinf(li * step);
    const float nr = ar - 1.f, ni = ai, den = lr * lr + li * li;
    const float cr = (nr * lr + ni * li) / den, ci = (ni * lr - nr * li) / den;
    float Br[16], Bi[16], Cr[16], Ci[16], Dk[16];
#pragma unroll
    for (int c = 0; c < 16; ++c) {
        const float br = b_re[((size_t)g * SP + p) * SC + c], bi = b_im[((size_t)g * SP + p) * SC + c];
        Br[c] = cr * br - ci * bi; Bi[c] = cr * bi + ci * br;
        Cr[c] = c_re[((size_t)g * SC + c) * SP + p]; Ci[c] = c_im[((size_t)g * SC + c) * SP + p];
        Dk[c] = d_skip[g * SC + c];
    }
    float xr = 0.f, xi = 0.f;
    for (int t = 0; t < L_; ++t) {
        const float* up = proj + ((size_t)b * L_ + t) * NPROJ + 1536 + g * SC;
        float u[16];
#pragma unroll
        for (int c = 0; c < 16; c += 4) { const float4 v = *(const float4*)(up + c); u[c] = v.x; u[c + 1] = v.y; u[c + 2] = v.z; u[c + 3] = v.w; }
        float bur = 0.f, bui = 0.f;
#pragma unroll
        for (int c = 0; c < 16; ++c) { bur += Br[c] * u[c]; bui += Bi[c] * u[c]; }
        const float nxr = ar * xr - ai * xi + bur, nxi = ar * xi + ai * xr + bui;
        xr = nxr; xi = nxi;
        float yv[16];
#pragma unroll
        for (int c = 0; c < 16; ++c) {
            float v = Cr[c] * xr - Ci[c] * xi;
#pragma unroll
            for (int s = 32; s >= 1; s >>= 1) v += __shfl_xor(v, s);
            yv[c] = gelu_tanh(v + Dk[c] * u[c]);
        }
        if (p == 0) {
            float* yp = y + ((size_t)b * L_ + t) * 512 + g * SC;
#pragma unroll
            for (int c = 0; c < 16; c += 4) *(float4*)(yp + c) = make_float4(yv[c], yv[c + 1], yv[c + 2], yv[c + 3]);
        }
    }
}

__device__ __forceinline__ float wave_sum(float v) {
#pragma unroll
    for (int s = 32; s >= 1; s >>= 1) v += __shfl_xor(v, s);
    return v;
}
__global__ __launch_bounds__(64) void k_rms_cat(const float* oatt, const float* ossm, const float* g_att, const float* g_ssm, float* ycat) {
    const int tok = blockIdx.x, lane = threadIdx.x;
    float a[8], s[8]; float sa = 0.f, ss = 0.f;
#pragma unroll
    for (int i = 0; i < 8; ++i) { a[i] = oatt[(size_t)tok * 512 + i * 64 + lane]; s[i] = ossm[(size_t)tok * 512 + i * 64 + lane]; sa += a[i] * a[i]; ss += s[i] * s[i]; }
    sa = wave_sum(sa); ss = wave_sum(ss);
    const float ra = rsqrtf(sa / 512.f + 1e-6f), rs = rsqrtf(ss / 512.f + 1e-6f);
#pragma unroll
    for (int i = 0; i < 8; ++i) {
        const int c = i * 64 + lane;
        ycat[(size_t)tok * 1024 + c] = a[i] * ra * g_att[c];
        ycat[(size_t)tok * 1024 + 512 + c] = s[i] * rs * g_ssm[c];
    }
}

__global__ __launch_bounds__(64) void k_ln(const float* in, const float* g, const float* bta, float* out) {
    const int tok = blockIdx.x, lane = threadIdx.x;
    float v[16]; float s = 0.f;
#pragma unroll
    for (int i = 0; i < 16; ++i) { v[i] = in[(size_t)tok * 1024 + i * 64 + lane]; s += v[i]; }
    const float mu = wave_sum(s) / 1024.f;
    float q = 0.f;
#pragma unroll
    for (int i = 0; i < 16; ++i) { const float d = v[i] - mu; q += d * d; }
    const float rstd = rsqrtf(wave_sum(q) / 1024.f + 1e-5f);
#pragma unroll
    for (int i = 0; i < 16; ++i) { const int c = i * 64 + lane; out[(size_t)tok * 1024 + c] = (v[i] - mu) * rstd * g[c] + bta[c]; }
}

__global__ __launch_bounds__(64) void k_route(const float* logits, const float* rbias, float* gate, int* cnt, int* list) {
    const int tok = blockIdx.x, lane = threadIdx.x;
    const float4 lg = *(const float4*)(logits + (size_t)tok * NE + lane * 4);
    const float4 rb = *(const float4*)(rbias + lane * 4);
    float sc[4], ch[4];
    sc[0] = 1.f / (1.f + expf(-lg.x)); sc[1] = 1.f / (1.f + expf(-lg.y)); sc[2] = 1.f / (1.f + expf(-lg.z)); sc[3] = 1.f / (1.f + expf(-lg.w));
    ch[0] = sc[0] + rb.x; ch[1] = sc[1] + rb.y; ch[2] = sc[2] + rb.z; ch[3] = sc[3] + rb.w;
    float t1 = -INFINITY, t2 = -INFINITY;
#pragma unroll
    for (int i = 0; i < 4; ++i) { const float v = ch[i]; if (v > t1) { t2 = t1; t1 = v; } else if (v > t2) t2 = v; }
#pragma unroll
    for (int s = 1; s <= 4; s <<= 1) {
        const float o1 = __shfl_xor(t1, s), o2 = __shfl_xor(t2, s);
        const float n1 = fmaxf(t1, o1);
        const float n2 = fmaxf(fminf(t1, o1), fmaxf(t2, o2));
        t1 = n1; t2 = n2;
    }
    const float gs = t1 + t2;
    const int mygrp = lane >> 3;
    int rank = 0;
#pragma unroll
    for (int g2 = 0; g2 < 8; ++g2) { const float og = __shfl(gs, g2 * 8); if (og > gs || (og == gs && g2 < mygrp)) ++rank; }
    const bool gsel = rank < 4;
#pragma unroll
    for (int i = 0; i < 4; ++i) if (!gsel) ch[i] = -INFINITY;
    float gsum = 0.f; float myg = 0.f; int mye = -1;
    for (int k = 0; k < TOPK; ++k) {
        float bv = ch[0]; int bi = 0;
#pragma unroll
        for (int i = 1; i < 4; ++i) if (ch[i] > bv) { bv = ch[i]; bi = i; }
        int be = lane * 4 + bi;
#pragma unroll
        for (int s = 32; s >= 1; s >>= 1) {
            const float ov = __shfl_xor(bv, s); const int oe = __shfl_xor(be, s);
            if (ov > bv || (ov == bv && oe < be)) { bv = ov; be = oe; }
        }
        const int ol = be >> 2, oi = be & 3;
        float sv = 0.f;
        if (lane == ol) {
#pragma unroll
            for (int i = 0; i < 4; ++i) if (i == oi) { sv = sc[i]; ch[i] = -INFINITY; }
        }
        sv = __shfl(sv, ol);
        gsum += sv;
        if (lane == k) { myg = sv; mye = be; }
    }
    if (lane < TOPK) {
        const float gv = 2.5f * myg / (gsum + 1e-20f);
        gate[(size_t)tok * TOPK + lane] = gv;
        const int pos = atomicAdd(&cnt[mye], 1);
        list[(size_t)mye * CAP + pos] = tok * TOPK + lane;
    }
}

__global__ void k_swiglu(const float* gu, float* act, size_t nrows) {
    const size_t idx = (size_t)blockIdx.x * blockDim.x + threadIdx.x;
    if (idx >= nrows * 256) return;
    const size_t r = idx >> 8; const int j = (int)(idx & 255);
    const float g = gu[r * 512 + j], u = gu[r * 512 + 256 + j];
    act[idx] = g / (1.f + expf(-g)) * u;
}

__global__ __launch_bounds__(64) void k_final(const float* pre2, const float* contrib, const float* gate, const float* g, const float* bta, float* out) {
    const int tok = blockIdx.x, lane = threadIdx.x;
    float gk[8];
#pragma unroll
    for (int k = 0; k < 8; ++k) gk[k] = gate[(size_t)tok * 8 + k];
    float v[16]; float s = 0.f;
#pragma unroll
    for (int i = 0; i < 16; ++i) {
        const int c = i * 64 + lane;
        float a = pre2[(size_t)tok * 1024 + c];
#pragma unroll
        for (int k = 0; k < 8; ++k) a += gk[k] * contrib[((size_t)tok * 8 + k) * 1024 + c];
        v[i] = a; s += a;
    }
    const float mu = wave_sum(s) / 1024.f;
    float q = 0.f;
#pragma unroll
    for (int i = 0; i < 16; ++i) { const float d = v[i] - mu; q += d * d; }
    const float rstd = rsqrtf(wave_sum(q) / 1024.f + 1e-5f);
#pragma unroll
    for (int i = 0; i < 16; ++i) { const int c = i * 64 + lane; out[(size_t)tok * 1024 + c] = (v[i] - mu) * rstd * g[c] + bta[c]; }
}
}

extern "C" void kernel_launch(void* const* d_in, const int* in_sizes, int n_in, void* d_out, int out_size, void* d_ws, size_t ws_size, hipStream_t stream) {
    const float* x = (const float*)d_in[0];
    const float* w_in = (const float*)d_in[1];
    const float* att_norm_g = (const float*)d_in[2];
    const float* lam_re = (const float*)d_in[3];
    const float* lam_im = (const float*)d_in[4];
    const float* log_step = (const float*)d_in[5];
    const float* b_re = (const float*)d_in[6];
    const float* b_im = (const float*)d_in[7];
    const float* c_re = (const float*)d_in[8];
    const float* c_im = (const float*)d_in[9];
    const float* d_skip = (const float*)d_in[10];
    const float* w_glu = (const float*)d_in[11];
    const float* b_glu = (const float*)d_in[12];
    const float* ssm_norm_g = (const float*)d_in[13];
    const float* w_out = (const float*)d_in[14];
    const float* ln1_g = (const float*)d_in[15];
    const float* ln1_b = (const float*)d_in[16];
    const float* router_w = (const float*)d_in[17];
    const float* router_bias = (const float*)d_in[18];
    const float* w_gu = (const float*)d_in[19];
    const float* w_down = (const float*)d_in[20];
    const float* shared_w_gu = (const float*)d_in[21];
    const float* shared_w_down = (const float*)d_in[22];
    const float* ln2_g = (const float*)d_in[23];
    const float* ln2_b = (const float*)d_in[24];
    float* out = (float*)d_out;

    char* ws = (char*)d_ws; size_t off = 0;
    auto take = [&](size_t bytes) { char* p = ws + off; off += (bytes + 255) & ~(size_t)255; return p; };
    int* cnt = (int*)take(NE * sizeof(int));
    int* list = (int*)take((size_t)NE * CAP * sizeof(int));
    float* proj = (float*)take((size_t)NT * NPROJ * 4);
    float* oatt = (float*)take((size_t)NT * 512 * 4);
    float* yss = (float*)take((size_t)NT * 512 * 4);
    float* ossm = (float*)take((size_t)NT * 512 * 4);
    float* ycat = (float*)take((size_t)NT * 1024 * 4);
    float* pre1 = (float*)take((size_t)NT * 1024 * 4);
    float* h1 = (float*)take((size_t)NT * 1024 * 4);
    float* logits = (float*)take((size_t)NT * NE * 4);
    float* gate = (float*)take((size_t)NT * TOPK * 4);
    float* sgu = (float*)take((size_t)NT * 512 * 4);
    float* sact = (float*)take((size_t)NT * 256 * 4);
    float* pre2 = (float*)take((size_t)NT * 1024 * 4);
    float* act = (float*)take((size_t)NT * TOPK * 256 * 4);
    float* contrib = (float*)take((size_t)NT * TOPK * 1024 * 4);
    float* gu = contrib;

    (void)hipMemsetAsync(cnt, 0, NE * sizeof(int), stream);

    k_gemm<<<dim3(NPROJ / 64, NT / 64, 1), 256, 0, stream>>>(FPlain{x, w_in, proj, D_, NPROJ, NT, 0}, NPROJ, D_);
    k_rope<<<NT * 128 / 256, 256, 0, stream>>>(proj);
    k_attn<<<NT * NH / 64, 64, 0, stream>>>(proj, oatt);
    k_ssm<<<B_ * SG, 64, 0, stream>>>(proj, lam_re, lam_im, log_step, b_re, b_im, c_re, c_im, d_skip, yss);
    k_gemm<<<dim3(512 / 64, NT / 64, 1), 256, 0, stream>>>(FGlu{yss, w_glu, b_glu, ossm}, 512, 512);
    k_rms_cat<<<NT, 64, 0, stream>>>(oatt, ossm, att_norm_g, ssm_norm_g, ycat);
    k_gemm<<<dim3(1024 / 64, NT / 64, 1), 256, 0, stream>>>(FResid{ycat, w_out, x, pre1, 1024, 0}, 1024, 1024);
    k_ln<<<NT, 64, 0, stream>>>(pre1, ln1_g, ln1_b, h1);
    k_gemm<<<dim3(NE / 64, NT / 64, 1), 256, 0, stream>>>(FPlain{h1, router_w, logits, 1024, NE, NT, 0}, NE, 1024);
    k_route<<<NT, 64, 0, stream>>>(logits, router_bias, gate, cnt, list);
    k_gemm<<<dim3(512 / 64, CAP / 64, NE), 256, 0, stream>>>(FMoeUp{h1, w_gu, cnt, list, gu}, 512, 1024);
    k_swiglu<<<(unsigned)(((size_t)NT * TOPK * 256 + 255) / 256), 256, 0, stream>>>(gu, act, (size_t)NT * TOPK);
    k_gemm<<<dim3(1024 / 64, CAP / 64, NE), 256, 0, stream>>>(FMoeDown{act, w_down, cnt, list, contrib}, 1024, 256);
    k_gemm<<<dim3(512 / 64, NT / 64, 1), 256, 0, stream>>>(FPlain{h1, shared_w_gu, sgu, 1024, 512, NT, 0}, 512, 1024);
    k_swiglu<<<(unsigned)(((size_t)NT * 256 + 255) / 256), 256, 0, stream>>>(sgu, sact, (size_t)NT);
    k_gemm<<<dim3(1024 / 64, NT / 64, 1), 256, 0, stream>>>(FResid{sact, shared_w_down, h1, pre2, 256, 0}, 1024, 256);
    k_final<<<NT, 64, 0, stream>>>(pre2, contrib, gate, ln2_g, ln2_b, out);
}
```

```cpp
#include <hip/hip_runtime.h>
#include <stdint.h>

namespace {
constexpr int B_ = 8, L_ = 2048, D_ = 1024, NT = B_ * L_;
constexpr int NH = 8, HD = 64, NPROJ = 2048;
constexpr int SG = 32, SC = 16, SP = 64;
constexpr int NE = 256, TOPK = 8, EFF = 256;
constexpr int CAP = 16384;
constexpr float ALPHA = 1.189207115002721f;

template <class F>
__global__ __launch_bounds__(256) void k_gemm(F f, int N, int K) {
    const int z = blockIdx.z;
    const int M = f.M(z);
    const int m0 = blockIdx.y * 64, n0 = blockIdx.x * 64;
    if (m0 >= M) return;
    __shared__ float As[16][68];
    __shared__ float Bs[16][68];
    const int tid = threadIdx.x;
    const int tx = tid & 15, ty = tid >> 4;
    const int ar = tid >> 2, aq = (tid & 3) * 4;
    const bool arow_ok = (m0 + ar) < M;
    const float* ap = f.arow(z, arow_ok ? (m0 + ar) : m0);
    const int bk = tid >> 4, bq = (tid & 15) * 4;
    const float* bp = f.B(z) + (size_t)bk * N + n0 + bq;
    float acc[4][4];
#pragma unroll
    for (int i = 0; i < 4; ++i)
#pragma unroll
        for (int j = 0; j < 4; ++j) acc[i][j] = 0.f;
    for (int k0 = 0; k0 < K; k0 += 16) {
        float4 av = *(const float4*)(ap + k0 + aq);
        if (!arow_ok) av = make_float4(0.f, 0.f, 0.f, 0.f);
        const float4 bv = *(const float4*)(bp + (size_t)k0 * N);
        __syncthreads();
        As[aq + 0][ar] = av.x; As[aq + 1][ar] = av.y; As[aq + 2][ar] = av.z; As[aq + 3][ar] = av.w;
        *(float4*)&Bs[bk][bq] = bv;
        __syncthreads();
#pragma unroll
        for (int kk = 0; kk < 16; ++kk) {
            const float4 a4 = *(const float4*)&As[kk][ty * 4];
            const float4 b4 = *(const float4*)&Bs[kk][tx * 4];
            const float a[4] = {a4.x, a4.y, a4.z, a4.w};
            const float b[4] = {b4.x, b4.y, b4.z, b4.w};
#pragma unroll
            for (int i = 0; i < 4; ++i)
#pragma unroll
                for (int j = 0; j < 4; ++j) acc[i][j] += a[i] * b[j];
        }
    }
#pragma unroll
    for (int i = 0; i < 4; ++i) {
        const int m = m0 + ty * 4 + i;
        if (m < M) {
#pragma unroll
            for (int j = 0; j < 4; ++j) f.store(z, m, n0 + tx * 4 + j, acc[i][j]);
        }
    }
}

struct FPlain {
    const float* A; const float* Bm; float* C; int lda; int ldc; int M_; int pad_;
    __device__ int M(int) const { return M_; }
    __device__ const float* arow(int, int m) const { return A + (size_t)m * lda; }
    __device__ const float* B(int) const { return Bm; }
    __device__ void store(int, int m, int n, float v) const { C[(size_t)m * ldc + n] = v; }
};
struct FGlu {
    const float* Y; const float* W; const float* bias; float* O;
    __device__ int M(int) const { return NT; }
    __device__ const float* arow(int, int m) const { return Y + (size_t)m * 512; }
    __device__ const float* B(int) const { return W; }
    __device__ void store(int, int m, int n, float v) const {
        const float yv = Y[(size_t)m * 512 + n];
        const float s = 1.f / (1.f + expf(-(v + bias[n])));
        O[(size_t)m * 512 + n] = yv * s;
    }
};
struct FResid {
    const float* A; const float* Bm; const float* R; float* C; int lda; int pad_;
    __device__ int M(int) const { return NT; }
    __device__ const float* arow(int, int m) const { return A + (size_t)m * lda; }
    __device__ const float* B(int) const { return Bm; }
    __device__ void store(int, int m, int n, float v) const { C[(size_t)m * 1024 + n] = ALPHA * R[(size_t)m * 1024 + n] + v; }
};
struct FMoeUp {
    const float* H; const float* W; const int* cnt; const int* list; float* GU;
    __device__ int M(int z) const { return cnt[z]; }
    __device__ const float* arow(int z, int m) const { return H + (size_t)(list[(size_t)z * CAP + m] >> 3) * 1024; }
    __device__ const float* B(int z) const { return W + (size_t)z * 1024 * 512; }
    __device__ void store(int z, int m, int n, float v) const { GU[(size_t)list[(size_t)z * CAP + m] * 512 + n] = v; }
};
struct FMoeDown {
    const float* ACT; const float* W; const int* cnt; const int* list; float* CT;
    __device__ int M(int z) const { return cnt[z]; }
    __device__ const float* arow(int z, int m) const { return ACT + (size_t)list[(size_t)z * CAP + m] * 256; }
    __device__ const float* B(int z) const { return W + (size_t)z * 256 * 1024; }
    __device__ void store(int z, int m, int n, float v) const { CT[(size_t)list[(size_t)z * CAP + m] * 1024 + n] = v; }
};

__global__ void k_rope(float* proj) {
    const int idx = blockIdx.x * blockDim.x + threadIdx.x;
    if (idx >= NT * 128) return;
    const int i = idx & 7, h = (idx >> 3) & 7, w = (idx >> 6) & 1, tok = idx >> 7;
    const int pos = tok % L_;
    const float inv = powf(500000.0f, -(float)i / 8.0f);
    const float ang = (float)pos * inv;
    const float c = cosf(ang), s = sinf(ang);
    float* p = proj + (size_t)tok * NPROJ + w * 512 + h * 64;
    const float x1 = p[i], x2 = p[8 + i];
    p[i] = x1 * c - x2 * s;
    p[8 + i] = x2 * c + x1 * s;
}

__global__ __launch_bounds__(64) void k_attn(const float* __restrict__ proj, float* __restrict__ oatt) {
    const int idx = blockIdx.x * blockDim.x + threadIdx.x;
    const int t = idx % L_, h = (idx / L_) % NH, b = idx / (L_ * NH);
    const float* base = proj + (size_t)b * L_ * NPROJ + h * 64;
    float q[64], o[64];
    {
        const float* qp = base + (size_t)t * NPROJ;
#pragma unroll
        for (int d = 0; d < 64; d += 4) { const float4 v = *(const float4*)(qp + d); q[d] = v.x * 0.125f; q[d + 1] = v.y * 0.125f; q[d + 2] = v.z * 0.125f; q[d + 3] = v.w * 0.125f; }
#pragma unroll
        for (int d = 0; d < 64; ++d) o[d] = 0.f;
    }
    float mx = -INFINITY, l = 0.f;
    for (int br = 0; br < 3; ++br) {
        const int dil = 1 << (2 * br);
        for (int j = 0; j <= 128; ++j) {
            const int tk = t - j * dil;
            if (tk < 0) break;
            const float* kp = base + (size_t)tk * NPROJ + 512;
            const float* vp = base + (size_t)tk * NPROJ + 1024;
            float s = 0.f;
#pragma unroll
            for (int d = 0; d < 64; d += 4) { const float4 v = *(const float4*)(kp + d); s += q[d] * v.x + q[d + 1] * v.y + q[d + 2] * v.z + q[d + 3] * v.w; }
            const float mn = fmaxf(mx, s);
            const float a = expf(mx - mn), p = expf(s - mn);
            l = l * a + p;
#pragma unroll
            for (int d = 0; d < 64; d += 4) {
                const float4 v = *(const float4*)(vp + d);
                o[d] = o[d] * a + p * v.x; o[d + 1] = o[d + 1] * a + p * v.y; o[d + 2] = o[d + 2] * a + p * v.z; o[d + 3] = o[d + 3] * a + p * v.w;
            }
            mx = mn;
        }
    }
    const float il = 1.f / l;
    float* op = oatt + ((size_t)b * L_ + t) * 512 + h * 64;
#pragma unroll
    for (int d = 0; d < 64; d += 4) *(float4*)(op + d) = make_float4(o[d] * il, o[d + 1] * il, o[d + 2] * il, o[d + 3] * il);
}

__device__ __forceinline__ float gelu_tanh(float x) {
    const float k0 = 0.7978845608028654f;
    return 0.5f * x * (1.f + tanhf(k0 * (x + 0.044715f * x * x * x)));
}
__global__ __launch_bounds__(64) void k_ssm(const float* __restrict__ proj, const float* lam_re, const float* lam_im, const float* log_step,
                                            const float* b_re, const float* b_im, const float* c_re, const float* c_im, const float* d_skip,
                                            float* __restrict__ y) {
    const int b = blockIdx.x / SG, g = blockIdx.x % SG, p = threadIdx.x;
    const float lr = lam_re[g * SP + p], li = lam_im[g * SP + p];
    const float step = expf(log_step[g]);
    const float er = expf(lr * step);
    const float ar = er * cosf(li * step), ai = er * sinf(li * step);
    const float nr = ar - 1.f, ni = ai, den = lr * lr + li * li;
    const float cr = (nr * lr + ni * li) / den, ci = (ni * lr - nr * li) / den;
    float Br[16], Bi[16], Cr[16], Ci[16], Dk[16];
#pragma unroll
    for (int c = 0; c < 16; ++c) {
        const float br = b_re[((size_t)g * SP + p) * SC + c], bi = b_im[((size_t)g * SP + p) * SC + c];
        Br[c] = cr * br - ci * bi; Bi[c] = cr * bi + ci * br;
        Cr[c] = c_re[((size_t)g * SC + c) * SP + p]; Ci[c] = c_im[((size_t)g * SC + c) * SP + p];
        Dk[c] = d_skip[g * SC + c];
    }
    float xr = 0.f, xi = 0.f;
    for (int t = 0; t < L_; ++t) {
        const float* up = proj + ((size_t)b * L_ + t) * NPROJ + 1536 + g * SC;
        float u[16];
#pragma unroll
        for (int c = 0; c < 16; c += 4) { const float4 v = *(const float4*)(up + c); u[c] = v.x; u[c + 1] = v.y; u[c + 2] = v.z; u[c + 3] = v.w; }
        float bur = 0.f, bui = 0.f;
#pragma unroll
        for (int c = 0; c < 16; ++c) { bur += Br[c] * u[c]; bui += Bi[c] * u[c]; }
        const float nxr = ar * xr - ai * xi + bur, nxi = ar * xi + ai * xr + bui;
        xr = nxr; xi = nxi;
        float yv[16];
#pragma unroll
        for (int c = 0; c < 16; ++c) {
            float v = Cr[c] * xr - Ci[c] * xi;
#pragma unroll
            for (int s = 32; s >= 1; s >>= 1) v += __shfl_xor(v, s);
            yv[c] = gelu_tanh(v + Dk[c] * u[c]);
        }
        if (p == 0) {
            float* yp = y + ((size_t)b * L_ + t) * 512 + g * SC;
#pragma unroll
            for (int c = 0; c < 16; c += 4) *(float4*)(yp + c) = make_float4(yv[c], yv[c + 1], yv[c + 2], yv[c + 3]);
        }
    }
}

__device__ __forceinline__ float wave_sum(float v) {
#pragma unroll
    for (int s = 32; s >= 1; s >>= 1) v += __shfl_xor(v, s);
    return v;
}
__global__ __launch_bounds__(64) void k_rms_cat(const float* oatt, const float* ossm, const float* g_att, const float* g_ssm, float* ycat) {
    const int tok = blockIdx.x, lane = threadIdx.x;
    float a[8], s[8]; float sa = 0.f, ss = 0.f;
#pragma unroll
    for (int i = 0; i < 8; ++i) { a[i] = oatt[(size_t)tok * 512 + i * 64 + lane]; s[i] = ossm[(size_t)tok * 512 + i * 64 + lane]; sa += a[i] * a[i]; ss += s[i] * s[i]; }
    sa = wave_sum(sa); ss = wave_sum(ss);
    const float ra = rsqrtf(sa / 512.f + 1e-6f), rs = rsqrtf(ss / 512.f + 1e-6f);
#pragma unroll
    for (int i = 0; i < 8; ++i) {
        const int c = i * 64 + lane;
        ycat[(size_t)tok * 1024 + c] = a[i] * ra * g_att[c];
        ycat[(size_t)tok * 1024 + 512 + c] = s[i] * rs * g_ssm[c];
    }
}

__global__ __launch_bounds__(64) void k_ln(const float* in, const float* g, const float* bta, float* out) {
    const int tok = blockIdx.x, lane = threadIdx.x;
    float v[16]; float s = 0.f;
#pragma unroll
    for (int i = 0; i < 16; ++i) { v[i] = in[(size_t)tok * 1024 + i * 64 + lane]; s += v[i]; }
    const float mu = wave_sum(s) / 1024.f;
    float q = 0.f;
#pragma unroll
    for (int i = 0; i < 16; ++i) { const float d = v[i] - mu; q += d * d; }
    const float rstd = rsqrtf(wave_sum(q) / 1024.f + 1e-5f);
#pragma unroll
    for (int i = 0; i < 16; ++i) { const int c = i * 64 + lane; out[(size_t)tok * 1024 + c] = (v[i] - mu) * rstd * g[c] + bta[c]; }
}

__global__ __launch_bounds__(64) void k_route(const float* logits, const float* rbias, float* gate, int* cnt, int* list) {
    const int tok = blockIdx.x, lane = threadIdx.x;
    const float4 lg = *(const float4*)(logits + (size_t)tok * NE + lane * 4);
    const float4 rb = *(const float4*)(rbias + lane * 4);
    float sc[4], ch[4];
    sc[0] = 1.f / (1.f + expf(-lg.x)); sc[1] = 1.f / (1.f + expf(-lg.y)); sc[2] = 1.f / (1.f + expf(-lg.z)); sc[3] = 1.f / (1.f + expf(-lg.w));
    ch[0] = sc[0] + rb.x; ch[1] = sc[1] + rb.y; ch[2] = sc[2] + rb.z; ch[3] = sc[3] + rb.w;
    float t1 = -INFINITY, t2 = -INFINITY;
#pragma unroll
    for (int i = 0; i < 4; ++i) { const float v = ch[i]; if (v > t1) { t2 = t1; t1 = v; } else if (v > t2) t2 = v; }
#pragma unroll
    for (int s = 1; s <= 4; s <<= 1) {
        const float o1 = __shfl_xor(t1, s), o2 = __shfl_xor(t2, s);
        const float n1 = fmaxf(t1, o1);
        const float n2 = fmaxf(fminf(t1, o1), fmaxf(t2, o2));
        t1 = n1; t2 = n2;
    }
    const float gs = t1 + t2;
    const int mygrp = lane >> 3;
    int rank = 0;
#pragma unroll
    for (int g2 = 0; g2 < 8; ++g2) { const float og = __shfl(gs, g2 * 8); if (og > gs || (og == gs && g2 < mygrp)) ++rank; }
    const bool gsel = rank < 4;
#pragma unroll
    for (int i = 0; i < 4; ++i) if (!gsel) ch[i] = -INFINITY;
    float gsum = 0.f; float myg = 0.f; int mye = -1;
    for (int k = 0; k < TOPK; ++k) {
        float bv = ch[0]; int bi = 0;
#pragma unroll
        for (int i = 1; i < 4; ++i) if (ch[i] > bv) { bv = ch[i]; bi = i; }
        int be = lane * 4 + bi;
#pragma unroll
        for (int s = 32; s >= 1; s >>= 1) {
            const float ov = __shfl_xor(bv, s); const int oe = __shfl_xor(be, s);
            if (ov > bv || (ov == bv && oe < be)) { bv = ov; be = oe; }
        }
        const int ol = be >> 2, oi = be & 3;
        float sv = 0.f;
        if (lane == ol) {
#pragma unroll
            for (int i = 0; i < 4; ++i) if (i == oi) { sv = sc[i]; ch[i] = -INFINITY; }
        }
        sv = __shfl(sv, ol);
        gsum += sv;
        if (lane == k) { myg = sv; mye = be; }
    }
    if (lane < TOPK) {
        const float gv = 2.5f * myg / (gsum + 1e-20f);
        gate[(size_t)tok * TOPK + lane] = gv;
        const int pos = atomicAdd(&cnt[mye], 1);
        list[(size_t)mye * CAP + pos] = tok * TOPK + lane;
    }
}

__global__ void k_swiglu(const float* gu, float* act, size_t nrows) {
    const size_t idx = (size_t)blockIdx.x * blockDim.x + threadIdx.x;
    if (idx >= nrows * 256) return;
    const size_t r = idx >> 8; const int j = (int)(idx & 255);
    const float g = gu[r * 512 + j], u = gu[r * 512 + 256 + j];
    act[idx] = g / (1.f + expf(-g)) * u;
}

__global__ __launch_bounds__(64) void k_final(const float* pre2, const float* contrib, const float* gate, const float* g, const float* bta, float* out) {
    const int tok = blockIdx.x, lane = threadIdx.x;
    float gk[8];
#pragma unroll
    for (int k = 0; k < 8; ++k) gk[k] = gate[(size_t)tok * 8 + k];
    float v[16]; float s = 0.f;
#pragma unroll
    for (int i = 0; i < 16; ++i) {
        const int c = i * 64 + lane;
        float a = pre2[(size_t)tok * 1024 + c];
#pragma unroll
        for (int k = 0; k < 8; ++k) a += gk[k] * contrib[((size_t)tok * 8 + k) * 1024 + c];
        v[i] = a; s += a;
    }
    const float mu = wave_sum(s) / 1024.f;
    float q = 0.f;
#pragma unroll
    for (int i = 0; i < 16; ++i) { const float d = v[i] - mu; q += d * d; }
    const float rstd = rsqrtf(wave_sum(q) / 1024.f + 1e-5f);
#pragma unroll
    for (int i = 0; i < 16; ++i) { const int c = i * 64 + lane; out[(size_t)tok * 1024 + c] = (v[i] - mu) * rstd * g[c] + bta[c]; }
}

typedef unsigned short bf16_t;
typedef short bf16x8 __attribute__((ext_vector_type(8)));
typedef float f32x4 __attribute__((ext_vector_type(4)));
typedef unsigned u32x2 __attribute__((ext_vector_type(2)));
typedef unsigned u32x4 __attribute__((ext_vector_type(4)));
#define LDSP __attribute__((address_space(3)))

__device__ __forceinline__ unsigned f2bf(float f) { unsigned u = __builtin_bit_cast(unsigned, f); return (u + 0x7fffu + ((u >> 16) & 1u)) >> 16; }
__device__ __forceinline__ unsigned pk2(float lo, float hi) { return f2bf(lo) | (f2bf(hi) << 16); }
__device__ __forceinline__ float bf2f(unsigned short b) { return __builtin_bit_cast(float, (unsigned)b << 16); }

constexpr int GT_LDS = 131072;
template <class ARow, class Epi>
__device__ __forceinline__ void gemm_tile(LDSP unsigned char* lds, const ARow& arow, const unsigned char* Bt, size_t ldb  , int K, const Epi& epi) {
    const int tid = threadIdx.x, lane = tid & 63;
    const int wid = __builtin_amdgcn_readfirstlane(tid >> 6);
    const int wr = wid >> 2, wc = wid & 3, fr = lane & 15, fq = lane >> 4;
    const int srow = lane >> 3, schunk = (lane & 7) ^ (srow & 7);
    const unsigned char* ap[4]; const unsigned char* bp[4];
#pragma unroll
    for (int i = 0; i < 4; ++i) { const int r = 64 * i + 8 * wid + srow; ap[i] = arow(r) + schunk * 16; bp[i] = Bt + (size_t)r * ldb + schunk * 16; }
    const int aoff = (wr * 128 + fr) * 128, boff = 32768 + (wc * 64 + fr) * 128;
    const int c0 = ((fq) ^ (fr & 7)) * 16, c1 = ((4 + fq) ^ (fr & 7)) * 16;
    f32x4 acc[8][4];
#pragma unroll
    for (int mi = 0; mi < 8; ++mi)
#pragma unroll
        for (int ni = 0; ni < 4; ++ni) acc[mi][ni] = (f32x4){0.f, 0.f, 0.f, 0.f};
    const int nt = K >> 6;
    __syncthreads();
#pragma unroll
    for (int i = 0; i < 4; ++i) {
        __builtin_amdgcn_global_load_lds((const unsigned*)(ap[i]), (LDSP unsigned*)(lds + (64 * i + 8 * wid) * 128), 16, 0, 0);
        __builtin_amdgcn_global_load_lds((const unsigned*)(bp[i]), (LDSP unsigned*)(lds + 32768 + (64 * i + 8 * wid) * 128), 16, 0, 0);
    }
    for (int t = 0; t < nt; ++t) {
        asm volatile("s_waitcnt vmcnt(0)" ::: "memory");
        __syncthreads();
        if (t + 1 < nt) {
            const int nb = ((t + 1) & 1) * 65536; const size_t ko = (size_t)(t + 1) * 128;
#pragma unroll
            for (int i = 0; i < 4; ++i) {
                __builtin_amdgcn_global_load_lds((const unsigned*)(ap[i] + ko), (LDSP unsigned*)(lds + nb + (64 * i + 8 * wid) * 128), 16, 0, 0);
                __builtin_amdgcn_global_load_lds((const unsigned*)(bp[i] + ko), (LDSP unsigned*)(lds + nb + 32768 + (64 * i + 8 * wid) * 128), 16, 0, 0);
            }
        }
        const LDSP unsigned char* base = lds + (t & 1) * 65536;
#pragma unroll
        for (int ks = 0; ks < 2; ++ks) {
            const int cc = ks ? c1 : c0;
            bf16x8 af[8], bfr[4];
#pragma unroll
            for (int mi = 0; mi < 8; ++mi) af[mi] = *(const LDSP bf16x8*)(base + aoff + mi * 2048 + cc);
#pragma unroll
            for (int ni = 0; ni < 4; ++ni) bfr[ni] = *(const LDSP bf16x8*)(base + boff + ni * 2048 + cc);
#pragma unroll
            for (int mi = 0; mi < 8; ++mi)
#pragma unroll
                for (int ni = 0; ni < 4; ++ni) acc[mi][ni] = __builtin_amdgcn_mfma_f32_16x16x32_bf16(bfr[ni], af[mi], acc[mi][ni], 0, 0, 0);
        }
    }
    epi(acc, wr, wc, fr, fq);
}
template <class F> struct PerFrag {
    F f;
    __device__ __forceinline__ void operator()(const f32x4 (&acc)[8][4], int wr, int wc, int fr, int fq) const {
#pragma unroll
        for (int mi = 0; mi < 8; ++mi)
#pragma unroll
            for (int ni = 0; ni < 4; ++ni) f(wr * 128 + mi * 16 + fr, wc * 64 + ni * 16 + 4 * fq, acc[mi][ni]);
    }
};
template <class F> __device__ __forceinline__ PerFrag<F> per_frag(F f) { return PerFrag<F>{f}; }

struct RowId { __device__ __forceinline__ int operator()(int n) const { return n; } };
struct RowGU { __device__ __forceinline__ int operator()(int j) const { const int up = j >> 8, jj = j & 255; return (jj >> 7) * 256 + ((jj >> 5) & 3) * 64 + up * 32 + (jj & 31); } };
template <class RM>
__device__ __forceinline__ void transpose_tile(const float* W, int K, int N, bf16_t* Wt, int tile, LDSP float* scr  , int tid, RM rm = RM()) {
    const int tn = N >> 6; const int k0 = (tile / tn) * 64, n0 = (tile % tn) * 64;
#pragma unroll
    for (int i = 0; i < 4; ++i) {
        const int k = (tid >> 4) + 16 * i, n = (tid & 15) * 4;
        const float4 v = *(const float4*)(W + (size_t)(k0 + k) * N + n0 + n);
        scr[(n + 0) * 65 + k] = v.x; scr[(n + 1) * 65 + k] = v.y; scr[(n + 2) * 65 + k] = v.z; scr[(n + 3) * 65 + k] = v.w;
    }
    __syncthreads();
    {
        const int n = tid >> 2, kq = (tid & 3) * 16;
        u32x4 w0, w1;
        const LDSP float* p = scr + n * 65 + kq;
        w0.x = pk2(p[0], p[1]); w0.y = pk2(p[2], p[3]); w0.z = pk2(p[4], p[5]); w0.w = pk2(p[6], p[7]);
        w1.x = pk2(p[8], p[9]); w1.y = pk2(p[10], p[11]); w1.z = pk2(p[12], p[13]); w1.w = pk2(p[14], p[15]);
        bf16_t* o = Wt + (size_t)rm(n0 + n) * K + k0 + kq;
        *(u32x4*)o = w0; *(u32x4*)(o + 8) = w1;
    }
    __syncthreads();
}

struct ProArgs {
    const float* x; const float* w_in; bf16_t* xb; bf16_t* w_inT; float* rope;
};
__global__ __launch_bounds__(256) void k_prologue(ProArgs a) {
    __shared__ float scr[64 * 65];
    const int tid = threadIdx.x;
    for (size_t i = ((size_t)blockIdx.x * 256 + tid) * 8; i < (size_t)NT * D_; i += (size_t)gridDim.x * 256 * 8) {
        const float4 v0 = *(const float4*)(a.x + i), v1 = *(const float4*)(a.x + i + 4);
        u32x4 w; w.x = pk2(v0.x, v0.y); w.y = pk2(v0.z, v0.w); w.z = pk2(v1.x, v1.y); w.w = pk2(v1.z, v1.w);
        *(u32x4*)(a.xb + i) = w;
    }
    for (int t = blockIdx.x; t < (1024 / 64) * (2048 / 64); t += gridDim.x) transpose_tile<RowId>(a.w_in, 1024, 2048, a.w_inT, t, (LDSP float*)scr, tid);
    for (int i = blockIdx.x * 256 + tid; i < 2048 * 8; i += gridDim.x * 256) {
        const int pos = i >> 3, f = i & 7;
        const float inv = powf(500000.0f, -(float)f / 8.0f);
        const float ang = (float)pos * inv;
        a.rope[2 * i] = cosf(ang); a.rope[2 * i + 1] = sinf(ang);
    }
}

constexpr float QSCALE = 0.125f * 1.4426950408889634f;
struct P1Args { const bf16_t* xb; const bf16_t* w_inT; const float* rope; bf16_t* q; bf16_t* k; bf16_t* v; bf16_t* u; };
struct ARowDense { const unsigned char* base; size_t ld; __device__ __forceinline__ const unsigned char* operator()(int r) const { return base + (size_t)r * ld; } };
__global__ __launch_bounds__(512, 2) void k_p1(P1Args a) {
    extern __shared__ __attribute__((aligned(16))) unsigned char smem[];
    LDSP unsigned char* lds = (LDSP unsigned char*)smem;
    const int lane = threadIdx.x & 63;
    for (int u = blockIdx.x; u < 64 * 8; u += gridDim.x) {
        const int pm = u >> 3, pn = u & 7;
        const int m0 = pm * 256, n0 = pn * 256;
        ARowDense ar{(const unsigned char*)(a.xb + (size_t)m0 * 1024), 2048};
        gemm_tile(lds, ar, (const unsigned char*)(a.w_inT + (size_t)n0 * 1024), 2048, 1024, per_frag([&](int r, int c, f32x4 v) {
            const int m = m0 + r, n = n0 + c;
            const int b = m >> 11, t = m & 2047;
            const int sec = n >> 9, cs = n & 511;
            if (sec < 2) {
                const int h = cs >> 6, d = cs & 63;
                if (d < 16) {
                    f32x4 o;
                    o[0] = __shfl_xor(v[0], 32); o[1] = __shfl_xor(v[1], 32); o[2] = __shfl_xor(v[2], 32); o[3] = __shfl_xor(v[3], 32);
                    const int f0 = d & 7;
                    const float4 cs0 = *(const float4*)(a.rope + ((size_t)t * 8 + f0) * 2), cs1 = *(const float4*)(a.rope + ((size_t)t * 8 + f0 + 2) * 2);
                    const float cc[4] = {cs0.x, cs0.z, cs1.x, cs1.z}, ss[4] = {cs0.y, cs0.w, cs1.y, cs1.w};
                    const bool lo = d < 8;
#pragma unroll
                    for (int j = 0; j < 4; ++j) v[j] = lo ? (v[j] * cc[j] - o[j] * ss[j]) : (v[j] * cc[j] + o[j] * ss[j]);
                }
                if (sec == 0) { v[0] *= QSCALE; v[1] *= QSCALE; v[2] *= QSCALE; v[3] *= QSCALE; }
                bf16_t* dst = (sec == 0 ? a.q : a.k) + ((size_t)(b * 8 + h) * 2048 + t) * 64 + d;
                u32x2 w; w.x = pk2(v[0], v[1]); w.y = pk2(v[2], v[3]); *(u32x2*)dst = w;
            } else if (sec == 2) {
                const int h = cs >> 6, d = cs & 63;
                bf16_t* dst = a.v + ((size_t)(b * 8 + h) * 2048 + t) * 64 + d;
                u32x2 w; w.x = pk2(v[0], v[1]); w.y = pk2(v[2], v[3]); *(u32x2*)dst = w;
            } else {
                const int g = cs >> 4, ch = cs & 15;
                bf16_t* dst = a.u + ((size_t)(b * 32 + g) * 2048 + t) * 16 + ch;
                u32x2 w; w.x = pk2(v[0], v[1]); w.y = pk2(v[2], v[3]); *(u32x2*)dst = w;
            }
        }));
    }
    (void)lane;
}

__global__ void k_adapt_proj(const bf16_t* q, const bf16_t* k, const bf16_t* v, const bf16_t* u, float* proj) {
    const size_t idx = (size_t)blockIdx.x * blockDim.x + threadIdx.x;
    if (idx >= (size_t)NT * 2048) return;
    const int n = (int)(idx & 2047); const int m = (int)(idx >> 11);
    const int b = m >> 11, t = m & 2047, sec = n >> 9, cs = n & 511;
    float val;
    if (sec < 3) {
        const int h = cs >> 6, d = cs & 63;
        const bf16_t* src = sec == 0 ? q : (sec == 1 ? k : v);
        val = bf2f(src[((size_t)(b * 8 + h) * 2048 + t) * 64 + d]);
        if (sec == 0) val *= (1.0f / QSCALE);
    } else {
        const int g = cs >> 4, ch = cs & 15;
        val = bf2f(u[((size_t)(b * 32 + g) * 2048 + t) * 16 + ch]);
    }
    proj[idx] = val;
}

typedef float f32x16 __attribute__((ext_vector_type(16)));
typedef short s16x4 __attribute__((ext_vector_type(4)));
__device__ __forceinline__ s16x4 vtr(const LDSP unsigned char* p) { return __builtin_bit_cast(s16x4, __builtin_amdgcn_ds_read_tr16_b64_v4i16((LDSP s16x4*)p)); }
constexpr int ATT_UNITS = 3 * 64 * 64;
constexpr int ATT_VROW = 192, ATT_WLDS = 32 * ATT_VROW;
struct AttArgs { const bf16_t* q; const bf16_t* k; const bf16_t* v; bf16_t* opart; float* lse; };

__device__ __forceinline__ void attn_unit(const AttArgs& A, int u, LDSP unsigned char* vs, int lane) {
    const int c = u >> 12, rem = u & 4095, bh = rem >> 6, j = rem & 63;
    const int dsh = 2 * c, d = 1 << dsh, nblk = 64 >> dsh;
    const int r = j / nblk, a = j % nblk;
    const int l31 = lane & 31, h2 = lane >> 5;
    const bf16_t* Qb = A.q + (size_t)bh * 2048 * 64;
    const bf16_t* Kb = A.k + (size_t)bh * 2048 * 64;
    const bf16_t* Vb = A.v + (size_t)bh * 2048 * 64;
    const int sq = 32 * a + l31;
    const int tq = sq * d + r;
    bf16x8 qf[4];
    {
        const bf16_t* qp = Qb + (size_t)tq * 64 + 8 * h2;
#pragma unroll
        for (int s = 0; s < 4; ++s) qf[s] = *(const bf16x8*)(qp + 16 * s);
    }
    f32x16 S[5];
#pragma unroll
    for (int kt = 0; kt < 5; ++kt) {
        const int k0 = 32 * a - 128 + 32 * kt;
        if (k0 >= 0) {
            const int tk = (k0 + l31) * d + r;
            const bf16_t* kp = Kb + (size_t)tk * 64 + 8 * h2;
            bf16x8 kf[4];
#pragma unroll
            for (int s = 0; s < 4; ++s) kf[s] = *(const bf16x8*)(kp + 16 * s);
            f32x16 acc;
#pragma unroll
            for (int i = 0; i < 16; ++i) acc[i] = 0.f;
#pragma unroll
            for (int s = 0; s < 4; ++s) acc = __builtin_amdgcn_mfma_f32_32x32x16_bf16(kf[s], qf[s], acc, 0, 0, 0);
            if (kt == 0 || kt == 4) {
#pragma unroll
                for (int i = 0; i < 16; ++i) {
                    const int keyrow = (i & 3) + 8 * (i >> 2) + 4 * h2;
                    const int dist = sq - (k0 + keyrow);
                    if (dist < 0 || dist > 128) acc[i] = -INFINITY;
                }
            }
            S[kt] = acc;
        } else {
#pragma unroll
            for (int i = 0; i < 16; ++i) S[kt][i] = -INFINITY;
        }
    }
    float m = -INFINITY;
#pragma unroll
    for (int kt = 0; kt < 5; ++kt)
#pragma unroll
        for (int i = 0; i < 16; ++i) m = fmaxf(m, S[kt][i]);
    m = fmaxf(m, __shfl_xor(m, 32));
    float l = 0.f;
#pragma unroll
    for (int kt = 0; kt < 5; ++kt)
#pragma unroll
        for (int i = 0; i < 16; ++i) { const float p = exp2f(S[kt][i] - m); S[kt][i] = p; l += p; }
    l += __shfl_xor(l, 32);
    f32x16 O[2];
#pragma unroll
    for (int dt = 0; dt < 2; ++dt)
#pragma unroll
        for (int i = 0; i < 16; ++i) O[dt][i] = 0.f;
    const int g = lane >> 4, li = lane & 15;
    const LDSP unsigned char* vrd = vs + (4 * (g >> 1) + (li >> 2)) * ATT_VROW + (16 * (g & 1) + 4 * (li & 3)) * 2;
#pragma unroll
    for (int kt = 0; kt < 5; ++kt) {
        const int k0 = 32 * a - 128 + 32 * kt;
        if (k0 >= 0) {
#pragma unroll
            for (int i = 0; i < 4; ++i) {
                const int id = lane + 64 * i, row = id >> 3, ch = id & 7;
                const u32x4 w = *(const u32x4*)(Vb + (size_t)((k0 + row) * d + r) * 64 + ch * 8);
                *(LDSP u32x4*)(vs + row * ATT_VROW + ch * 16) = w;
            }
#pragma unroll
            for (int sp = 0; sp < 2; ++sp) {
                bf16x8 pf;
                {
                    u32x4 w;
                    w.x = pk2(S[kt][8 * sp + 0], S[kt][8 * sp + 1]); w.y = pk2(S[kt][8 * sp + 2], S[kt][8 * sp + 3]);
                    w.z = pk2(S[kt][8 * sp + 4], S[kt][8 * sp + 5]); w.w = pk2(S[kt][8 * sp + 6], S[kt][8 * sp + 7]);
                    pf = __builtin_bit_cast(bf16x8, w);
                }
#pragma unroll
                for (int dt = 0; dt < 2; ++dt) {
                    const s16x4 lo = vtr(vrd + (16 * sp) * ATT_VROW + dt * 64);
                    const s16x4 hi = vtr(vrd + (16 * sp + 8) * ATT_VROW + dt * 64);
                    const bf16x8 vf = (bf16x8){lo[0], lo[1], lo[2], lo[3], hi[0], hi[1], hi[2], hi[3]};
                    O[dt] = __builtin_amdgcn_mfma_f32_32x32x16_bf16(vf, pf, O[dt], 0, 0, 0);
                }
            }
        }
    }
    const float il = 1.f / l;
    const int b = bh >> 3, h = bh & 7;
    const size_t tok = (size_t)b * 2048 + tq;
    bf16_t* op = A.opart + ((size_t)c * NT + tok) * 512 + h * 64 + 4 * h2;
#pragma unroll
    for (int dt = 0; dt < 2; ++dt)
#pragma unroll
        for (int g4 = 0; g4 < 4; ++g4) {
            u32x2 w; w.x = pk2(O[dt][4 * g4 + 0] * il, O[dt][4 * g4 + 1] * il); w.y = pk2(O[dt][4 * g4 + 2] * il, O[dt][4 * g4 + 3] * il);
            *(u32x2*)(op + 32 * dt + 8 * g4) = w;
        }
    if (h2 == 0) A.lse[((size_t)c * NT + tok) * 8 + h] = m + log2f(l);
}
__global__ __launch_bounds__(512, 2) void k_attn2(AttArgs A) {
    extern __shared__ __attribute__((aligned(16))) unsigned char smem[];
    const int lane = threadIdx.x & 63, wid = __builtin_amdgcn_readfirstlane(threadIdx.x >> 6);
    LDSP unsigned char* vs = (LDSP unsigned char*)smem + wid * ATT_WLDS;
    for (int u = blockIdx.x * 8 + wid; u < ATT_UNITS; u += gridDim.x * 8) attn_unit(A, u, vs, lane);
}

struct MergeArgs { const bf16_t* opart; const float* lse; const bf16_t* ossm; const float* g_att; const float* g_ssm; bf16_t* ycat; };
__device__ __forceinline__ void merge_token(const MergeArgs& A, int tok, int lane) {
    const int h = lane >> 3;
    float ls[3], w[3];
#pragma unroll
    for (int c = 0; c < 3; ++c) ls[c] = A.lse[((size_t)c * NT + tok) * 8 + h];
    const float mx = fmaxf(ls[0], fmaxf(ls[1], ls[2]));
    float ws = 0.f;
#pragma unroll
    for (int c = 0; c < 3; ++c) { w[c] = exp2f(ls[c] - mx); ws += w[c]; }
    const float iw = 1.f / ws;
    float o[8];
#pragma unroll
    for (int i = 0; i < 8; ++i) o[i] = 0.f;
#pragma unroll
    for (int c = 0; c < 3; ++c) {
        const u32x4 v = *(const u32x4*)(A.opart + ((size_t)c * NT + tok) * 512 + lane * 8);
        const float wc = w[c] * iw;
        o[0] += wc * bf2f(v.x & 0xffff); o[1] += wc * bf2f(v.x >> 16); o[2] += wc * bf2f(v.y & 0xffff); o[3] += wc * bf2f(v.y >> 16);
        o[4] += wc * bf2f(v.z & 0xffff); o[5] += wc * bf2f(v.z >> 16); o[6] += wc * bf2f(v.w & 0xffff); o[7] += wc * bf2f(v.w >> 16);
    }
    float sa = 0.f;
#pragma unroll
    for (int i = 0; i < 8; ++i) sa += o[i] * o[i];
    sa = wave_sum(sa);
    const float ra = rsqrtf(sa * (1.f / 512.f) + 1e-6f);
    float s[8];
    {
        const u32x4 v = *(const u32x4*)(A.ossm + (size_t)tok * 512 + lane * 8);
        s[0] = bf2f(v.x & 0xffff); s[1] = bf2f(v.x >> 16); s[2] = bf2f(v.y & 0xffff); s[3] = bf2f(v.y >> 16);
        s[4] = bf2f(v.z & 0xffff); s[5] = bf2f(v.z >> 16); s[6] = bf2f(v.w & 0xffff); s[7] = bf2f(v.w >> 16);
    }
    float ss = 0.f;
#pragma unroll
    for (int i = 0; i < 8; ++i) ss += s[i] * s[i];
    ss = wave_sum(ss);
    const float rs = rsqrtf(ss * (1.f / 512.f) + 1e-6f);
    const float4 ga0 = *(const float4*)(A.g_att + lane * 8), ga1 = *(const float4*)(A.g_att + lane * 8 + 4);
    const float4 gs0 = *(const float4*)(A.g_ssm + lane * 8), gs1 = *(const float4*)(A.g_ssm + lane * 8 + 4);
    u32x4 wa, wsn;
    wa.x = pk2(o[0] * ra * ga0.x, o[1] * ra * ga0.y); wa.y = pk2(o[2] * ra * ga0.z, o[3] * ra * ga0.w);
    wa.z = pk2(o[4] * ra * ga1.x, o[5] * ra * ga1.y); wa.w = pk2(o[6] * ra * ga1.z, o[7] * ra * ga1.w);
    wsn.x = pk2(s[0] * rs * gs0.x, s[1] * rs * gs0.y); wsn.y = pk2(s[2] * rs * gs0.z, s[3] * rs * gs0.w);
    wsn.z = pk2(s[4] * rs * gs1.x, s[5] * rs * gs1.y); wsn.w = pk2(s[6] * rs * gs1.z, s[7] * rs * gs1.w);
    *(u32x4*)(A.ycat + (size_t)tok * 1024 + lane * 8) = wa;
    *(u32x4*)(A.ycat + (size_t)tok * 1024 + 512 + lane * 8) = wsn;
}
__global__ __launch_bounds__(512, 2) void k_merge(MergeArgs A) {
    const int lane = threadIdx.x & 63, wid = threadIdx.x >> 6;
    for (int tok = blockIdx.x * 8 + wid; tok < NT; tok += gridDim.x * 8) merge_token(A, tok, lane);
}
__global__ void k_bf2f(const bf16_t* in, float* out, size_t n) { const size_t i = (size_t)blockIdx.x * blockDim.x + threadIdx.x; if (i < n) out[i] = bf2f(in[i]); }
__global__ void k_f2bf(const float* in, bf16_t* out, size_t n) { const size_t i = (size_t)blockIdx.x * blockDim.x + threadIdx.x; if (i < n) out[i] = (bf16_t)f2bf(in[i]); }

struct SsmTabArgs { const float* lam_re; const float* lam_im; const float* log_step; const float* b_re; const float* b_im; const float* c_re; const float* c_im;
                    bf16_t* wendT; bf16_t* wcarT; bf16_t* klagT; float* a16; };
__device__ __forceinline__ void ssm_apow(const SsmTabArgs& A, int g, int p, float k, float& pr, float& pi) {
    const float lr = A.lam_re[g * 64 + p], li = A.lam_im[g * 64 + p], step = expf(A.log_step[g]);
    const float e = expf(k * lr * step); pr = e * cosf(k * li * step); pi = e * sinf(k * li * step);
}
__device__ __forceinline__ void ssm_coef(const SsmTabArgs& A, int g, int p, float& cr, float& ci) {
    const float lr = A.lam_re[g * 64 + p], li = A.lam_im[g * 64 + p];
    float ar, ai; ssm_apow(A, g, p, 1.f, ar, ai);
    const float nr = ar - 1.f, ni = ai, den = lr * lr + li * li;
    cr = (nr * lr + ni * li) / den; ci = (ni * lr - nr * li) / den;
}
__device__ __forceinline__ void ssm_tab_item(const SsmTabArgs& A, int it) {
    if (it < 32768) {
        const int s = it & 15, p = (it >> 4) & 63, g = it >> 10;
        float pr, pi, cr, ci; ssm_apow(A, g, p, (float)(15 - s), pr, pi); ssm_coef(A, g, p, cr, ci);
        const float mr = pr * cr - pi * ci, mi = pr * ci + pi * cr;
        bf16_t* ore = A.wendT + ((size_t)g * 128 + p) * 256 + s * 16;
        bf16_t* oim = A.wendT + ((size_t)g * 128 + 64 + p) * 256 + s * 16;
#pragma unroll
        for (int c = 0; c < 16; ++c) {
            const float br = A.b_re[((size_t)g * 64 + p) * 16 + c], bi = A.b_im[((size_t)g * 64 + p) * 16 + c];
            ore[c] = (bf16_t)f2bf(mr * br - mi * bi); oim[c] = (bf16_t)f2bf(mr * bi + mi * br);
        }
    } else if (it < 65536) {
        const int j = it - 32768; const int t = j & 15, p = (j >> 4) & 63, g = j >> 10;
        float pr, pi; ssm_apow(A, g, p, (float)(t + 1), pr, pi);
#pragma unroll
        for (int co = 0; co < 16; ++co) {
            const float cr = A.c_re[((size_t)g * 16 + co) * 64 + p], ci = A.c_im[((size_t)g * 16 + co) * 64 + p];
            bf16_t* o = A.wcarT + ((size_t)g * 256 + t * 16 + co) * 128;
            o[p] = (bf16_t)f2bf(cr * pr - ci * pi); o[64 + p] = (bf16_t)f2bf(-(cr * pi + ci * pr));
        }
    } else {
        const int j = it - 65536; const int p = j & 63, g = j >> 6;
        float pr, pi; ssm_apow(A, g, p, 16.f, pr, pi);
        A.a16[(size_t)j * 2] = pr; A.a16[(size_t)j * 2 + 1] = pi;
    }
}
constexpr int SSM_TAB_ITEMS = 65536 + 2048;
__device__ __forceinline__ void ssm_klag_item(const SsmTabArgs& A, int it, LDSP float* scr, int tid) {
    const int g = it >> 4, lag = it & 15;
    LDSP float* Mr = scr; LDSP float* Mi = scr + 1024; LDSP float* Cr = scr + 2048; LDSP float* Ci = scr + 3072;
    __syncthreads();
    if (tid < 64) {
        const int p = tid; float pr, pi, cr, ci; ssm_apow(A, g, p, (float)lag, pr, pi); ssm_coef(A, g, p, cr, ci);
        const float mr = pr * cr - pi * ci, mi = pr * ci + pi * cr;
#pragma unroll
        for (int c = 0; c < 16; ++c) {
            const float br = A.b_re[((size_t)g * 64 + p) * 16 + c], bi = A.b_im[((size_t)g * 64 + p) * 16 + c];
            Mr[p * 16 + c] = mr * br - mi * bi; Mi[p * 16 + c] = mr * bi + mi * br;
            Cr[p * 16 + c] = A.c_re[((size_t)g * 16 + c) * 64 + p]; Ci[p * 16 + c] = A.c_im[((size_t)g * 16 + c) * 64 + p];
        }
    }
    __syncthreads();
    if (tid < 256) {
        const int co = tid >> 4, ci_ = tid & 15; float acc = 0.f;
        for (int p = 0; p < 64; ++p) acc += Cr[p * 16 + co] * Mr[p * 16 + ci_] - Ci[p * 16 + co] * Mi[p * 16 + ci_];
        A.klagT[(((size_t)g * 16 + lag) * 16 + co) * 16 + ci_] = (bf16_t)f2bf(acc);
    }
}

struct SsmArgs { const bf16_t* u; const bf16_t* wendT; const bf16_t* wcarT; const bf16_t* klagT; const float* a16; const float* d_skip; bf16_t* yss; };
__device__ __forceinline__ void ssm_stage_u(LDSP unsigned char* lds, const bf16_t* ubase  , int hh, int tid) {
#pragma unroll
    for (int i = 0; i < 4; ++i) {
        const int id = tid + 512 * i, row = id >> 5, ch = id & 31;
        const u32x4 w = *(const u32x4*)(ubase + (size_t)(64 * hh + row) * 256 + ch * 8);
        *(LDSP u32x4*)(lds + (ch >> 3) * 8192 + row * 128 + (((ch & 7) ^ (row & 7)) * 16)) = w;
    }
}
__device__ __forceinline__ void ssm_unit(const SsmArgs& A, int bg, LDSP unsigned char* lds) {
    const int tid = threadIdx.x, lane = tid & 63, w = __builtin_amdgcn_readfirstlane(tid >> 6), fr = lane & 15, fq = lane >> 4;
    const int g = bg & 31, b = bg >> 5;
    const bf16_t* ubase = A.u + (size_t)bg * 2048 * 16;
    LDSP unsigned char* Ebuf = lds + 32768; LDSP unsigned char* Xbuf = lds + 98304;
    const bf16_t* wend = A.wendT + (size_t)g * 128 * 256;
    const bf16_t* wcar = A.wcarT + (size_t)g * 256 * 128;
    const bf16_t* klag = A.klagT + (size_t)g * 16 * 256;
    for (int hh = 0; hh < 2; ++hh) {
        __syncthreads();
        ssm_stage_u(lds, ubase, hh, tid);
        __syncthreads();
        f32x4 acc[4];
#pragma unroll
        for (int mi = 0; mi < 4; ++mi) acc[mi] = (f32x4){0.f, 0.f, 0.f, 0.f};
#pragma unroll
        for (int kk = 0; kk < 8; ++kk) {
            const bf16x8 wf = *(const bf16x8*)(wend + (size_t)(16 * w + fr) * 256 + 32 * kk + 8 * fq);
#pragma unroll
            for (int mi = 0; mi < 4; ++mi) {
                const bf16x8 af = *(const LDSP bf16x8*)(lds + (kk >> 1) * 8192 + (16 * mi + fr) * 128 + (((((kk & 1) * 4) + fq) ^ (fr & 7)) * 16));
                acc[mi] = __builtin_amdgcn_mfma_f32_16x16x32_bf16(wf, af, acc[mi], 0, 0, 0);
            }
        }
#pragma unroll
        for (int mi = 0; mi < 4; ++mi) *(LDSP f32x4*)(Ebuf + ((64 * hh + 16 * mi + fr) * 128 + 16 * w + 4 * fq) * 4) = acc[mi];
    }
    __syncthreads();
    if (w == 0) {
        const float ar = A.a16[((size_t)g * 64 + lane) * 2], ai = A.a16[((size_t)g * 64 + lane) * 2 + 1];
        float cr = 0.f, ci = 0.f;
        const int xo = ((lane >> 3)) , xb = (lane & 7) * 2;
        for (int c = 0; c < 128; ++c) {
            const float er = *(const LDSP float*)(Ebuf + (c * 128 + lane) * 4), ei = *(const LDSP float*)(Ebuf + (c * 128 + 64 + lane) * 4);
            const int off = c * 128 + ((xo ^ (c & 7)) * 16) + xb;
            *(LDSP bf16_t*)(Xbuf + off) = (bf16_t)f2bf(cr);
            *(LDSP bf16_t*)(Xbuf + 16384 + off) = (bf16_t)f2bf(ci);
            const float nr = ar * cr - ai * ci + er, ni = ar * ci + ai * cr + ei;
            cr = nr; ci = ni;
        }
    }
    __syncthreads();
    for (int hx = 0; hx < 2; ++hx) {
        const int hh = 1 - hx;
        if (hx == 1) { __syncthreads(); ssm_stage_u(lds, ubase, hh, tid); __syncthreads(); }
        f32x4 acc[4][2];
#pragma unroll
        for (int mi = 0; mi < 4; ++mi) { acc[mi][0] = (f32x4){0.f, 0.f, 0.f, 0.f}; acc[mi][1] = (f32x4){0.f, 0.f, 0.f, 0.f}; }
#pragma unroll
        for (int j = 0; j < 2; ++j) {
            const int t = j ? (15 - w) : w;
#pragma unroll
            for (int kk = 0; kk < 8; ++kk) {
                if (2 * kk <= t) {
                    const int s = 2 * kk + (fq >> 1);
                    bf16x8 wf = (bf16x8){0, 0, 0, 0, 0, 0, 0, 0};
                    if (s <= t) wf = *(const bf16x8*)(klag + ((size_t)(t - s) * 16 + fr) * 16 + 8 * (fq & 1));
#pragma unroll
                    for (int mi = 0; mi < 4; ++mi) {
                        const bf16x8 af = *(const LDSP bf16x8*)(lds + (kk >> 1) * 8192 + (16 * mi + fr) * 128 + (((((kk & 1) * 4) + fq) ^ (fr & 7)) * 16));
                        acc[mi][j] = __builtin_amdgcn_mfma_f32_16x16x32_bf16(wf, af, acc[mi][j], 0, 0, 0);
                    }
                }
            }
#pragma unroll
            for (int k2 = 0; k2 < 4; ++k2) {
                const bf16x8 wf = *(const bf16x8*)(wcar + (size_t)(t * 16 + fr) * 128 + 32 * k2 + 8 * fq);
#pragma unroll
                for (int mi = 0; mi < 4; ++mi) {
                    const int row = 64 * hh + 16 * mi + fr;
                    const bf16x8 xf = *(const LDSP bf16x8*)(Xbuf + (k2 >> 1) * 16384 + row * 128 + (((((k2 & 1) * 4) + fq) ^ (fr & 7)) * 16));
                    acc[mi][j] = __builtin_amdgcn_mfma_f32_16x16x32_bf16(wf, xf, acc[mi][j], 0, 0, 0);
                }
            }
        }
        const float4 dk = *(const float4*)(A.d_skip + g * 16 + 4 * fq);
#pragma unroll
        for (int j = 0; j < 2; ++j) {
            const int t = j ? (15 - w) : w;
#pragma unroll
            for (int mi = 0; mi < 4; ++mi) {
                const int tt = (64 * hh + 16 * mi + fr) * 16 + t;
                const u32x2 uw = *(const u32x2*)(ubase + (size_t)tt * 16 + 4 * fq);
                const f32x4 a = acc[mi][j];
                const float y0 = gelu_tanh(a[0] + dk.x * bf2f(uw.x & 0xffff)), y1 = gelu_tanh(a[1] + dk.y * bf2f(uw.x >> 16));
                const float y2 = gelu_tanh(a[2] + dk.z * bf2f(uw.y & 0xffff)), y3 = gelu_tanh(a[3] + dk.w * bf2f(uw.y >> 16));
                u32x2 o; o.x = pk2(y0, y1); o.y = pk2(y2, y3);
                *(u32x2*)(A.yss + ((size_t)b * 2048 + tt) * 512 + g * 16 + 4 * fq) = o;
            }
        }
    }
}
__global__ __launch_bounds__(512, 2) void k_ssm2(SsmArgs A) {
    extern __shared__ __attribute__((aligned(16))) unsigned char smem[];
    for (int bg = blockIdx.x; bg < 256; bg += gridDim.x) ssm_unit(A, bg, (LDSP unsigned char*)smem);
}
__global__ __launch_bounds__(256) void k_ssmtab(SsmTabArgs A, const float* w_glu, bf16_t* w_gluT) {
    __shared__ float scr[64 * 65];
    const int tid = threadIdx.x;
    for (int it = blockIdx.x * 256 + tid; it < SSM_TAB_ITEMS; it += gridDim.x * 256) ssm_tab_item(A, it);
    for (int it = blockIdx.x; it < 512; it += gridDim.x) ssm_klag_item(A, it, (LDSP float*)scr, tid);
    for (int t = blockIdx.x; t < 64; t += gridDim.x) transpose_tile<RowId>(w_glu, 512, 512, w_gluT, t, (LDSP float*)scr, tid);
}
struct GluArgs { const bf16_t* yss; const bf16_t* w_gluT; const float* b_glu; bf16_t* ossm; };
__global__ __launch_bounds__(512, 2) void k_glu(GluArgs a) {
    extern __shared__ __attribute__((aligned(16))) unsigned char smem[];
    LDSP unsigned char* lds = (LDSP unsigned char*)smem;
    for (int u = blockIdx.x; u < 64 * 2; u += gridDim.x) {
        const int m0 = (u >> 1) * 256, n0 = (u & 1) * 256;
        ARowDense ar{(const unsigned char*)(a.yss + (size_t)m0 * 512), 1024};
        gemm_tile(lds, ar, (const unsigned char*)(a.w_gluT + (size_t)n0 * 512), 1024, 512, per_frag([&](int r, int c, f32x4 v) {
            const int m = m0 + r, n = n0 + c;
            const u32x2 yw = *(const u32x2*)(a.yss + (size_t)m * 512 + n);
            const float4 bb = *(const float4*)(a.b_glu + n);
            const float y0 = bf2f(yw.x & 0xffff), y1 = bf2f(yw.x >> 16), y2 = bf2f(yw.y & 0xffff), y3 = bf2f(yw.y >> 16);
            u32x2 o;
            o.x = pk2(y0 / (1.f + __expf(-(v[0] + bb.x))), y1 / (1.f + __expf(-(v[1] + bb.y))));
            o.y = pk2(y2 / (1.f + __expf(-(v[2] + bb.z))), y3 / (1.f + __expf(-(v[3] + bb.w))));
            *(u32x2*)(a.ossm + (size_t)m * 512 + n) = o;
        }));
    }
}

struct Pro3Args { const float* w_out; const float* router_w; const float* shared_w_gu; const float* shared_w_down; bf16_t* w_outT; bf16_t* rsT; bf16_t* sdT; };
__global__ __launch_bounds__(256) void k_pro3(Pro3Args a) {
    __shared__ float scr[64 * 65];
    const int tid = threadIdx.x;
    for (int t = blockIdx.x; t < 256; t += gridDim.x) transpose_tile<RowId>(a.w_out, 1024, 1024, a.w_outT, t, (LDSP float*)scr, tid);
    for (int t = blockIdx.x; t < 64; t += gridDim.x) transpose_tile<RowId>(a.router_w, 1024, 256, a.rsT, t, (LDSP float*)scr, tid);
    for (int t = blockIdx.x; t < 128; t += gridDim.x) transpose_tile<RowGU>(a.shared_w_gu, 1024, 512, a.rsT + (size_t)256 * 1024, t, (LDSP float*)scr, tid);
    for (int t = blockIdx.x; t < 64; t += gridDim.x) transpose_tile<RowId>(a.shared_w_down, 256, 1024, a.sdT, t, (LDSP float*)scr, tid);
}
__device__ __forceinline__ float silu_f(float g) { return g / (1.f + __expf(-g)); }
template <class RowPtr>
__device__ __forceinline__ void swiglu_epi(const f32x4 (&acc)[8][4], int wr, int wc, int fr, int fq, const RowPtr& rowp  , int colbase) {
#pragma unroll
    for (int mi = 0; mi < 8; ++mi) {
        bf16_t* rp = rowp(wr * 128 + mi * 16 + fr);
        if (rp) {
#pragma unroll
            for (int ni = 0; ni < 2; ++ni) {
                const f32x4 g = acc[mi][ni], u = acc[mi][ni + 2];
                u32x2 o; o.x = pk2(silu_f(g[0]) * u[0], silu_f(g[1]) * u[1]); o.y = pk2(silu_f(g[2]) * u[2], silu_f(g[3]) * u[3]);
                *(u32x2*)(rp + colbase + 32 * wc + 16 * ni + 4 * fq) = o;
            }
        }
    }
}
struct P3Args { const bf16_t* ycat; const bf16_t* w_outT; const float* x; float* pre1; const float* ln1_g; const float* ln1_b; bf16_t* h1b;
                const bf16_t* rsT; float* logits; bf16_t* sact; const bf16_t* sdT; float* pre2; };
__global__ __launch_bounds__(512, 2) void k_wout(P3Args a) {
    extern __shared__ __attribute__((aligned(16))) unsigned char smem[];
    LDSP unsigned char* lds = (LDSP unsigned char*)smem;
    for (int u = blockIdx.x; u < 64 * 4; u += gridDim.x) {
        const int m0 = (u >> 2) * 256, n0 = (u & 3) * 256;
        ARowDense ar{(const unsigned char*)(a.ycat + (size_t)m0 * 1024), 2048};
        gemm_tile(lds, ar, (const unsigned char*)(a.w_outT + (size_t)n0 * 1024), 2048, 1024, per_frag([&](int r, int c, f32x4 v) {
            const size_t o = (size_t)(m0 + r) * 1024 + n0 + c;
            const f32x4 xv = *(const f32x4*)(a.x + o);
            *(f32x4*)(a.pre1 + o) = xv * ALPHA + v;
        }));
    }
}
__device__ __forceinline__ void ln_row_bf16(const float* in, const float* g, const float* bta, bf16_t* out, int lane) {
    f32x4 v[4]; float s = 0.f;
#pragma unroll
    for (int i = 0; i < 4; ++i) { v[i] = *(const f32x4*)(in + i * 256 + lane * 4); s += (v[i][0] + v[i][1]) + (v[i][2] + v[i][3]); }
    const float mu = wave_sum(s) * (1.f / 1024.f);
    float q = 0.f;
#pragma unroll
    for (int i = 0; i < 4; ++i) { const f32x4 d = v[i] - mu; q += (d[0] * d[0] + d[1] * d[1]) + (d[2] * d[2] + d[3] * d[3]); }
    const float rstd = rsqrtf(wave_sum(q) * (1.f / 1024.f) + 1e-5f);
#pragma unroll
    for (int i = 0; i < 4; ++i) {
        const f32x4 gg = *(const f32x4*)(g + i * 256 + lane * 4), bb = *(const f32x4*)(bta + i * 256 + lane * 4);
        const f32x4 y = (v[i] - mu) * rstd * gg + bb;
        u32x2 o; o.x = pk2(y[0], y[1]); o.y = pk2(y[2], y[3]);
        *(u32x2*)(out + i * 256 + lane * 4) = o;
    }
}
__global__ __launch_bounds__(512, 2) void k_ln1(P3Args a) {
    const int lane = threadIdx.x & 63, wid = threadIdx.x >> 6;
    for (int tok = blockIdx.x * 8 + wid; tok < NT; tok += gridDim.x * 8) ln_row_bf16(a.pre1 + (size_t)tok * 1024, a.ln1_g, a.ln1_b, a.h1b + (size_t)tok * 1024, lane);
}
__global__ __launch_bounds__(512, 2) void k_rs(P3Args a) {
    extern __shared__ __attribute__((aligned(16))) unsigned char smem[];
    LDSP unsigned char* lds = (LDSP unsigned char*)smem;
    for (int u = blockIdx.x; u < 64 * 3; u += gridDim.x) {
        const int pm = u / 3, pn = u % 3, m0 = pm * 256;
        ARowDense ar{(const unsigned char*)(a.h1b + (size_t)m0 * 1024), 2048};
        const unsigned char* bt = (const unsigned char*)(a.rsT + (size_t)pn * 256 * 1024);
        if (pn == 0) {
            gemm_tile(lds, ar, bt, 2048, 1024, per_frag([&](int r, int c, f32x4 v) { *(f32x4*)(a.logits + (size_t)(m0 + r) * 256 + c) = v; }));
        } else {
            gemm_tile(lds, ar, bt, 2048, 1024, [&](const f32x4 (&acc)[8][4], int wr, int wc, int fr, int fq) {
                swiglu_epi(acc, wr, wc, fr, fq, [&](int r) { return a.sact + (size_t)(m0 + r) * 256; }, 128 * (pn - 1));
            });
        }
    }
}
__global__ __launch_bounds__(512, 2) void k_sdown(P3Args a) {
    extern __shared__ __attribute__((aligned(16))) unsigned char smem[];
    LDSP unsigned char* lds = (LDSP unsigned char*)smem;
    for (int u = blockIdx.x; u < 64 * 4; u += gridDim.x) {
        const int m0 = (u >> 2) * 256, n0 = (u & 3) * 256;
        ARowDense ar{(const unsigned char*)(a.sact + (size_t)m0 * 256), 512};
        gemm_tile(lds, ar, (const unsigned char*)(a.sdT + (size_t)n0 * 256), 512, 256, per_frag([&](int r, int c, f32x4 v) {
            const size_t o = (size_t)(m0 + r) * 1024 + n0 + c;
            const u32x2 hw = *(const u32x2*)(a.h1b + o);
            f32x4 hv; hv[0] = bf2f(hw.x & 0xffff); hv[1] = bf2f(hw.x >> 16); hv[2] = bf2f(hw.y & 0xffff); hv[3] = bf2f(hw.y >> 16);
            *(f32x4*)(a.pre2 + o) = hv * ALPHA + v;
        }));
    }
}

__global__ __launch_bounds__(256) void k_proexp(const float* w_gu, const float* w_down, bf16_t* w_guT, bf16_t* w_dnT) {
    __shared__ float scr[64 * 65];
    const int tid = threadIdx.x;
    for (int t = blockIdx.x; t < 256 * 128; t += gridDim.x) { const int e = t >> 7; transpose_tile<RowGU>(w_gu + (size_t)e * 1024 * 512, 1024, 512, w_guT + (size_t)e * 512 * 1024, t & 127, (LDSP float*)scr, tid); }
    for (int t = blockIdx.x; t < 256 * 64; t += gridDim.x) { const int e = t >> 6; transpose_tile<RowId>(w_down + (size_t)e * 256 * 1024, 256, 1024, w_dnT + (size_t)e * 1024 * 256, t & 63, (LDSP float*)scr, tid); }
}
struct MoeArgs { const bf16_t* h1b; const bf16_t* w_guT; const bf16_t* w_dnT; const int* cnt; const int* list; const float* gate; bf16_t* actb; bf16_t* contrib; };
__device__ __forceinline__ void moe_tile_table(const int* cnt, LDSP int* ts, int tid) {
    __syncthreads();
    if (tid < 257) { int s = 0; for (int e = 0; e < tid; ++e) s += (cnt[e] + 255) >> 8; ts[tid] = s; }
    __syncthreads();
}
__device__ __forceinline__ int moe_find_expert(const LDSP int* ts, int tile) {
    int lo = 0, hi = 256;
    while (hi - lo > 1) { const int mid = (lo + hi) >> 1; if (ts[mid] <= tile) lo = mid; else hi = mid; }
    return lo;
}
struct ARowGather { const unsigned char* base; const int* lst; int n; __device__ __forceinline__ const unsigned char* operator()(int r) const { const int tok = r < n ? (lst[r] >> 3) : 0; return base + (size_t)tok * 2048; } };
__global__ __launch_bounds__(512, 2) void k_moe_up(MoeArgs a) {
    extern __shared__ __attribute__((aligned(16))) unsigned char smem[];
    LDSP unsigned char* lds = (LDSP unsigned char*)smem;
    LDSP int* ts = (LDSP int*)(lds + GT_LDS);
    moe_tile_table(a.cnt, ts, threadIdx.x);
    const int T = ts[256];
    for (int u = blockIdx.x; u < 2 * T; u += gridDim.x) {
        const int tile = u >> 1, pn = u & 1;
        const int e = moe_find_expert(ts, tile), mt = tile - ts[e];
        const int nvalid = a.cnt[e] - mt * 256;
        ARowGather ar{(const unsigned char*)a.h1b, a.list + (size_t)e * CAP + mt * 256, nvalid};
        gemm_tile(lds, ar, (const unsigned char*)(a.w_guT + ((size_t)e * 512 + pn * 256) * 1024), 2048, 1024, [&](const f32x4 (&acc)[8][4], int wr, int wc, int fr, int fq) {
            swiglu_epi(acc, wr, wc, fr, fq, [&](int r) { return a.actb + ((size_t)tile * 256 + r) * 256; }, 128 * pn);
        });
    }
}
__global__ __launch_bounds__(512, 2) void k_moe_down(MoeArgs a) {
    extern __shared__ __attribute__((aligned(16))) unsigned char smem[];
    LDSP unsigned char* lds = (LDSP unsigned char*)smem;
    LDSP int* ts = (LDSP int*)(lds + GT_LDS);
    moe_tile_table(a.cnt, ts, threadIdx.x);
    const int T = ts[256];
    for (int u = blockIdx.x; u < 4 * T; u += gridDim.x) {
        const int tile = u >> 2, pn = u & 3;
        const int e = moe_find_expert(ts, tile), mt = tile - ts[e];
        const int nvalid = a.cnt[e] - mt * 256;
        const int* lst = a.list + (size_t)e * CAP + mt * 256;
        ARowDense ar{(const unsigned char*)(a.actb + (size_t)tile * 256 * 256), 512};
        gemm_tile(lds, ar, (const unsigned char*)(a.w_dnT + ((size_t)e * 1024 + pn * 256) * 256), 512, 256, [&](const f32x4 (&acc)[8][4], int wr, int wc, int fr, int fq) {
#pragma unroll
            for (int mi = 0; mi < 8; ++mi) {
                const int r = wr * 128 + mi * 16 + fr;
                if (r < nvalid) {
                    const int slot = lst[r];
                    const float gt = a.gate[slot];
                    bf16_t* rp = a.contrib + (size_t)slot * 1024 + pn * 256 + wc * 64 + 4 * fq;
#pragma unroll
                    for (int ni = 0; ni < 4; ++ni) { const f32x4 v = acc[mi][ni] * gt; u32x2 o; o.x = pk2(v[0], v[1]); o.y = pk2(v[2], v[3]); *(u32x2*)(rp + ni * 16) = o; }
                }
            }
        });
    }
}
struct FinArgs { const float* pre2; const bf16_t* contrib; const float* g; const float* b; float* out; };
__device__ __forceinline__ void final_token(const FinArgs& A, int tok, int lane) {
    f32x4 v[4];
#pragma unroll
    for (int i = 0; i < 4; ++i) v[i] = *(const f32x4*)(A.pre2 + (size_t)tok * 1024 + i * 256 + lane * 4);
#pragma unroll
    for (int k = 0; k < 8; ++k) {
        const bf16_t* cp = A.contrib + ((size_t)tok * 8 + k) * 1024 + lane * 4;
#pragma unroll
        for (int i = 0; i < 4; ++i) {
            const u32x2 w = *(const u32x2*)(cp + i * 256);
            v[i][0] += bf2f(w.x & 0xffff); v[i][1] += bf2f(w.x >> 16); v[i][2] += bf2f(w.y & 0xffff); v[i][3] += bf2f(w.y >> 16);
        }
    }
    float s = 0.f;
#pragma unroll
    for (int i = 0; i < 4; ++i) s += (v[i][0] + v[i][1]) + (v[i][2] + v[i][3]);
    const float mu = wave_sum(s) * (1.f / 1024.f);
    float q = 0.f;
#pragma unroll
    for (int i = 0; i < 4; ++i) { const f32x4 d = v[i] - mu; q += (d[0] * d[0] + d[1] * d[1]) + (d[2] * d[2] + d[3] * d[3]); }
    const float rstd = rsqrtf(wave_sum(q) * (1.f / 1024.f) + 1e-5f);
#pragma unroll
    for (int i = 0; i < 4; ++i) {
        const f32x4 gg = *(const f32x4*)(A.g + i * 256 + lane * 4), bb = *(const f32x4*)(A.b + i * 256 + lane * 4);
        *(f32x4*)(A.out + (size_t)tok * 1024 + i * 256 + lane * 4) = (v[i] - mu) * rstd * gg + bb;
    }
}
__global__ __launch_bounds__(512, 2) void k_final2(FinArgs A) {
    const int lane = threadIdx.x & 63, wid = threadIdx.x >> 6;
    for (int tok = blockIdx.x * 8 + wid; tok < NT; tok += gridDim.x * 8) final_token(A, tok, lane);
}
}

extern "C" void kernel_launch(void* const* d_in, const int* in_sizes, int n_in, void* d_out, int out_size, void* d_ws, size_t ws_size, hipStream_t stream) {
    const float* x = (const float*)d_in[0];
    const float* w_in = (const float*)d_in[1];
    const float* att_norm_g = (const float*)d_in[2];
    const float* lam_re = (const float*)d_in[3];
    const float* lam_im = (const float*)d_in[4];
    const float* log_step = (const float*)d_in[5];
    const float* b_re = (const float*)d_in[6];
    const float* b_im = (const float*)d_in[7];
    const float* c_re = (const float*)d_in[8];
    const float* c_im = (const float*)d_in[9];
    const float* d_skip = (const float*)d_in[10];
    const float* w_glu = (const float*)d_in[11];
    const float* b_glu = (const float*)d_in[12];
    const float* ssm_norm_g = (const float*)d_in[13];
    const float* w_out = (const float*)d_in[14];
    const float* ln1_g = (const float*)d_in[15];
    const float* ln1_b = (const float*)d_in[16];
    const float* router_w = (const float*)d_in[17];
    const float* router_bias = (const float*)d_in[18];
    const float* w_gu = (const float*)d_in[19];
    const float* w_down = (const float*)d_in[20];
    const float* shared_w_gu = (const float*)d_in[21];
    const float* shared_w_down = (const float*)d_in[22];
    const float* ln2_g = (const float*)d_in[23];
    const float* ln2_b = (const float*)d_in[24];
    float* out = (float*)d_out;

    char* ws = (char*)d_ws; size_t off = 0;
    auto take = [&](size_t bytes) { char* p = ws + off; off += (bytes + 255) & ~(size_t)255; return p; };
    int* cnt = (int*)take(NE * sizeof(int));
    int* list = (int*)take((size_t)NE * CAP * sizeof(int));
    float* proj = (float*)take((size_t)NT * NPROJ * 4);
    float* oatt = (float*)take((size_t)NT * 512 * 4);
    float* yss = (float*)take((size_t)NT * 512 * 4);
    float* ossm = (float*)take((size_t)NT * 512 * 4);
    float* ycat = (float*)take((size_t)NT * 1024 * 4);
    float* pre1 = (float*)take((size_t)NT * 1024 * 4);
    float* h1 = (float*)take((size_t)NT * 1024 * 4);
    float* logits = (float*)take((size_t)NT * NE * 4);
    float* gate = (float*)take((size_t)NT * TOPK * 4);
    float* sgu = (float*)take((size_t)NT * 512 * 4);
    float* sact = (float*)take((size_t)NT * 256 * 4);
    float* pre2 = (float*)take((size_t)NT * 1024 * 4);
    float* act = (float*)take((size_t)NT * TOPK * 256 * 4);
    float* contrib = (float*)take((size_t)NT * TOPK * 1024 * 4);
    float* gu = contrib;

    (void)hipMemsetAsync(cnt, 0, NE * sizeof(int), stream);

    {
        bf16_t* xb = (bf16_t*)take((size_t)NT * 1024 * 2);
        bf16_t* w_inT = (bf16_t*)take((size_t)2048 * 1024 * 2);
        float* rope = (float*)take(2048 * 8 * 2 * 4);
        bf16_t* qb = (bf16_t*)take((size_t)NT * 512 * 2);
        bf16_t* kb = (bf16_t*)take((size_t)NT * 512 * 2);
        bf16_t* vb = (bf16_t*)take((size_t)NT * 512 * 2);
        bf16_t* ub = (bf16_t*)take((size_t)NT * 512 * 2);
        k_prologue<<<1024, 256, 0, stream>>>(ProArgs{x, w_in, xb, w_inT, rope});
        static bool attr_set = false;
        if (!attr_set) { (void)hipFuncSetAttribute((const void*)k_p1, hipFuncAttributeMaxDynamicSharedMemorySize, GT_LDS); attr_set = true; }
        k_p1<<<256, 512, GT_LDS, stream>>>(P1Args{xb, w_inT, rope, qb, kb, vb, ub});
        bf16_t* opart = (bf16_t*)take((size_t)3 * NT * 512 * 2);
        float* lse = (float*)take((size_t)3 * NT * 8 * 4);
        bf16_t* wendT = (bf16_t*)take((size_t)32 * 128 * 256 * 2);
        bf16_t* wcarT = (bf16_t*)take((size_t)32 * 256 * 128 * 2);
        bf16_t* klagT = (bf16_t*)take((size_t)32 * 16 * 256 * 2);
        float* a16 = (float*)take((size_t)32 * 64 * 2 * 4);
        bf16_t* w_gluT = (bf16_t*)take((size_t)512 * 512 * 2);
        bf16_t* yssb = (bf16_t*)take((size_t)NT * 512 * 2);
        bf16_t* ossmb = (bf16_t*)take((size_t)NT * 512 * 2);
        bf16_t* ycatb = (bf16_t*)take((size_t)NT * 1024 * 2);
        static bool attr2 = false;
        if (!attr2) {
            (void)hipFuncSetAttribute((const void*)k_attn2, hipFuncAttributeMaxDynamicSharedMemorySize, GT_LDS);
            (void)hipFuncSetAttribute((const void*)k_ssm2, hipFuncAttributeMaxDynamicSharedMemorySize, GT_LDS);
            (void)hipFuncSetAttribute((const void*)k_glu, hipFuncAttributeMaxDynamicSharedMemorySize, GT_LDS);
            attr2 = true;
        }
        k_ssmtab<<<256, 256, 0, stream>>>(SsmTabArgs{lam_re, lam_im, log_step, b_re, b_im, c_re, c_im, wendT, wcarT, klagT, a16}, w_glu, w_gluT);
        k_attn2<<<256, 512, GT_LDS, stream>>>(AttArgs{qb, kb, vb, opart, lse});
        k_ssm2<<<256, 512, GT_LDS, stream>>>(SsmArgs{ub, wendT, wcarT, klagT, a16, d_skip, yssb});
        k_glu<<<256, 512, GT_LDS, stream>>>(GluArgs{yssb, w_gluT, b_glu, ossmb});
        k_merge<<<256, 512, 0, stream>>>(MergeArgs{opart, lse, ossmb, att_norm_g, ssm_norm_g, ycatb});
        bf16_t* w_outT = (bf16_t*)take((size_t)1024 * 1024 * 2);
        bf16_t* rsT = (bf16_t*)take((size_t)768 * 1024 * 2);
        bf16_t* sdT = (bf16_t*)take((size_t)1024 * 256 * 2);
        bf16_t* h1b = (bf16_t*)take((size_t)NT * 1024 * 2);
        bf16_t* sactb = (bf16_t*)take((size_t)NT * 256 * 2);
        static bool attr3 = false;
        if (!attr3) {
            (void)hipFuncSetAttribute((const void*)k_wout, hipFuncAttributeMaxDynamicSharedMemorySize, GT_LDS);
            (void)hipFuncSetAttribute((const void*)k_rs, hipFuncAttributeMaxDynamicSharedMemorySize, GT_LDS);
            (void)hipFuncSetAttribute((const void*)k_sdown, hipFuncAttributeMaxDynamicSharedMemorySize, GT_LDS);
            attr3 = true;
        }
        k_pro3<<<256, 256, 0, stream>>>(Pro3Args{w_out, router_w, shared_w_gu, shared_w_down, w_outT, rsT, sdT});
        P3Args p3{ycatb, w_outT, x, pre1, ln1_g, ln1_b, h1b, rsT, logits, sactb, sdT, pre2};
        k_wout<<<256, 512, GT_LDS, stream>>>(p3);
        k_ln1<<<256, 512, 0, stream>>>(p3);
        k_rs<<<256, 512, GT_LDS, stream>>>(p3);
        k_sdown<<<256, 512, GT_LDS, stream>>>(p3);
        bf16_t* w_guT = (bf16_t*)take((size_t)256 * 512 * 1024 * 2);
        bf16_t* w_dnT = (bf16_t*)take((size_t)256 * 1024 * 256 * 2);
        bf16_t* actb = (bf16_t*)take((size_t)768 * 256 * 256 * 2);
        bf16_t* contribb = (bf16_t*)contrib;
        static bool attr4 = false;
        if (!attr4) {
            (void)hipFuncSetAttribute((const void*)k_moe_up, hipFuncAttributeMaxDynamicSharedMemorySize, GT_LDS + 2048);
            (void)hipFuncSetAttribute((const void*)k_moe_down, hipFuncAttributeMaxDynamicSharedMemorySize, GT_LDS + 2048);
            attr4 = true;
        }
        k_proexp<<<2048, 256, 0, stream>>>(w_gu, w_down, w_guT, w_dnT);
        k_route<<<NT, 64, 0, stream>>>(logits, router_bias, gate, cnt, list);
        MoeArgs ma{h1b, w_guT, w_dnT, cnt, list, gate, actb, contribb};
        k_moe_up<<<256, 512, GT_LDS + 2048, stream>>>(ma);
        k_moe_down<<<256, 512, GT_LDS + 2048, stream>>>(ma);
        k_final2<<<256, 512, 0, stream>>>(FinArgs{pre2, contribb, ln2_g, ln2_b, out});
    }

}
```

```cpp
#include <hip/hip_runtime.h>
#include <stdint.h>

namespace {
constexpr int B_ = 8, L_ = 2048, D_ = 1024, NT = B_ * L_;
constexpr int NE = 256, TOPK = 8;
constexpr int NSEG = 8, SEGCAP = 2048, CNT_STRIDE = 64;
constexpr float ALPHA = 1.189207115002721f;

__device__ __forceinline__ float gelu_tanh(float x) {
    const float z2 = 1.5957691216057308f * (x + 0.044715f * x * x * x);
    return x / (1.f + __expf(-z2));
}
__device__ __forceinline__ float wave_sum(float v) {
#pragma unroll
    for (int s = 32; s >= 1; s >>= 1) v += __shfl_xor(v, s);
    return v;
}
#define XB_TMO      128
#define XB_XCNT(j)  (256  + 64 * (j))
#define XB_XSUB(j)  (1280 + 64 * (j))
#define XB_XGEN(j)  (2304 + 64 * (j))
#define XB_TOP      3328
#define XB_TOPGEN   3392
#define XCD_BAR_WORDS 3456
#define XB_SPIN_CAP (1u << 18)
#define LAS __attribute__((address_space(3)))

__device__ __forceinline__ unsigned xb_ld(unsigned* p)              { return __hip_atomic_load(p, __ATOMIC_RELAXED, __HIP_MEMORY_SCOPE_AGENT); }
__device__ __forceinline__ unsigned xb_add(unsigned* p, unsigned v) { return __hip_atomic_fetch_add(p, v, __ATOMIC_RELAXED, __HIP_MEMORY_SCOPE_AGENT); }
__device__ __forceinline__ unsigned xb_xcc_id() { return (unsigned)__builtin_amdgcn_s_getreg((3 << 11) | 20) & 0xFu; }
#define XB_SPIN(cond, bar) do { unsigned _sp = 0; while (cond) { __builtin_amdgcn_s_sleep(1); \
    if ((++_sp & 255u) == 0u) { if (xb_ld(&(bar)[XB_TMO])) break; if (_sp > XB_SPIN_CAP) { atomicAdd(&(bar)[XB_TMO], 1u); break; } } } } while (0)

struct XcdBarrier {
    unsigned* bar; unsigned x;
    volatile LAS unsigned* st;
};

__device__ __forceinline__ XcdBarrier xcd_barrier_post(unsigned* bar, volatile LAS unsigned* st) {
    XcdBarrier b; b.bar = bar; b.x = xb_xcc_id(); b.st = st;
    if (threadIdx.x == 0) (void)xb_add(&bar[XB_XCNT(b.x)], 1u);
    return b;
}
__device__ __forceinline__ void xcd_barrier_complete(unsigned* bar, unsigned x, unsigned& nloc, unsigned& nx) {
    const unsigned G = gridDim.x * gridDim.y * gridDim.z;
    unsigned sum, cnt, mine, sp = 0u;
    for (;;) {
        sum = 0u; cnt = 0u; mine = 0u;
#pragma unroll
        for (unsigned j = 0; j < 16; ++j) { const unsigned c = xb_ld(&bar[XB_XCNT(j)]); sum += c; cnt += (c > 0u) ? 1u : 0u; mine = (j == x) ? c : mine; }
        if (sum == G) break;
        __builtin_amdgcn_s_sleep(1);
        if ((++sp & 255u) == 0u) { if (xb_ld(&bar[XB_TMO])) break; if (sp > XB_SPIN_CAP) { atomicAdd(&bar[XB_TMO], 1u); break; } }
    }
    nloc = mine > 0u ? mine : 1u; nx = cnt > 0u ? cnt : 1u;
}

__device__ __forceinline__ void xcd_barrier(const XcdBarrier& b) {
    asm volatile("s_waitcnt vmcnt(0)" ::: "memory");
    __syncthreads();
    if (threadIdx.x == 0) {
        unsigned* bar = b.bar;
        __builtin_amdgcn_s_waitcnt(0);
        unsigned nloc = b.st[0], nx = b.st[1];
        if (nloc == 0u) { xcd_barrier_complete(bar, b.x, nloc, nx); b.st[0] = nloc; b.st[1] = nx; }
        const unsigned old = xb_add(&bar[XB_XSUB(b.x)], 1u);
        const unsigned gen = old / nloc;
        if (old + 1u == (gen + 1u) * nloc) {
            __builtin_amdgcn_fence(__ATOMIC_RELEASE, "agent");
            asm volatile("s_waitcnt vmcnt(0)" ::: "memory");
            const unsigned og = xb_add(&bar[XB_TOP], 1u);
            const unsigned tg = og / nx;
            if (og + 1u == (tg + 1u) * nx) xb_add(&bar[XB_TOPGEN], 1u);
            else XB_SPIN(xb_ld(&bar[XB_TOPGEN]) == tg, bar);
            __builtin_amdgcn_fence(__ATOMIC_ACQUIRE, "agent");
            xb_add(&bar[XB_XGEN(b.x)], 1u);
            asm volatile("s_waitcnt vmcnt(0)" ::: "memory");
        } else {
            XB_SPIN(xb_ld(&bar[XB_XGEN(b.x)]) == gen, bar);
            __builtin_amdgcn_fence(__ATOMIC_ACQUIRE, "agent");
            asm volatile("s_waitcnt vmcnt(0)" ::: "memory");
        }
    }
    __syncthreads();
}


typedef unsigned short bf16_t;
typedef short bf16x8 __attribute__((ext_vector_type(8)));
typedef float f32x4 __attribute__((ext_vector_type(4)));
typedef unsigned u32x2 __attribute__((ext_vector_type(2)));
typedef unsigned u32x4 __attribute__((ext_vector_type(4)));
#define LDSP __attribute__((address_space(3)))
typedef short s16x4 __attribute__((ext_vector_type(4)));
__device__ __forceinline__ s16x4 vtr(const LDSP unsigned char* p) { return __builtin_bit_cast(s16x4, __builtin_amdgcn_ds_read_tr16_b64_v4i16((LDSP s16x4*)p)); }

__device__ __forceinline__ unsigned f2bf(float f) { unsigned u = __builtin_bit_cast(unsigned, f); return (u + 0x7fffu + ((u >> 16) & 1u)) >> 16; }
typedef float f32x2_t __attribute__((ext_vector_type(2))); typedef __bf16 bf16x2_t __attribute__((ext_vector_type(2)));
__device__ __forceinline__ unsigned pk2(float lo, float hi) { f32x2_t v = {lo, hi}; bf16x2_t b = __builtin_convertvector(v, bf16x2_t); return __builtin_bit_cast(unsigned, b); }
__device__ __forceinline__ float bf2f(unsigned short b) { return __builtin_bit_cast(float, (unsigned)b << 16); }
typedef int i32x4_t __attribute__((ext_vector_type(4))); typedef int i32x8_t __attribute__((ext_vector_type(8)));
constexpr float F8_SH = 4.f, F8_SW = 64.f, F8_SA = 8.f, F8_SC = 16.f;
__device__ __forceinline__ float f8clamp(float x) { return __builtin_amdgcn_fmed3f(x, -448.f, 448.f); }
__device__ __forceinline__ unsigned pk4f8(float a, float b, float c, float d) {
    unsigned w = 0;
    w = __builtin_amdgcn_cvt_pk_fp8_f32(f8clamp(a), f8clamp(b), w, false);
    w = __builtin_amdgcn_cvt_pk_fp8_f32(f8clamp(c), f8clamp(d), w, true);
    return w;
}
__device__ __forceinline__ f32x2_t f8lo(unsigned w) { return __builtin_amdgcn_cvt_pk_f32_fp8(w, false); }
__device__ __forceinline__ f32x2_t f8hi(unsigned w) { return __builtin_amdgcn_cvt_pk_f32_fp8(w, true); }
__device__ __forceinline__ void mfma_f8(f32x4& c, i32x8_t a, i32x8_t b) { asm volatile("v_mfma_f32_16x16x128_f8f6f4 %0, %1, %2, %0" : "+v"(c) : "v"(a), "v"(b)); }
__device__ __forceinline__ i32x8_t cat8(bf16x8 lo, bf16x8 hi) { return __builtin_shufflevector(__builtin_bit_cast(i32x4_t, lo), __builtin_bit_cast(i32x4_t, hi), 0, 1, 2, 3, 4, 5, 6, 7); }

struct RowId { __device__ __forceinline__ int operator()(int n) const { return n; } };
struct RowGU64 { __device__ __forceinline__ int operator()(int j) const { const int up = j >> 8, jj = j & 255; return (jj >> 5) * 64 + up * 32 + (jj & 31); } };
struct RowGU { __device__ __forceinline__ int operator()(int j) const { const int up = j >> 8, jj = j & 255; return (jj >> 7) * 256 + up * 128 + (jj & 127); } };
constexpr float QSCALE = 0.125f * 1.4426950408889634f;
struct ARowDense { const unsigned char* base; size_t ld; __device__ __forceinline__ const unsigned char* operator()(int r) const { return base + (size_t)r * ld; } };
typedef float f32x16 __attribute__((ext_vector_type(16)));
constexpr int ATT_UNITS = 3 * 64 * 64;
constexpr int ATT_VROW = 192, ATT_WLDS = 32 * ATT_VROW;
struct AttArgs { const bf16_t* q; const bf16_t* k; const bf16_t* v; bf16_t* opart; float* lse; };

__device__ __forceinline__ void attn_unit(const AttArgs& A, int u, LDSP unsigned char* vs, int lane) {
    const int c = u >> 12, rem = u & 4095, bh = rem >> 6, j = rem & 63;
    const int dsh = 2 * c, d = 1 << dsh, nblk = 64 >> dsh;
    const int r = j / nblk, a = j % nblk;
    const int l31 = lane & 31, h2 = lane >> 5;
    const bf16_t* Qb = A.q + (size_t)bh * 2048 * 64;
    const bf16_t* Kb = A.k + (size_t)bh * 2048 * 64;
    const bf16_t* Vb = A.v + (size_t)bh * 2048 * 64;
    const int sq = 32 * a + l31;
    const int tq = sq * d + r;
    bf16x8 qf[4];
    {
        const bf16_t* qp = Qb + (size_t)tq * 64 + 8 * h2;
#pragma unroll
        for (int s = 0; s < 4; ++s) qf[s] = *(const bf16x8*)(qp + 16 * s);
    }
    bf16x8 kf[5][4];
#pragma unroll
    for (int kt = 0; kt < 5; ++kt) {
        const int k0 = 32 * a - 128 + 32 * kt;
        const int kr = k0 >= 0 ? k0 + l31 : 0;
        const bf16_t* kp = Kb + (size_t)(kr * d + r) * 64 + 8 * h2;
#pragma unroll
        for (int s = 0; s < 4; ++s) kf[kt][s] = *(const bf16x8*)(kp + 16 * s);
    }
    u32x4 vreg[4];
#define ATT_VLOAD(kt_) do { const int k0_ = 32 * a - 128 + 32 * (kt_); _Pragma("unroll") for (int i = 0; i < 4; ++i) { const int id = lane + 64 * i, row = id >> 3, ch = id & 7; \
        const int vr_ = k0_ >= 0 ? k0_ + row : 0; vreg[i] = *(const u32x4*)(Vb + (size_t)(vr_ * d + r) * 64 + ch * 8); } } while (0)
    ATT_VLOAD(0);
    f32x16 S[5];
#pragma unroll
    for (int kt = 0; kt < 5; ++kt) {
        const int k0 = 32 * a - 128 + 32 * kt;
        f32x16 acc;
#pragma unroll
        for (int i = 0; i < 16; ++i) acc[i] = 0.f;
#pragma unroll
        for (int s = 0; s < 4; ++s) acc = __builtin_amdgcn_mfma_f32_32x32x16_bf16(kf[kt][s], qf[s], acc, 0, 0, 0);
        if (kt == 0 || kt == 4) {
#pragma unroll
            for (int i = 0; i < 16; ++i) {
                const int keyrow = (i & 3) + 8 * (i >> 2) + 4 * h2;
                const int dist = sq - (k0 + keyrow);
                if (dist < 0 || dist > 128) acc[i] = -INFINITY;
            }
        }
        if (k0 < 0) {
#pragma unroll
            for (int i = 0; i < 16; ++i) acc[i] = -INFINITY;
        }
        S[kt] = acc;
    }
    float m = -INFINITY;
#pragma unroll
    for (int kt = 0; kt < 5; ++kt)
#pragma unroll
        for (int i = 0; i < 16; ++i) m = fmaxf(m, S[kt][i]);
    m = fmaxf(m, __shfl_xor(m, 32));
    float l = 0.f;
#pragma unroll
    for (int kt = 0; kt < 5; ++kt)
#pragma unroll
        for (int i = 0; i < 16; ++i) { const float p = exp2f(S[kt][i] - m); S[kt][i] = p; l += p; }
    l += __shfl_xor(l, 32);
    f32x16 O[2];
#pragma unroll
    for (int dt = 0; dt < 2; ++dt)
#pragma unroll
        for (int i = 0; i < 16; ++i) O[dt][i] = 0.f;
    const int g = lane >> 4, li = lane & 15;
    const LDSP unsigned char* vrd = vs + (4 * (g >> 1) + (li >> 2)) * ATT_VROW + (16 * (g & 1) + 4 * (li & 3)) * 2;
#pragma unroll
    for (int kt = 0; kt < 5; ++kt) {
#pragma unroll
        for (int i = 0; i < 4; ++i) { const int id = lane + 64 * i, row = id >> 3, ch = id & 7; *(LDSP u32x4*)(vs + row * ATT_VROW + ch * 16) = vreg[i]; }
        if (kt < 4) ATT_VLOAD(kt + 1);
#pragma unroll
        for (int sp = 0; sp < 2; ++sp) {
            bf16x8 pf;
            {
                u32x4 w;
                w.x = pk2(S[kt][8 * sp + 0], S[kt][8 * sp + 1]); w.y = pk2(S[kt][8 * sp + 2], S[kt][8 * sp + 3]);
                w.z = pk2(S[kt][8 * sp + 4], S[kt][8 * sp + 5]); w.w = pk2(S[kt][8 * sp + 6], S[kt][8 * sp + 7]);
                pf = __builtin_bit_cast(bf16x8, w);
            }
#pragma unroll
            for (int dt = 0; dt < 2; ++dt) {
                const s16x4 lo = vtr(vrd + (16 * sp) * ATT_VROW + dt * 64);
                const s16x4 hi = vtr(vrd + (16 * sp + 8) * ATT_VROW + dt * 64);
                const bf16x8 vf = (bf16x8){lo[0], lo[1], lo[2], lo[3], hi[0], hi[1], hi[2], hi[3]};
                O[dt] = __builtin_amdgcn_mfma_f32_32x32x16_bf16(vf, pf, O[dt], 0, 0, 0);
            }
        }
    }
#undef ATT_VLOAD
    const float il = 1.f / l;
    const int b = bh >> 3, h = bh & 7;
    const size_t tok = (size_t)b * 2048 + tq;
    bf16_t* op = A.opart + ((size_t)c * NT + tok) * 512 + h * 64 + 4 * h2;
#pragma unroll
    for (int dt = 0; dt < 2; ++dt)
#pragma unroll
        for (int g4 = 0; g4 < 4; ++g4) {
            u32x2 w; w.x = pk2(O[dt][4 * g4 + 0] * il, O[dt][4 * g4 + 1] * il); w.y = pk2(O[dt][4 * g4 + 2] * il, O[dt][4 * g4 + 3] * il);
            *(u32x2*)(op + 32 * dt + 8 * g4) = w;
        }
    if (h2 == 0) A.lse[((size_t)c * NT + tok) * 8 + h] = m + log2f(l);
}
constexpr int AW_UNITS = 3 * 64 * 8, AW_KP = 144, AW_VP = 192, AW_KBYTES = 384 * AW_KP;
struct AwPre { u32x4 k[6], v[6]; bf16x8 q[4]; };
__device__ __forceinline__ int aw_key_token(int c, int j, int kk) {
    if (c == 2) { const int rr = (kk >> 7) & 1, ks = kk & 127; return ks * 16 + 2 * j + rr; }
    const int d = c ? 4 : 1, r = c ? (j >> 1) : 0, A = c ? (j & 1) : j;
    int ks = 256 * A - 128 + kk; ks = ks < 0 ? 0 : ks;
    return ks * d + r;
}
__device__ __forceinline__ void aw_wave_coords(int c, int j, int w, int l31, int& d, int& r, int& sq, int& k00, int& lrow00) {
    if (c == 2) { const int rr = w >> 2, a = w & 3; d = 16; r = 2 * j + rr; sq = 32 * a + l31; k00 = 32 * a - 128; lrow00 = rr * 128 + k00; }
    else { d = c ? 4 : 1; r = c ? (j >> 1) : 0; const int A = c ? (j & 1) : j; sq = 256 * A + 32 * w + l31; k00 = 256 * A + 32 * w - 128; lrow00 = 32 * w; }
}
__device__ __forceinline__ void aw_prefetch(const AttArgs& A, int U, AwPre& P, int tid) {
    const int c = U >> 9, rem = U & 511, bh = rem >> 3, j = rem & 7;
    const bf16_t* Kb = A.k + (size_t)bh * 2048 * 64; const bf16_t* Vb = A.v + (size_t)bh * 2048 * 64;
    const int ch = tid & 7, row0 = tid >> 3;
#pragma unroll
    for (int i = 0; i < 6; ++i) {
        const size_t off = (size_t)aw_key_token(c, j, row0 + 64 * i) * 64 + ch * 8;
        P.k[i] = *(const u32x4*)(Kb + off); P.v[i] = *(const u32x4*)(Vb + off);
    }
    const int lane = tid & 63, w = tid >> 6, l31 = lane & 31, h2 = lane >> 5;
    int d, r, sq, k00, lrow00; aw_wave_coords(c, j, w, l31, d, r, sq, k00, lrow00);
    const bf16_t* qp = A.q + ((size_t)bh * 2048 + (size_t)sq * d + r) * 64 + 8 * h2;
#pragma unroll
    for (int s_ = 0; s_ < 4; ++s_) P.q[s_] = *(const bf16x8*)(qp + 16 * s_);
}
__device__ __forceinline__ void aw_stage(const AwPre& P, LDSP unsigned char* lds, int tid) {
    const int ch = tid & 7, row0 = tid >> 3;
#pragma unroll
    for (int i = 0; i < 6; ++i) {
        *(LDSP u32x4*)(lds + (row0 + 64 * i) * AW_KP + ch * 16) = P.k[i];
        *(LDSP u32x4*)(lds + AW_KBYTES + (row0 + 64 * i) * AW_VP + ch * 16) = P.v[i];
    }
}
__device__ __forceinline__ void aw_compute(const AttArgs& A, int U, const bf16x8 (&qf)[4], const LDSP unsigned char* lds, int tid) {
    const int c = U >> 9, rem = U & 511, bh = rem >> 3, j = rem & 7;
    const int lane = tid & 63, w = __builtin_amdgcn_readfirstlane(tid >> 6), l31 = lane & 31, h2 = lane >> 5;
    int d, r, sq, k00, lrow00; aw_wave_coords(c, j, w, l31, d, r, sq, k00, lrow00);
    const int tq = sq * d + r;
    f32x16 S[5];
#pragma unroll
    for (int kt = 0; kt < 5; ++kt) {
        const int k0 = k00 + 32 * kt;
        int lrow = lrow00 + 32 * kt; lrow = lrow < 0 ? 0 : lrow;
        const LDSP unsigned char* kp = lds + (lrow + l31) * AW_KP + 16 * h2;
        f32x16 acc;
#pragma unroll
        for (int i = 0; i < 16; ++i) acc[i] = 0.f;
#pragma unroll
        for (int s_ = 0; s_ < 4; ++s_) acc = __builtin_amdgcn_mfma_f32_32x32x16_bf16(*(const LDSP bf16x8*)(kp + 32 * s_), qf[s_], acc, 0, 0, 0);
        if (kt == 0 || kt == 4) {
#pragma unroll
            for (int i = 0; i < 16; ++i) {
                const int keyrow = (i & 3) + 8 * (i >> 2) + 4 * h2;
                const int dist = sq - (k0 + keyrow);
                if (dist < 0 || dist > 128) acc[i] = -INFINITY;
            }
        }
        if (k0 < 0) {
#pragma unroll
            for (int i = 0; i < 16; ++i) acc[i] = -INFINITY;
        }
        S[kt] = acc;
    }
    float m = -INFINITY;
#pragma unroll
    for (int kt = 0; kt < 5; ++kt)
#pragma unroll
        for (int i = 0; i < 16; ++i) m = fmaxf(m, S[kt][i]);
    m = fmaxf(m, __shfl_xor(m, 32));
    float l = 0.f;
#pragma unroll
    for (int kt = 0; kt < 5; ++kt)
#pragma unroll
        for (int i = 0; i < 16; ++i) { const float pe = exp2f(S[kt][i] - m); S[kt][i] = pe; l += pe; }
    l += __shfl_xor(l, 32);
    f32x16 O[2];
#pragma unroll
    for (int dt = 0; dt < 2; ++dt)
#pragma unroll
        for (int i = 0; i < 16; ++i) O[dt][i] = 0.f;
    const int g = lane >> 4, li = lane & 15;
    const int vro = (4 * (g >> 1) + (li >> 2)) * AW_VP + (16 * (g & 1) + 4 * (li & 3)) * 2;
#pragma unroll
    for (int kt = 0; kt < 5; ++kt) {
        int lrow = lrow00 + 32 * kt; lrow = lrow < 0 ? 0 : lrow;
        const LDSP unsigned char* vrd = lds + AW_KBYTES + lrow * AW_VP + vro;
#pragma unroll
        for (int sp = 0; sp < 2; ++sp) {
            bf16x8 pf;
            {
                u32x4 w4;
                w4.x = pk2(S[kt][8 * sp + 0], S[kt][8 * sp + 1]); w4.y = pk2(S[kt][8 * sp + 2], S[kt][8 * sp + 3]);
                w4.z = pk2(S[kt][8 * sp + 4], S[kt][8 * sp + 5]); w4.w = pk2(S[kt][8 * sp + 6], S[kt][8 * sp + 7]);
                pf = __builtin_bit_cast(bf16x8, w4);
            }
#pragma unroll
            for (int dt = 0; dt < 2; ++dt) {
                const s16x4 lo = vtr(vrd + (16 * sp) * AW_VP + dt * 64);
                const s16x4 hi = vtr(vrd + (16 * sp + 8) * AW_VP + dt * 64);
                const bf16x8 vf = (bf16x8){lo[0], lo[1], lo[2], lo[3], hi[0], hi[1], hi[2], hi[3]};
                O[dt] = __builtin_amdgcn_mfma_f32_32x32x16_bf16(vf, pf, O[dt], 0, 0, 0);
            }
        }
    }
    const float il = 1.f / l;
    const int b = bh >> 3, h = bh & 7;
    const size_t tok = (size_t)b * 2048 + tq;
    bf16_t* op = A.opart + ((size_t)c * NT + tok) * 512 + h * 64 + 4 * h2;
#pragma unroll
    for (int dt = 0; dt < 2; ++dt)
#pragma unroll
        for (int g4 = 0; g4 < 4; ++g4) {
            u32x2 w2; w2.x = pk2(O[dt][4 * g4 + 0] * il, O[dt][4 * g4 + 1] * il); w2.y = pk2(O[dt][4 * g4 + 2] * il, O[dt][4 * g4 + 3] * il);
            *(u32x2*)(op + 32 * dt + 8 * g4) = w2;
        }
    if (h2 == 0) A.lse[((size_t)c * NT + tok) * 8 + h] = m + log2f(l);
}
struct SsmTabArgs { const float* lam_re; const float* lam_im; const float* log_step; const float* b_re; const float* b_im; const float* c_re; const float* c_im;
                    bf16_t* wendT; bf16_t* wcarT; bf16_t* klagT; float* a16; };
__device__ __forceinline__ void ssm_apow(const SsmTabArgs& A, int g, int p, float k, float& pr, float& pi) {
    const float lr = A.lam_re[g * 64 + p], li = A.lam_im[g * 64 + p], step = expf(A.log_step[g]);
    const float e = expf(k * lr * step); pr = e * cosf(k * li * step); pi = e * sinf(k * li * step);
}
__device__ __forceinline__ void ssm_coef(const SsmTabArgs& A, int g, int p, float& cr, float& ci) {
    const float lr = A.lam_re[g * 64 + p], li = A.lam_im[g * 64 + p];
    float ar, ai; ssm_apow(A, g, p, 1.f, ar, ai);
    const float nr = ar - 1.f, ni = ai, den = lr * lr + li * li;
    cr = (nr * lr + ni * li) / den; ci = (ni * lr - nr * li) / den;
}
__device__ __forceinline__ size_t ft_off(int n, int k, int K) { return ((size_t)((n >> 4) * (K >> 5) + (k >> 5)) << 9) + (((k >> 3) & 3) << 7) + ((n & 15) << 3) + (k & 7); }
__device__ __forceinline__ void ssm_tab_item(const SsmTabArgs& A, int it) {
    if (it < 32768) {
        const int s = it & 15, p = (it >> 4) & 63, g = it >> 10;
        float pr, pi, cr, ci; ssm_apow(A, g, p, (float)(15 - s), pr, pi); ssm_coef(A, g, p, cr, ci);
        const float mr = pr * cr - pi * ci, mi = pr * ci + pi * cr;
        bf16_t* wb = A.wendT + (size_t)g * 128 * 256;
#pragma unroll
        for (int c = 0; c < 16; ++c) {
            const float br = A.b_re[((size_t)g * 64 + p) * 16 + c], bi = A.b_im[((size_t)g * 64 + p) * 16 + c];
            wb[ft_off(p, s * 16 + c, 256)] = (bf16_t)f2bf(mr * br - mi * bi); wb[ft_off(64 + p, s * 16 + c, 256)] = (bf16_t)f2bf(mr * bi + mi * br);
        }
    } else if (it < 65536) {
        const int j = it - 32768; const int t = j & 15, p = (j >> 4) & 63, g = j >> 10;
        float pr, pi; ssm_apow(A, g, p, (float)(t + 1), pr, pi);
#pragma unroll
        for (int co = 0; co < 16; ++co) {
            const float cr = A.c_re[((size_t)g * 16 + co) * 64 + p], ci = A.c_im[((size_t)g * 16 + co) * 64 + p];
            bf16_t* wb = A.wcarT + (size_t)g * 256 * 128;
            wb[ft_off(t * 16 + co, p, 128)] = (bf16_t)f2bf(cr * pr - ci * pi); wb[ft_off(t * 16 + co, 64 + p, 128)] = (bf16_t)f2bf(-(cr * pi + ci * pr));
        }
    } else {
        const int j = it - 65536; const int p = j & 63, g = j >> 6;
        float pr, pi; ssm_apow(A, g, p, 16.f, pr, pi);
        A.a16[(size_t)j * 2] = pr; A.a16[(size_t)j * 2 + 1] = pi;
    }
}
constexpr int SSM_TAB_ITEMS = 65536 + 2048;
__device__ __forceinline__ void ssm_klag_item(const SsmTabArgs& A, int it, LDSP float* scr, int tid) {
    const int g = it >> 4, lag = it & 15;
    LDSP float* Mr = scr; LDSP float* Mi = scr + 1024; LDSP float* Cr = scr + 2048; LDSP float* Ci = scr + 3072;
    __syncthreads();
    if (tid < 64) {
        const int p = tid; float pr, pi, cr, ci; ssm_apow(A, g, p, (float)lag, pr, pi); ssm_coef(A, g, p, cr, ci);
        const float mr = pr * cr - pi * ci, mi = pr * ci + pi * cr;
#pragma unroll
        for (int c = 0; c < 16; ++c) {
            const float br = A.b_re[((size_t)g * 64 + p) * 16 + c], bi = A.b_im[((size_t)g * 64 + p) * 16 + c];
            Mr[p * 16 + c] = mr * br - mi * bi; Mi[p * 16 + c] = mr * bi + mi * br;
            Cr[p * 16 + c] = A.c_re[((size_t)g * 16 + c) * 64 + p]; Ci[p * 16 + c] = A.c_im[((size_t)g * 16 + c) * 64 + p];
        }
    }
    __syncthreads();
    if (tid < 256) {
        const int co = tid >> 4, ci_ = tid & 15; float acc = 0.f;
        for (int p = 0; p < 64; ++p) acc += Cr[p * 16 + co] * Mr[p * 16 + ci_] - Ci[p * 16 + co] * Mi[p * 16 + ci_];
        A.klagT[(((size_t)g * 16 + lag) * 16 + co) * 16 + ci_] = (bf16_t)f2bf(acc);
    }
}

struct SsmArgs { const bf16_t* u; const bf16_t* wendT; const bf16_t* wcarT; const bf16_t* klagT; const float* a16; const float* d_skip; bf16_t* yss; };
__device__ __forceinline__ void ssm_stage_u(LDSP unsigned char* lds, const bf16_t* ubase  , int hh, int tid) {
#pragma unroll
    for (int i = 0; i < 4; ++i) {
        const int id = tid + 512 * i, row = id >> 5, ch = id & 31;
        const u32x4 w = *(const u32x4*)(ubase + (size_t)(64 * hh + row) * 256 + ch * 8);
        *(LDSP u32x4*)(lds + (ch >> 3) * 8192 + row * 128 + (((ch & 7) ^ (row & 7)) * 16)) = w;
    }
}
__device__ __forceinline__ void ssm_unit(const SsmArgs& A, int bg, LDSP unsigned char* lds) {
    const int tid = threadIdx.x, lane = tid & 63, w = __builtin_amdgcn_readfirstlane(tid >> 6), fr = lane & 15, fq = lane >> 4;
    const int g = bg & 31, b = bg >> 5;
    const bf16_t* ubase = A.u + (size_t)bg * 2048 * 16;
    LDSP unsigned char* Ebuf = lds + 32768; LDSP unsigned char* Xbuf = lds + 98304;
    const bf16_t* wend = A.wendT + (size_t)g * 128 * 256;
    const bf16_t* wcar = A.wcarT + (size_t)g * 256 * 128;
    const bf16_t* klag = A.klagT + (size_t)g * 16 * 256;
    for (int hh = 0; hh < 2; ++hh) {
        __syncthreads();
        ssm_stage_u(lds, ubase, hh, tid);
        __syncthreads();
        f32x4 acc[4];
#pragma unroll
        for (int mi = 0; mi < 4; ++mi) acc[mi] = (f32x4){0.f, 0.f, 0.f, 0.f};
#pragma unroll
        for (int kk = 0; kk < 8; ++kk) {
            const bf16x8 wf = *(const bf16x8*)(wend + ((size_t)(w * 8 + kk) << 9) + lane * 8);
#pragma unroll
            for (int mi = 0; mi < 4; ++mi) {
                const bf16x8 af = *(const LDSP bf16x8*)(lds + (kk >> 1) * 8192 + (16 * mi + fr) * 128 + (((((kk & 1) * 4) + fq) ^ (fr & 7)) * 16));
                acc[mi] = __builtin_amdgcn_mfma_f32_16x16x32_bf16(wf, af, acc[mi], 0, 0, 0);
            }
        }
#pragma unroll
        for (int mi = 0; mi < 4; ++mi) *(LDSP f32x4*)(Ebuf + ((64 * hh + 16 * mi + fr) * 128 + 16 * w + 4 * fq) * 4) = acc[mi];
    }
    __syncthreads();
    {
        const float ar = A.a16[((size_t)g * 64 + lane) * 2], ai = A.a16[((size_t)g * 64 + lane) * 2 + 1];
        LDSP float* Tb = (LDSP float*)(lds + 131072);
        float Lr[16], Li[16];
        float cr = 0.f, ci = 0.f;
#pragma unroll
        for (int j = 0; j < 16; ++j) {
            const int c = 16 * w + j;
            const float er = *(const LDSP float*)(Ebuf + (c * 128 + lane) * 4), ei = *(const LDSP float*)(Ebuf + (c * 128 + 64 + lane) * 4);
            Lr[j] = cr; Li[j] = ci;
            const float nr = ar * cr - ai * ci + er, ni = ar * ci + ai * cr + ei;
            cr = nr; ci = ni;
        }
        Tb[w * 128 + lane] = cr; Tb[w * 128 + 64 + lane] = ci;
        float pr = ar, pi = ai;
#pragma unroll
        for (int q = 0; q < 4; ++q) { const float tr = pr * pr - pi * pi, ti = 2.f * pr * pi; pr = tr; pi = ti; }
        __syncthreads();
        float gr = 0.f, gi = 0.f;
        for (int v = 0; v < w; ++v) {
            const float tr = Tb[v * 128 + lane], ti = Tb[v * 128 + 64 + lane];
            const float nr = pr * gr - pi * gi + tr, ni = pr * gi + pi * gr + ti;
            gr = nr; gi = ni;
        }
        const int xo = (lane >> 3), xb = (lane & 7) * 2;
        float qr = 1.f, qi = 0.f;
#pragma unroll
        for (int j = 0; j < 16; ++j) {
            const int c = 16 * w + j;
            const float xr = Lr[j] + qr * gr - qi * gi, xi = Li[j] + qr * gi + qi * gr;
            const int off = c * 128 + ((xo ^ (c & 7)) * 16) + xb;
            *(LDSP bf16_t*)(Xbuf + off) = (bf16_t)f2bf(xr);
            *(LDSP bf16_t*)(Xbuf + 16384 + off) = (bf16_t)f2bf(xi);
            const float tr = qr * ar - qi * ai, ti = qr * ai + qi * ar; qr = tr; qi = ti;
        }
    }
    __syncthreads();
    for (int hx = 0; hx < 2; ++hx) {
        const int hh = 1 - hx;
        if (hx == 1) { __syncthreads(); ssm_stage_u(lds, ubase, hh, tid); __syncthreads(); }
        f32x4 acc[4][2];
#pragma unroll
        for (int mi = 0; mi < 4; ++mi) { acc[mi][0] = (f32x4){0.f, 0.f, 0.f, 0.f}; acc[mi][1] = (f32x4){0.f, 0.f, 0.f, 0.f}; }
#pragma unroll
        for (int j = 0; j < 2; ++j) {
            const int t = j ? (15 - w) : w;
#pragma unroll
            for (int kk = 0; kk < 8; ++kk) {
                if (2 * kk <= t) {
                    const int s = 2 * kk + (fq >> 1);
                    bf16x8 wf = (bf16x8){0, 0, 0, 0, 0, 0, 0, 0};
                    if (s <= t) wf = *(const bf16x8*)(klag + ((size_t)(t - s) * 16 + fr) * 16 + 8 * (fq & 1));
#pragma unroll
                    for (int mi = 0; mi < 4; ++mi) {
                        const bf16x8 af = *(const LDSP bf16x8*)(lds + (kk >> 1) * 8192 + (16 * mi + fr) * 128 + (((((kk & 1) * 4) + fq) ^ (fr & 7)) * 16));
                        acc[mi][j] = __builtin_amdgcn_mfma_f32_16x16x32_bf16(wf, af, acc[mi][j], 0, 0, 0);
                    }
                }
            }
#pragma unroll
            for (int k2 = 0; k2 < 4; ++k2) {
                const bf16x8 wf = *(const bf16x8*)(wcar + ((size_t)(t * 4 + k2) << 9) + lane * 8);
#pragma unroll
                for (int mi = 0; mi < 4; ++mi) {
                    const int row = 64 * hh + 16 * mi + fr;
                    const bf16x8 xf = *(const LDSP bf16x8*)(Xbuf + (k2 >> 1) * 16384 + row * 128 + (((((k2 & 1) * 4) + fq) ^ (fr & 7)) * 16));
                    acc[mi][j] = __builtin_amdgcn_mfma_f32_16x16x32_bf16(wf, xf, acc[mi][j], 0, 0, 0);
                }
            }
        }
        const float4 dk = *(const float4*)(A.d_skip + g * 16 + 4 * fq);
#pragma unroll
        for (int j = 0; j < 2; ++j) {
            const int t = j ? (15 - w) : w;
#pragma unroll
            for (int mi = 0; mi < 4; ++mi) {
                const int tt = (64 * hh + 16 * mi + fr) * 16 + t;
                const u32x2 uw = *(const u32x2*)(ubase + (size_t)tt * 16 + 4 * fq);
                const f32x4 a = acc[mi][j];
                const float y0 = gelu_tanh(a[0] + dk.x * bf2f(uw.x & 0xffff)), y1 = gelu_tanh(a[1] + dk.y * bf2f(uw.x >> 16));
                const float y2 = gelu_tanh(a[2] + dk.z * bf2f(uw.y & 0xffff)), y3 = gelu_tanh(a[3] + dk.w * bf2f(uw.y >> 16));
                u32x2 o; o.x = pk2(y0, y1); o.y = pk2(y2, y3);
                *(u32x2*)(A.yss + ((size_t)b * 2048 + tt) * 512 + g * 16 + 4 * fq) = o;
            }
        }
    }
}
__device__ __forceinline__ float silu_f(float g) { return g / (1.f + __expf(-g)); }
constexpr int ME_LDS = 147456;
namespace pg {
constexpr int BM = 256, BK = 64, HALF = 128, HTB = HALF * BK * 2, STAGE_BYTES = 8 * HTB;
constexpr int VA_SLOT_OFF = 151552;
__device__ __forceinline__ int lds_byte(int r, int c) { const int st = (r >> 4) * 2 + (c >> 5), rr = r & 15, cc = c & 31, ob = rr * 64 + cc * 2; return st * 1024 + (ob ^ (((ob >> 9) & 1) << 5)); }
__device__ __forceinline__ void stage_rc(int b, int& R, int& C) { const int st = b / 1024, sb = b % 1024, swz = sb ^ (((sb >> 9) & 1) << 5); R = (st >> 1) * 16 + swz / 64; C = (st & 1) * 32 + (swz % 64) / 2; }
struct Unit { const char* A; const char* B; int x0, x1, x2, x3; };
struct LaneRC { int R0, C0, R1, C1; };
__device__ __forceinline__ LaneRC lane_rc() { LaneRC l; stage_rc(threadIdx.x * 16, l.R0, l.C0); stage_rc(threadIdx.x * 16 + 8192, l.R1, l.C1); return l; }
__device__ __forceinline__ LaneRC lane_rc_fresh() { int t = threadIdx.x; asm volatile("" : "+v"(t)); LaneRC l; stage_rc(t * 16, l.R0, l.C0); stage_rc(t * 16 + 8192, l.R1, l.C1); return l; }
struct VA { unsigned v00, v01, v10, v11; };
__device__ __forceinline__ VA dense_va(unsigned lda  ) {
    const LaneRC l = lane_rc(); VA v;
    v.v00 = l.R0 * lda + l.C0 * 2; v.v01 = l.R1 * lda + l.C1 * 2; v.v10 = (128 + l.R0) * lda + l.C0 * 2; v.v11 = (128 + l.R1) * lda + l.C1 * 2; return v;
}
__device__ __forceinline__ int perm32(int rho) { const int n = rho >> 4, i = rho & 15; return 8 * (i >> 2) + 4 * n + (i & 3); }
__device__ __forceinline__ int ragged_row(int h, int R) { return 16 * (2 * (4 * h + ((R >> 4) & 3)) + (R >> 6)) + (R & 15); }
template <bool GATHER, int PERM, bool RAGGED, bool F8, class Sched, class Epi>
__device__ __forceinline__ void gemm_phase(LDSP unsigned char* lds, const int K, const Sched& S, const Epi& E) {
    const int tid = threadIdx.x, wid = __builtin_amdgcn_readfirstlane(tid >> 6), lane = tid & 63, wr = wid >> 2, wc = wid & 3, fr = lane & 15, fq = lane >> 4;
    const int nt = K / BK;
    unsigned voffB[2];
    { int R, C; stage_rc(tid * 16, R, C); if (PERM == 1) R = (R & ~31) + perm32(R & 31); if (PERM == 2) R = 64 * (R >> 5) + 16 * ((R >> 2) & 3) + 4 * ((R >> 4) & 1) + (R & 3); voffB[0] = (unsigned)(R * K + C) * 2u;
      stage_rc(tid * 16 + 8192, R, C); if (PERM == 1) R = (R & ~31) + perm32(R & 31); if (PERM == 2) R = 64 * (R >> 5) + 16 * ((R >> 2) & 3) + 4 * ((R >> 4) & 1) + (R & 3); voffB[1] = (unsigned)(R * K + C) * 2u; }
    const size_t kstep = (size_t)(BK * 2), hstepB = (size_t)(PERM == 2 ? 8 : HALF) * K * 2;
    const unsigned ldsw = (unsigned)wid * 1024u;
    const int aoff = lds_byte(wr * 64 + fr, fq * 8), boff = lds_byte(wc * 32 + fr, fq * 8);
#define PG_SA(b, h) (((b) * 2 + (h)) * HTB)
#define PG_SB(b, h) ((4 + (b) * 2 + (h)) * HTB)
#define PG_STAGE(bufoff, gbase, v0, v1) do { \
        __builtin_amdgcn_global_load_lds((const unsigned*)((const char*)(gbase) + (v0)), (LDSP unsigned*)(lds + (bufoff) + ldsw), 16, 0, 0); \
        __builtin_amdgcn_global_load_lds((const unsigned*)((const char*)(gbase) + (v1)), (LDSP unsigned*)(lds + (bufoff) + ldsw + 8192), 16, 0, 0); } while (0)
#define PG_LDA(dst, b, h) do { _Pragma("unroll") for (int m = 0; m < 4; ++m) _Pragma("unroll") for (int k = 0; k < 2; ++k) dst[m][k] = *(const LDSP bf16x8*)(lds + PG_SA(b, h) + aoff + m * 2048 + k * 1024); } while (0)
#define PG_LDB(dst, b, h) do { _Pragma("unroll") for (int n = 0; n < 2; ++n) _Pragma("unroll") for (int k = 0; k < 2; ++k) dst[n][k] = *(const LDSP bf16x8*)(lds + PG_SB(b, h) + boff + n * 2048 + k * 1024); } while (0)
#define PG_MMA(ai, bj, At, Bt, ML) do { __builtin_amdgcn_s_setprio(1); _Pragma("unroll") for (int m = 0; m < (ML); ++m) { _Pragma("unroll") for (int n = 0; n < 2; ++n) { \
        if constexpr (F8) mfma_f8(acc[ai][bj][m][n], cat8(Bt[n][0], Bt[n][1]), cat8(At[m][0], At[m][1])); \
        else { _Pragma("unroll") for (int k = 0; k < 2; ++k) acc[ai][bj][m][n] = __builtin_amdgcn_mfma_f32_16x16x32_bf16(Bt[n][k], At[m][k], acc[ai][bj][m][n], 0, 0, 0); } } } __builtin_amdgcn_s_setprio(0); } while (0)
#define PG_WAIT_V(n) asm volatile("s_waitcnt vmcnt(" #n ")" ::: "memory")
#define PG_WAIT_L(n) asm volatile("s_waitcnt lgkmcnt(" #n ")" ::: "memory")
#define PG_BAR __builtin_amdgcn_s_barrier()
#define PG_SCHED __builtin_amdgcn_sched_barrier(0)
    Unit cur, nxt; int ui = 0;
    if (!S.next(0, cur)) return;
    f32x4 acc[2][2][4][2];
#pragma unroll
    for (int a = 0; a < 2; ++a)
#pragma unroll
        for (int b = 0; b < 2; ++b)
#pragma unroll
            for (int m = 0; m < 4; ++m)
#pragma unroll
                for (int n = 0; n < 2; ++n) acc[a][b][m][n] = (f32x4){0.f, 0.f, 0.f, 0.f};
    bf16x8 At[4][2], B0[2][2], B1[2][2];
    const char* cA = cur.A; const char* cB = cur.B;
    int nvc = RAGGED ? cur.x1 : 256;
    VA cva = S.va(cur);
    PG_STAGE(PG_SB(0, 0), cB, voffB[0], voffB[1]); PG_STAGE(PG_SB(0, 1), cB + hstepB, voffB[0], voffB[1]);
    PG_STAGE(PG_SA(0, 0), cA, cva.v00, cva.v01); PG_STAGE(PG_SA(0, 1), cA, cva.v10, cva.v11);
    if (wr == 1) PG_BAR;
    PG_WAIT_V(2); PG_BAR;
    PG_STAGE(PG_SB(1, 0), cB + kstep, voffB[0], voffB[1]); PG_STAGE(PG_SA(1, 0), cA + kstep, cva.v00, cva.v01); PG_STAGE(PG_SB(1, 1), cB + hstepB + kstep, voffB[0], voffB[1]);
    PG_WAIT_V(6); PG_BAR;
    for (;;) {
        const bool has_next = S.next(ui + 1, nxt);
        const char* nA = has_next ? nxt.A : cA; const char* nB = has_next ? nxt.B : cB;
        if constexpr (GATHER) {
            VA nva_ = cva; if (has_next) nva_ = S.va(nxt);
            *(LDSP u32x4*)(lds + VA_SLOT_OFF + tid * 16) = (u32x4){nva_.v00, nva_.v01, nva_.v10, nva_.v11};
        }
#define PG_BODY(M1) do { \
              \
            PG_LDB(B0, 0, 0); PG_LDB(B1, 0, 1); PG_SCHED; PG_LDA(At, 0, 0); PG_STAGE(PG_SA(1, 1), a1, cva.v10, cva.v11); \
            PG_WAIT_V(8); PG_WAIT_L(0); PG_BAR; PG_MMA(0, 0, At, B0, 4); PG_MMA(0, 1, At, B1, 4); PG_BAR; PG_SCHED; \
            PG_LDA(At, 0, 1); PG_STAGE(PG_SB(0, 0), b2, voffB[0], voffB[1]); PG_STAGE(PG_SB(0, 1), b2 + hstepB, voffB[0], voffB[1]); PG_STAGE(PG_SA(0, 0), a2, v00, v01); \
            PG_WAIT_V(8); PG_WAIT_L(0); PG_BAR; PG_MMA(1, 0, At, B0, M1); PG_MMA(1, 1, At, B1, M1); PG_BAR; PG_SCHED; \
              \
            PG_LDB(B0, 1, 0); PG_LDB(B1, 1, 1); PG_SCHED; PG_LDA(At, 1, 0); PG_STAGE(PG_SA(0, 1), a2, v10, v11); \
            PG_WAIT_V(8); PG_WAIT_L(0); PG_BAR; PG_MMA(0, 0, At, B0, 4); PG_MMA(0, 1, At, B1, 4); PG_BAR; PG_SCHED; \
            PG_LDA(At, 1, 1); PG_STAGE(PG_SB(1, 0), b3, voffB[0], voffB[1]); PG_STAGE(PG_SB(1, 1), b3 + hstepB, voffB[0], voffB[1]); PG_STAGE(PG_SA(1, 0), a3, v00, v01); \
            PG_WAIT_V(8); PG_WAIT_L(0); PG_BAR; PG_MMA(1, 0, At, B0, M1); PG_MMA(1, 1, At, B1, M1); PG_BAR; PG_SCHED; } while (0)
#define PG_TLOOP(M1) do { _Pragma("unroll 1") for (int t = 0; t < nt; t += 2) { \
            const bool last = (t == nt - 2); \
            const char* a1 = cA + (size_t)(t + 1) * kstep; \
            const char* a2 = last ? nA : cA + (size_t)(t + 2) * kstep; const char* b2 = last ? nB : cB + (size_t)(t + 2) * kstep; \
            const char* a3 = a2 + kstep; const char* b3 = b2 + kstep; \
            unsigned v00 = cva.v00, v01 = cva.v01, v10 = cva.v10, v11 = cva.v11; \
            asm volatile("" : "+v"(voffB[0]), "+v"(voffB[1]));        \
            if constexpr (GATHER) { if (last) { const u32x4 q_ = *(const LDSP u32x4*)(lds + VA_SLOT_OFF + tid * 16); v00 = q_.x; v01 = q_.y; v10 = q_.z; v11 = q_.w; } } \
            PG_BODY(M1); } } while (0)
        if constexpr (RAGGED) {
            if (nvc > 192) PG_TLOOP(4); else if (nvc > 128) PG_TLOOP(2); else PG_TLOOP(0);
        } else PG_TLOOP(4);
#undef PG_TLOOP
#undef PG_BODY
        if (wr == 0) PG_BAR;
        if constexpr (F8) asm volatile("s_nop 15\n\ts_nop 15" ::: "memory");
        E(acc, cur, wr, wc, fr, fq);
        if (!has_next) break;
#pragma unroll
        for (int a = 0; a < 2; ++a)
#pragma unroll
            for (int b = 0; b < 2; ++b)
#pragma unroll
                for (int m = 0; m < 4; ++m)
#pragma unroll
                    for (int n = 0; n < 2; ++n) acc[a][b][m][n] = (f32x4){0.f, 0.f, 0.f, 0.f};
        cur = nxt; cA = nA; cB = nB; ++ui; if (RAGGED) nvc = cur.x1;
        if constexpr (GATHER) { const u32x4 q_ = *(const LDSP u32x4*)(lds + VA_SLOT_OFF + tid * 16); cva.v00 = q_.x; cva.v01 = q_.y; cva.v10 = q_.z; cva.v11 = q_.w; }
        if (wr == 1) PG_BAR;
    }
    PG_WAIT_V(0);
    PG_BAR;
#undef PG_SA
#undef PG_SB
#undef PG_STAGE
#undef PG_LDA
#undef PG_LDB
#undef PG_MMA
#undef PG_WAIT_V
#undef PG_WAIT_L
#undef PG_BAR
#undef PG_SCHED
}
template <class F, class V> struct SchedF { F f; V v; __device__ __forceinline__ bool next(int i, Unit& u) const { return f(i, u); } __device__ __forceinline__ VA va(const Unit& u) const { return v(u); } };
template <class F, class V> __device__ __forceinline__ SchedF<F, V> sched(F f, V v) { return SchedF<F, V>{f, v}; }
template <class F> struct EpiFrag {
    F f;
    __device__ __forceinline__ void operator()(const f32x4 (&acc)[2][2][4][2], const Unit& u, int wr, int wc, int fr, int fq) const {
#pragma unroll
        for (int ai = 0; ai < 2; ++ai)
#pragma unroll
            for (int m = 0; m < 4; ++m) {
                int rr_ = 128 * ai + 64 * wr + 16 * m + fr;
                asm volatile("" : "+v"(rr_));
#pragma unroll
                for (int bj = 0; bj < 2; ++bj)
#pragma unroll
                    for (int n = 0; n < 2; ++n) f(u, rr_, 128 * bj + 32 * wc + 16 * n + 4 * fq, acc[ai][bj][m][n]);
                asm volatile("" ::: "memory");
            }
    }
};
template <class F> __device__ __forceinline__ EpiFrag<F> epi_frag(F f) { return EpiFrag<F>{f}; }
template <class F> struct EpiRow8 {
    F f;
    __device__ __forceinline__ void operator()(const f32x4 (&acc)[2][2][4][2], const Unit& u, int wr, int wc, int fr, int fq) const {
#pragma unroll
        for (int ai = 0; ai < 2; ++ai)
#pragma unroll
            for (int m = 0; m < 4; ++m) {
                int rr_ = 128 * ai + 64 * wr + 16 * m + fr;
                asm volatile("" : "+v"(rr_));
#pragma unroll
                for (int bj = 0; bj < 2; ++bj) f(u, rr_, 128 * bj + 32 * wc + 8 * fq, acc[ai][bj][m][0], acc[ai][bj][m][1]);
                asm volatile("" ::: "memory");
            }
    }
};
template <class F> __device__ __forceinline__ EpiRow8<F> epi_row8(F f) { return EpiRow8<F>{f}; }
__device__ __forceinline__ u32x4 pack8(f32x4 a, f32x4 b) { u32x4 w; w.x = pk2(a[0], a[1]); w.y = pk2(a[2], a[3]); w.z = pk2(b[0], b[1]); w.w = pk2(b[2], b[3]); return w; }
__device__ __forceinline__ bool static_tile(int i, int nM, int nN, int& pm, int& pn) {
    const int nwg = nM * nN; const long L = (long)i * gridDim.x + blockIdx.x; if (L >= nwg) return false;
    int wgid = (int)L; { const int q = nwg / 8, r = nwg % 8, xcd = wgid % 8, off = wgid / 8; wgid = (xcd < r ? xcd * (q + 1) : r * (q + 1) + (xcd - r) * q) + off; }
    const int nig = 8 * nN, gid = wgid / nig, fm = gid * 8, gsz = (nM - fm) < 8 ? (nM - fm) : 8;
    pm = fm + ((wgid % nig) % gsz); pn = (wgid % nig) / gsz; return true;
}
}

__device__ __forceinline__ int moe_ntiles(int c) { return (c + 255) >> 8; }
__device__ __forceinline__ void moe_tile_rows(int c, int j, int& row0, int& nvalid) {
    const int nte = (c + 255) >> 8, rpt = nte ? (((c + nte - 1) / nte + 15) & ~15) : 0;
    row0 = j * rpt; nvalid = min(c - row0, rpt);
}
constexpr int LDS_SP = 131072, LDS_CT = LDS_SP + 256 * NSEG * 4, LDS_WT = LDS_CT + 1024;
template <bool COMPACT>
__device__ __forceinline__ void moe_tile_table(const int* cntp, int* ctab, LDSP unsigned char* lds, LDSP int* ts, int tid) {
    LDSP int* sp = (LDSP int*)(lds + LDS_SP); LDSP int* ct = (LDSP int*)(lds + LDS_CT); LDSP int* wt = (LDSP int*)(lds + LDS_WT);
    const int lane = tid & 63, wid = tid >> 6;
    __syncthreads();
    int c = 0;
    if (tid < 256) {
        int v[NSEG];
        if constexpr (COMPACT) {
            const i32x4_t a0 = *(const i32x4_t*)(ctab + tid * NSEG), a1 = *(const i32x4_t*)(ctab + tid * NSEG + 4);
            v[0] = a0[0]; v[1] = a0[1]; v[2] = a0[2]; v[3] = a0[3]; v[4] = a1[0]; v[5] = a1[1]; v[6] = a1[2]; v[7] = a1[3];
        } else {
#pragma unroll
            for (int sg = 0; sg < NSEG; ++sg) v[sg] = __hip_atomic_load(cntp + (size_t)(sg * 256 + tid) * CNT_STRIDE, __ATOMIC_RELAXED, __HIP_MEMORY_SCOPE_AGENT);
            *(i32x4_t*)(ctab + tid * NSEG) = (i32x4_t){v[0], v[1], v[2], v[3]}; *(i32x4_t*)(ctab + tid * NSEG + 4) = (i32x4_t){v[4], v[5], v[6], v[7]};
        }
#pragma unroll
        for (int sg = 0; sg < NSEG; ++sg) { sp[tid * NSEG + sg] = c; c += v[sg]; }
        ct[tid] = c;
    }
    const int own_t = (c + 255) >> 8, own_a = (c + 15) & ~15;
    int st = own_t, sa = own_a;
#pragma unroll
    for (int d = 1; d < 64; d <<= 1) { const int x = __shfl_up(st, d), y = __shfl_up(sa, d); if (lane >= d) { st += x; sa += y; } }
    if (lane == 63 && wid < 4) { wt[wid * 2] = st; wt[wid * 2 + 1] = sa; }
    __syncthreads();
    if (tid < 256) {
        for (int w2 = 0; w2 < wid; ++w2) { st += wt[w2 * 2]; sa += wt[w2 * 2 + 1]; }
        ts[tid] = st - own_t; ts[260 + tid] = sa - own_a;
        if (tid == 255) ts[256] = st;
    }
    __syncthreads();
}
__device__ __forceinline__ int moe_find_expert(const LDSP int* ts, int tile) {
    int lo = 0, hi = 256;
    while (hi - lo > 1) { const int mid = (lo + hi) >> 1; if (ts[mid] <= tile) lo = mid; else hi = mid; }
    return lo;
}
struct MoeUnit { int e, pn, row0, nvalid, arow0; };
constexpr int MOE_UD_OFF = 2176, MOE_UD_MAX = 56;
__device__ __forceinline__ MoeUnit moe_unit(const LDSP int* ts, const LDSP int* ct, int o, int npn) {
    MoeUnit u; u.e = moe_find_expert(ts, o / npn);
    const int nte = ts[u.e + 1] - ts[u.e], local = o - npn * ts[u.e];
    u.pn = local / nte; const int j = local - u.pn * nte;
    const int c = ct[u.e];
    moe_tile_rows(c, j, u.row0, u.nvalid); u.arow0 = ts[260 + u.e] + u.row0;
    return u;
}
__device__ __forceinline__ int moe_build_units(const LDSP int* ts, const LDSP int* cnt, int first, int last, int step, int npn, LDSP int* ud, int tid) {
    const int n = first < last ? (last - first + step - 1) / step : 0;
    if (tid < n && tid < MOE_UD_MAX) { const MoeUnit mu = moe_unit(ts, cnt, first + tid * step, npn); LDSP int* d = ud + tid * 5; d[0] = mu.e; d[1] = mu.pn; d[2] = mu.row0; d[3] = mu.nvalid > 0 ? mu.nvalid : 0; d[4] = mu.arow0; }
    __syncthreads();
    return n < MOE_UD_MAX ? n : MOE_UD_MAX;
}
__device__ __forceinline__ void unit_range(int U, int& first, int& last, int& step) {
    const int G = gridDim.x;
    if (G & 7) { first = blockIdx.x; last = U; step = G; return; }
    const int x = blockIdx.x & 7, r = blockIdx.x >> 3;
    first = (int)(((long)x * U) >> 3) + r; last = (int)(((long)(x + 1) * U) >> 3); step = G >> 3;
}
struct FinArgs { const bf16_t* pre2b; const unsigned char* contrib8; const float* gate; const int* inv; const float* g; const float* b; float* out; };
struct FinRows { u32x2 c0[8], c1[8]; u32x4 p0, p1; };
__device__ __forceinline__ void fin_index(const FinArgs& A, const LDSP int* ab, const LDSP int* sp, int tok, int lane, int& rowk, float& gk) {
    const int l8 = lane & 7;
    const int w = A.inv[(size_t)tok * 8 + l8]; rowk = ab[w >> 16] + sp[(w >> 16) * NSEG + ((w >> 11) & (NSEG - 1))] + (w & 2047); gk = A.gate[(size_t)tok * 8 + l8] * (1.f / F8_SC);
}
__device__ __forceinline__ void fin_rows(const FinArgs& A, int rowk, int tok, int lane, FinRows& R) {
#pragma unroll
    for (int k = 0; k < 8; ++k) {
        const int row = __shfl(rowk, k);
        const unsigned char* cp = A.contrib8 + (size_t)row * 1024 + lane * 8;
        R.c0[k] = *(const u32x2*)cp; R.c1[k] = *(const u32x2*)(cp + 512);
    }
    const bf16_t* pp = A.pre2b + (size_t)tok * 1024 + lane * 8;
    R.p0 = *(const u32x4*)pp; R.p1 = *(const u32x4*)(pp + 512);
}
__device__ __forceinline__ void fin_finish(const FinArgs& A, const FinRows& R, float gk, int tok, int lane) {
    const u32x4 p0 = R.p0, p1 = R.p1;
    f32x4 v[4];
    v[0] = (f32x4){bf2f(p0.x & 0xffff), bf2f(p0.x >> 16), bf2f(p0.y & 0xffff), bf2f(p0.y >> 16)}; v[1] = (f32x4){bf2f(p0.z & 0xffff), bf2f(p0.z >> 16), bf2f(p0.w & 0xffff), bf2f(p0.w >> 16)};
    v[2] = (f32x4){bf2f(p1.x & 0xffff), bf2f(p1.x >> 16), bf2f(p1.y & 0xffff), bf2f(p1.y >> 16)}; v[3] = (f32x4){bf2f(p1.z & 0xffff), bf2f(p1.z >> 16), bf2f(p1.w & 0xffff), bf2f(p1.w >> 16)};
#pragma unroll
    for (int k = 0; k < 8; ++k) {
        const float gt = __shfl(gk, k);
        const unsigned w4[4] = {R.c0[k].x, R.c0[k].y, R.c1[k].x, R.c1[k].y};
#pragma unroll
        for (int i = 0; i < 4; ++i) {
            const f32x2_t lo = f8lo(w4[i]), hi = f8hi(w4[i]);
            v[i][0] += gt * lo[0]; v[i][1] += gt * lo[1]; v[i][2] += gt * hi[0]; v[i][3] += gt * hi[1];
        }
    }
    float s_ = 0.f;
#pragma unroll
    for (int i = 0; i < 4; ++i) s_ += (v[i][0] + v[i][1]) + (v[i][2] + v[i][3]);
    const float mu = wave_sum(s_) * (1.f / 1024.f);
    float q = 0.f;
#pragma unroll
    for (int i = 0; i < 4; ++i) { const f32x4 d = v[i] - mu; q += (d[0] * d[0] + d[1] * d[1]) + (d[2] * d[2] + d[3] * d[3]); }
    const float rstd = rsqrtf(wave_sum(q) * (1.f / 1024.f) + 1e-5f);
    const int co[4] = {lane * 8, lane * 8 + 4, 512 + lane * 8, 516 + lane * 8};
#pragma unroll
    for (int i = 0; i < 4; ++i) {
        const f32x4 gg = *(const f32x4*)(A.g + co[i]), bb = *(const f32x4*)(A.b + co[i]);
        *(f32x4*)(A.out + (size_t)tok * 1024 + co[i]) = (v[i] - mu) * rstd * gg + bb;
    }
}
__device__ __forceinline__ void final_tokens(const FinArgs& A, const LDSP int* ab, const LDSP int* sp, int t0, int S, int lane) {
    if (t0 >= NT) return;
    int tok = t0, rk0, rk1; float g0, g1;
    fin_index(A, ab, sp, tok, lane, rk0, g0);
    FinRows R0; fin_rows(A, rk0, tok, lane, R0);
    int tok1 = tok + S, tk1 = tok1 < NT ? tok1 : tok;
    fin_index(A, ab, sp, tk1, lane, rk1, g1);
#pragma unroll 1
    for (;;) {
        FinRows R1; fin_rows(A, rk1, tk1, lane, R1);
        const int tok2 = tok1 + S, tk2 = tok2 < NT ? tok2 : tk1;
        int rk2; float g2; fin_index(A, ab, sp, tk2, lane, rk2, g2);
        fin_finish(A, R0, g0, tok, lane);
        if (tok1 >= NT) break;
        R0 = R1; g0 = g1; tok = tok1; tok1 = tok2; tk1 = tk2; rk1 = rk2; g1 = g2;
    }
}
__device__ __forceinline__ void route_tokens8(const float* logits, const float* rbias, float* gate, int tok0, int lane, int& e_out) {
    const float4 rb = *(const float4*)(rbias + lane * 4);
    float4 lgs[8];
#pragma unroll
    for (int t = 0; t < 8; ++t) lgs[t] = *(const float4*)(logits + (size_t)(tok0 + t) * NE + lane * 4);
    int e_all = 0; float g_all = 0.f;
#pragma unroll
    for (int t = 0; t < 8; ++t) {
        const float4 lg = lgs[t];
        float sc[4], ch[4];
        sc[0] = 1.f / (1.f + expf(-lg.x)); sc[1] = 1.f / (1.f + expf(-lg.y)); sc[2] = 1.f / (1.f + expf(-lg.z)); sc[3] = 1.f / (1.f + expf(-lg.w));
        ch[0] = sc[0] + rb.x; ch[1] = sc[1] + rb.y; ch[2] = sc[2] + rb.z; ch[3] = sc[3] + rb.w;
        float t1 = -INFINITY, t2 = -INFINITY;
#pragma unroll
        for (int i = 0; i < 4; ++i) { const float v = ch[i]; if (v > t1) { t2 = t1; t1 = v; } else if (v > t2) t2 = v; }
#pragma unroll
        for (int s_ = 1; s_ <= 4; s_ <<= 1) {
            const float o1 = __shfl_xor(t1, s_), o2 = __shfl_xor(t2, s_);
            const float n1 = fmaxf(t1, o1);
            const float n2 = fmaxf(fminf(t1, o1), fmaxf(t2, o2));
            t1 = n1; t2 = n2;
        }
        const float gs = t1 + t2;
        const int mygrp = lane >> 3;
        int rank = 0;
#pragma unroll
        for (int g2 = 0; g2 < 8; ++g2) { const float og = __shfl(gs, g2 * 8); if (og > gs || (og == gs && g2 < mygrp)) ++rank; }
        const bool gsel = rank < 4;
#pragma unroll
        for (int i = 0; i < 4; ++i) if (!gsel) ch[i] = -INFINITY;
        float gsum = 0.f; float myg = 0.f; int mye = -1;
#pragma unroll 1
        for (int k = 0; k < TOPK; ++k) {
            float bv = ch[0]; int bi = 0;
#pragma unroll
            for (int i = 1; i < 4; ++i) if (ch[i] > bv) { bv = ch[i]; bi = i; }
            int be = lane * 4 + bi;
#pragma unroll
            for (int s_ = 32; s_ >= 1; s_ >>= 1) {
                const float ov = __shfl_xor(bv, s_); const int oe = __shfl_xor(be, s_);
                if (ov > bv || (ov == bv && oe < be)) { bv = ov; be = oe; }
            }
            const int ol = be >> 2, oi = be & 3;
            float sv = 0.f;
            if (lane == ol) {
#pragma unroll
                for (int i = 0; i < 4; ++i) if (i == oi) { sv = sc[i]; ch[i] = -INFINITY; }
            }
            sv = __shfl(sv, ol);
            gsum += sv;
            if (lane == k) { myg = sv; mye = be; }
        }
        const float gv = 2.5f * myg / (gsum + 1e-20f);
        const int eo = __shfl(mye, lane & 7); const float go = __shfl(gv, lane & 7);
        if ((lane >> 3) == t) { e_all = eo; g_all = go; }
    }
    gate[(size_t)tok0 * TOPK + lane] = g_all;
    e_out = e_all;
}


struct Params {
    const float* x; const float* w_in; const float* att_norm_g; const float* lam_re; const float* lam_im; const float* log_step;
    const float* b_re; const float* b_im; const float* c_re; const float* c_im; const float* d_skip; const float* w_glu; const float* b_glu;
    const float* ssm_norm_g; const float* w_out; const float* ln1_g; const float* ln1_b; const float* router_w; const float* router_bias;
    const float* w_gu; const float* w_down; const float* shared_w_gu; const float* shared_w_down; const float* ln2_g; const float* ln2_b;
    float* out;
    unsigned* bar; int* cntp; int* list; int* ctab;
    bf16_t* xb; bf16_t* w_inT; float* rope; bf16_t* q; bf16_t* k; bf16_t* v; bf16_t* u;
    bf16_t* opart; float* lse; bf16_t* wendT; bf16_t* wcarT; bf16_t* klagT; float* a16; bf16_t* w_gluT; bf16_t* yss; void* rsv0; void* rsv1;
    bf16_t* w_outT; bf16_t* rsT; bf16_t* sdT; unsigned char* h1q; bf16_t* h1b; float* logits; void* rsv2; bf16_t* pre2b; float* gate; int* inv;
    unsigned char* w_gu8; unsigned char* w_dn8; unsigned char* act8; unsigned char* contrib8;
    int ph_lo, ph_hi;
};
constexpr int LDS_TS = ME_LDS;
constexpr int LDS_XB = ME_LDS + 4096 + 8192;
constexpr int LDS_TOTAL = ME_LDS + 4096 + 8192 + 64;
static_assert(pg::VA_SLOT_OFF == ME_LDS + 4096 && LDS_TOTAL <= 163840, "LDS map");
constexpr int N_PHASES = 12;

template <class RM>
__device__ __forceinline__ void transpose_range(const float* W, int K, int N, unsigned char* Wt, int t0, int t1, LDSP unsigned char* lds) {
    const int tid = threadIdx.x, lane = tid & 63, wid = __builtin_amdgcn_readfirstlane(tid >> 6);
    LDSP float* scr = (LDSP float*)(lds + wid * 17408);
    const int tk = K >> 6; const RM rm = RM();
    const int lr = lane >> 4, lc = (lane & 15) * 4;
    const int rc = lane & 3, rn = lane >> 2;
#define TR_LOAD(V, t_) do { const int k0_ = ((t_) % tk) * 64, n0_ = ((t_) / tk) * 64; const float* sp_ = W + (size_t)(k0_ + lr) * N + n0_ + lc; \
        _Pragma("unroll") for (int i = 0; i < 16; ++i) V[i] = __builtin_nontemporal_load((const f32x4*)(sp_ + (size_t)(4 * i) * N)); } while (0)
#define TR_PROC(V, t_) do { const int k0_ = ((t_) % tk) * 64, n0_ = ((t_) / tk) * 64; \
        _Pragma("unroll") for (int i = 0; i < 16; ++i) { const int k = 4 * i + lr; *(LDSP f32x4*)(scr + k * 68 + (lc ^ (4 * ((k >> 3) & 7)))) = V[i]; } \
        _Pragma("unroll") for (int j = 0; j < 4; ++j) { \
            const int n = rn + 16 * j; \
            const LDSP float* pa = scr + (16 * rc) * 68 + (n ^ (8 * rc)), * pb = scr + (16 * rc + 8) * 68 + (n ^ (8 * rc + 4)); \
            u32x4 w; \
            w.x = pk4f8(pa[0] * F8_SW, pa[68] * F8_SW, pa[2 * 68] * F8_SW, pa[3 * 68] * F8_SW); w.y = pk4f8(pa[4 * 68] * F8_SW, pa[5 * 68] * F8_SW, pa[6 * 68] * F8_SW, pa[7 * 68] * F8_SW); \
            w.z = pk4f8(pb[0] * F8_SW, pb[68] * F8_SW, pb[2 * 68] * F8_SW, pb[3 * 68] * F8_SW); w.w = pk4f8(pb[4 * 68] * F8_SW, pb[5 * 68] * F8_SW, pb[6 * 68] * F8_SW, pb[7 * 68] * F8_SW); \
            *(u32x4*)(Wt + (size_t)rm(n0_ + n) * K + k0_ + 16 * rc) = w; } } while (0)
    int t = t0 + wid;
    if (t >= t1) return;
    f32x4 va[16], vb[16];
    TR_LOAD(va, t);
#pragma unroll 1
    for (; t < t1; t += 16) {
        const int t2 = t + 8, t3 = t + 16;
        { const int tl = t2 < t1 ? t2 : t; TR_LOAD(vb, tl); }
        TR_PROC(va, t);
        if (t2 < t1) {
            { const int tl = t3 < t1 ? t3 : t2; TR_LOAD(va, tl); }
            TR_PROC(vb, t2);
        }
    }
#undef TR_LOAD
#undef TR_PROC
}
__device__ __forceinline__ void convert_experts(const Params& p, LDSP unsigned char* lds, int t0, int t1) {
    __syncthreads();
    for (int e = blockIdx.x; e < NE; e += gridDim.x) {
        if (t0 < 128) transpose_range<RowGU>(p.w_gu + (size_t)e * 1024 * 512, 1024, 512, p.w_gu8 + (size_t)e * 512 * 1024, t0, t1 < 128 ? t1 : 128, lds);
        if (t1 > 128) transpose_range<RowId>(p.w_down + (size_t)e * 256 * 1024, 256, 1024, p.w_dn8 + (size_t)e * 1024 * 256, (t0 > 128 ? t0 : 128) - 128, t1 - 128, lds);
    }
    __syncthreads();
}
__device__ __forceinline__ bool convert_first() { return ((blockIdx.x >> 3) & 1) == 0; }
template <class RM, bool FT>
__device__ __forceinline__ void transpose_tile_w(const float* W, int K, int N, bf16_t* Wt, int t, LDSP float* scr, int lane) {
    const int tn = N >> 6; const RM rm = RM();
    const int lr = lane >> 4, lc = (lane & 15) * 4;
    const int rc = lane & 7, rn = lane >> 3;
    const int k0 = (t / tn) * 64, n0 = (t % tn) * 64;
    const float* sp = W + (size_t)(k0 + lr) * N + n0 + lc;
    f32x4 v[16];
#pragma unroll
    for (int i = 0; i < 16; ++i) v[i] = *(const f32x4*)(sp + (size_t)(4 * i) * N);
#pragma unroll
    for (int i = 0; i < 16; ++i) { const int k = 4 * i + lr; *(LDSP f32x4*)(scr + k * 68 + (lc ^ (4 * ((k >> 3) & 7)))) = v[i]; }
#pragma unroll
    for (int j = 0; j < 8; ++j) {
        const int n = rn + 8 * j;
        const LDSP float* q = scr + (8 * rc) * 68 + (n ^ (4 * rc));
        u32x4 w;
        w.x = pk2(q[0], q[68]); w.y = pk2(q[2 * 68], q[3 * 68]); w.z = pk2(q[4 * 68], q[5 * 68]); w.w = pk2(q[6 * 68], q[7 * 68]);
        const int nn = rm(n0 + n);
        *(u32x4*)(Wt + (FT ? ft_off(nn, k0 + 8 * rc, K) : (size_t)nn * K + k0 + 8 * rc)) = w;
    }
}
__device__ __forceinline__ void phase_prologue(const Params& p, LDSP unsigned char* lds) {
    const int tid = threadIdx.x;
    {
        const int lane = tid & 63, wid = __builtin_amdgcn_readfirstlane(tid >> 6);
        LDSP float* scr = (LDSP float*)(lds + wid * 17408);
        for (int g = blockIdx.x * 8 + wid; g < 1088; g += gridDim.x * 8) {
            if (g < 512) transpose_tile_w<RowId, false>(p.w_in, 1024, 2048, p.w_inT, g, scr, lane);
            else if (g < 768) transpose_tile_w<RowId, true>(p.w_out, 1024, 1024, p.w_outT, g - 512, scr, lane);
            else if (g < 896) transpose_tile_w<RowGU64, true>(p.shared_w_gu, 1024, 512, p.rsT + (size_t)256 * 1024, g - 768, scr, lane);
            else if (g < 960) transpose_tile_w<RowId, true>(p.w_glu, 512, 512, p.w_gluT, g - 896, scr, lane);
            else if (g < 1024) transpose_tile_w<RowId, true>(p.router_w, 1024, 256, p.rsT, g - 960, scr, lane);
            else transpose_tile_w<RowId, true>(p.shared_w_down, 256, 1024, p.sdT, g - 1024, scr, lane);
        }
    }
    for (size_t i = ((size_t)blockIdx.x * 512 + tid) * 8; i < (size_t)NT * D_; i += (size_t)gridDim.x * 512 * 8) {
        const float4 v0 = *(const float4*)(p.x + i), v1 = *(const float4*)(p.x + i + 4);
        u32x4 w; w.x = pk2(v0.x, v0.y); w.y = pk2(v0.z, v0.w); w.z = pk2(v1.x, v1.y); w.w = pk2(v1.z, v1.w);
        *(u32x4*)(p.xb + i) = w;
    }
    for (int i = blockIdx.x * 512 + tid; i < 2048 * 8; i += gridDim.x * 512) {
        const int pos = i >> 3, f = i & 7;
        const float inv = powf(500000.0f, -(float)f / 8.0f);
        const float ang = (float)pos * inv;
        p.rope[2 * i] = cosf(ang); p.rope[2 * i + 1] = sinf(ang);
    }
    for (int i = blockIdx.x * 512 + tid; i < NSEG * NE; i += gridDim.x * 512) p.cntp[(size_t)i * CNT_STRIDE] = 0;
    SsmTabArgs sa{p.lam_re, p.lam_im, p.log_step, p.b_re, p.b_im, p.c_re, p.c_im, p.wendT, p.wcarT, p.klagT, p.a16};
    for (int it = blockIdx.x * 512 + tid; it < SSM_TAB_ITEMS; it += gridDim.x * 512) ssm_tab_item(sa, it);
    __syncthreads();
    for (int it = blockIdx.x; it < 512; it += gridDim.x) ssm_klag_item(sa, it, (LDSP float*)lds, tid);
    __syncthreads();
}
__device__ __forceinline__ void phase_proj(const Params& a, LDSP unsigned char* lds) {
    const bool cvf_ = convert_first();
    if (cvf_) convert_experts(a, lds, 0, 48);
    pg::gemm_phase<false, true, false, false>(lds, 1024, pg::sched([&](int i, pg::Unit& u) {
        int pm, pn; if (!pg::static_tile(i, 64, 8, pm, pn)) return false;
        u.A = (const char*)(a.xb + (size_t)pm * 256 * 1024); u.B = (const char*)(a.w_inT + (size_t)pn * 256 * 1024); u.x0 = pm; u.x1 = pn; u.x2 = 0; u.x3 = 0; return true;
    }, [](const pg::Unit&) { return pg::dense_va(2048); }), pg::epi_row8([&](const pg::Unit& u, int r, int c, f32x4 v0, f32x4 v1) {
        const int m = u.x0 * 256 + r, sec = u.x1 >> 1, cs = (u.x1 & 1) * 256 + c;
        const int b = m >> 11, t = m & 2047, sh = sec < 3 ? 6 : 4;
        bf16_t* dstb = sec == 0 ? a.q : (sec == 1 ? a.k : (sec == 2 ? a.v : a.u));
        if (sec == 0) { v0 = v0 * QSCALE; v1 = v1 * QSCALE; }
        if (sec < 2 && (c & 32) == 0) {
            f32x4 o0, o1;
#pragma unroll
            for (int j = 0; j < 4; ++j) { o0[j] = __shfl_xor(v0[j], 16); o1[j] = __shfl_xor(v1[j], 16); }
            if ((c & 16) == 0) {
                const float* rt = a.rope + (size_t)t * 16;
                const f32x4 c0 = *(const f32x4*)rt, c1 = *(const f32x4*)(rt + 4), c2 = *(const f32x4*)(rt + 8), c3 = *(const f32x4*)(rt + 12);
                const f32x4 cs0 = {c0[0], c0[2], c1[0], c1[2]}, cs1 = {c2[0], c2[2], c3[0], c3[2]}, sn0 = {c0[1], c0[3], c1[1], c1[3]}, sn1 = {c2[1], c2[3], c3[1], c3[3]};
                if ((c & 8) == 0) { v0 = v0 * cs0 - o0 * sn0; v1 = v1 * cs1 - o1 * sn1; }
                else { v0 = v0 * cs0 + o0 * sn0; v1 = v1 * cs1 + o1 * sn1; }
            }
        }
        const int grp = cs >> sh, within = cs & ((1 << sh) - 1);
        *(u32x4*)(dstb + ((((size_t)((b << (9 - sh)) + grp) << 11) + t) << sh) + within) = pg::pack8(v0, v1);
    }));
    if (!cvf_) convert_experts(a, lds, 0, 48);
}
__device__ __forceinline__ void phase_mixers(const Params& p, LDSP unsigned char* lds) {
    const bool cvf_ = convert_first();
    if (cvf_) convert_experts(p, lds, 48, 128);
    SsmArgs sa{p.u, p.wendT, p.wcarT, p.klagT, p.a16, p.d_skip, p.yss};
    for (int bg = blockIdx.x; bg < 256; bg += gridDim.x) ssm_unit(sa, bg, lds);
    __syncthreads();
    AttArgs aa{p.q, p.k, p.v, p.opart, p.lse};
    {
        const int tid = threadIdx.x;
        int U = blockIdx.x;
        AwPre P;
        if (U < AW_UNITS) aw_prefetch(aa, U, P, tid);
        while (U < AW_UNITS) {
            __syncthreads();
            aw_stage(P, lds, tid);
            bf16x8 qf[4];
#pragma unroll
            for (int s_ = 0; s_ < 4; ++s_) qf[s_] = P.q[s_];
            __syncthreads();
            const int Un = U + gridDim.x;
            aw_prefetch(aa, Un < AW_UNITS ? Un : U, P, tid);
            aw_compute(aa, U, qf, lds, tid);
            U = Un;
        }
        __syncthreads();
    }
    if (!cvf_) convert_experts(p, lds, 48, 128);
}
template <int NF, int NW = NF, int OFF = 0>
__device__ __forceinline__ void rb_gemm(f32x4 (&acc)[4][NW], const LDSP unsigned char* Alds, int apitch, const bf16_t* Bt, int K, int lane) {
    const int fr = lane & 15, fq = lane >> 4;
    const int nks = K >> 5;
    const char* bb = (const char*)Bt;
    unsigned bo = lane * 16;
    const unsigned nstride = (unsigned)nks * 1024u;
    const LDSP unsigned char* ap = Alds + fr * apitch + fq * 16;
#pragma unroll
    for (int m = 0; m < 4; ++m)
#pragma unroll
        for (int ni = 0; ni < NF; ++ni) acc[m][OFF + ni] = (f32x4){0.f, 0.f, 0.f, 0.f};
    bf16x8 b0[NF], b1[NF], b2[NF], b3[NF];
#define RB_LOADB(B_, step_) do { _Pragma("unroll") for (int ni = 0; ni < NF; ++ni) B_[ni] = *(const bf16x8*)(bb + (bo + (unsigned)(step_) * 1024u + ni * ns)); } while (0)
#define RB_MMA(B_, step_) do { bf16x8 af_[4]; _Pragma("unroll") for (int m = 0; m < 4; ++m) af_[m] = *(const LDSP bf16x8*)(ap + m * 16 * apitch + (step_) * 64); \
        _Pragma("unroll") for (int m = 0; m < 4; ++m) _Pragma("unroll") for (int ni = 0; ni < NF; ++ni) acc[m][OFF + ni] = __builtin_amdgcn_mfma_f32_16x16x32_bf16(B_[ni], af_[m], acc[m][OFF + ni], 0, 0, 0); } while (0)
    { unsigned ns = nstride; asm volatile("" : "+s"(ns), "+v"(bo)); RB_LOADB(b0, 0); RB_LOADB(b1, 1); RB_LOADB(b2, 2); }
#pragma unroll 1
    for (int ks = 0; ks < nks; ks += 4) {
        unsigned ns = nstride; asm volatile("" : "+s"(ns));
        RB_LOADB(b3, 3);
        RB_MMA(b0, 0);
        if (ks + 4 < nks) RB_LOADB(b0, 4);
        RB_MMA(b1, 1);
        if (ks + 4 < nks) RB_LOADB(b1, 5);
        RB_MMA(b2, 2);
        if (ks + 4 < nks) RB_LOADB(b2, 6);
        RB_MMA(b3, 3);
        bo += 4096u; ap += 256;
    }
#undef RB_LOADB
#undef RB_MMA
}
__device__ __forceinline__ void rb_stage_rows(LDSP unsigned char* dst, int lpitch, const bf16_t* src, size_t gpitch, int ncols) {
    const int cpr = ncols >> 3;
    int tid0 = threadIdx.x; asm volatile("" : "+v"(tid0));
    for (int id = tid0; id < 64 * cpr; id += 512) { const int r = id / cpr, c = id - r * cpr; *(LDSP u32x4*)(dst + r * lpitch + c * 16) = __builtin_nontemporal_load((const u32x4*)(src + (size_t)r * gpitch + c * 8)); }
}
constexpr int RB_HIST_OFF = 139264;
constexpr int RB_STAT_OFF = 64 * 2064;
__device__ __forceinline__ void phase_wout_ln(const Params& a, LDSP unsigned char* lds) {
    const bool cvf_ = convert_first();
    if (cvf_) convert_experts(a, lds, 128, 192);
    int lane = threadIdx.x & 63; const int w = __builtin_amdgcn_readfirstlane(threadIdx.x >> 6); int fr = lane & 15, fq = lane >> 4;
#define RB_FRESH() do { __builtin_amdgcn_sched_barrier(0); asm volatile("" : "+s"(m0), "+v"(fr), "+v"(fq), "+v"(lane)); } while (0)
    for (int tile = blockIdx.x; tile < NT / 64; tile += gridDim.x) {
        int m0 = tile * 64;
        asm volatile("" : "+s"(m0));
        __syncthreads();
#pragma unroll 1
        for (int tb = 0; tb < 8; tb += 4) {
            int ln = lane; asm volatile("" : "+v"(ln));
            const int h = ln >> 3;
            float ls[4][3]; u32x4 pv[4][3];
#pragma unroll
            for (int t = 0; t < 4; ++t) {
                const int tok = m0 + 8 * w + tb + t;
#pragma unroll
                for (int c = 0; c < 3; ++c) { ls[t][c] = a.lse[((size_t)c * NT + tok) * 8 + h]; pv[t][c] = __builtin_nontemporal_load((const u32x4*)(a.opart + ((size_t)c * NT + tok) * 512 + ln * 8)); }
            }
            const f32x4 ga0 = *(const f32x4*)(a.att_norm_g + ln * 8), ga1 = *(const f32x4*)(a.att_norm_g + ln * 8 + 4);
#pragma unroll
            for (int t = 0; t < 4; ++t) {
                const int row = 8 * w + tb + t;
                const float mx = fmaxf(ls[t][0], fmaxf(ls[t][1], ls[t][2]));
                float wg[3], ws = 0.f;
#pragma unroll
                for (int c = 0; c < 3; ++c) { wg[c] = exp2f(ls[t][c] - mx); ws += wg[c]; }
                const float iw = 1.f / ws;
                float o[8];
#pragma unroll
                for (int i = 0; i < 8; ++i) o[i] = 0.f;
#pragma unroll
                for (int c = 0; c < 3; ++c) {
                    const u32x4 v = pv[t][c]; const float wc = wg[c] * iw;
                    o[0] += wc * bf2f(v.x & 0xffff); o[1] += wc * bf2f(v.x >> 16); o[2] += wc * bf2f(v.y & 0xffff); o[3] += wc * bf2f(v.y >> 16);
                    o[4] += wc * bf2f(v.z & 0xffff); o[5] += wc * bf2f(v.z >> 16); o[6] += wc * bf2f(v.w & 0xffff); o[7] += wc * bf2f(v.w >> 16);
                }
                float sa = 0.f;
#pragma unroll
                for (int i = 0; i < 8; ++i) sa += o[i] * o[i];
                sa = wave_sum(sa);
                const float ra = rsqrtf(sa * (1.f / 512.f) + 1e-6f);
                u32x4 wa;
                wa.x = pk2(o[0] * ra * ga0[0], o[1] * ra * ga0[1]); wa.y = pk2(o[2] * ra * ga0[2], o[3] * ra * ga0[3]);
                wa.z = pk2(o[4] * ra * ga1[0], o[5] * ra * ga1[1]); wa.w = pk2(o[6] * ra * ga1[2], o[7] * ra * ga1[3]);
                *(LDSP u32x4*)(lds + row * 2064 + ln * 16) = wa;
            }
        }
        rb_stage_rows(lds + 1024, 2064, a.yss + (size_t)m0 * 512, 512, 512);
        __syncthreads();
        {
            f32x4 ga[4][4];
            rb_gemm<4>(ga, lds + 1024, 2064, a.w_gluT + (size_t)(64 * w) * 512, 512, lane);
            LDSP float* st = (LDSP float*)(lds + RB_STAT_OFF);
            RB_FRESH();
#pragma unroll
            for (int m = 0; m < 4; ++m) {
                float s2 = 0.f;
#pragma unroll
                for (int ni = 0; ni < 4; ++ni) {
                    const int col = 64 * w + 16 * ni + 4 * fq;
                    const u32x2 yw = *(const LDSP u32x2*)(lds + (16 * m + fr) * 2064 + 1024 + col * 2);
                    const f32x4 bb = *(const f32x4*)(a.b_glu + col);
                    f32x4 v = ga[m][ni];
                    v[0] = bf2f(yw.x & 0xffff) / (1.f + __expf(-(v[0] + bb[0]))); v[1] = bf2f(yw.x >> 16) / (1.f + __expf(-(v[1] + bb[1])));
                    v[2] = bf2f(yw.y & 0xffff) / (1.f + __expf(-(v[2] + bb[2]))); v[3] = bf2f(yw.y >> 16) / (1.f + __expf(-(v[3] + bb[3])));
                    ga[m][ni] = v; s2 += (v[0] * v[0] + v[1] * v[1]) + (v[2] * v[2] + v[3] * v[3]);
                }
                s2 += __shfl_xor(s2, 16); s2 += __shfl_xor(s2, 32);
                if (fq == 0) st[w * 64 + 16 * m + fr] = s2;
            }
            __syncthreads();
            RB_FRESH();
#pragma unroll
            for (int m = 0; m < 4; ++m) {
                float s2 = 0.f;
#pragma unroll
                for (int v = 0; v < 8; ++v) s2 += st[v * 64 + 16 * m + fr];
                const float rs = rsqrtf(s2 * (1.f / 512.f) + 1e-6f);
#pragma unroll
                for (int ni = 0; ni < 4; ++ni) {
                    const int col = 64 * w + 16 * ni + 4 * fq;
                    const f32x4 gs = *(const f32x4*)(a.ssm_norm_g + col);
                    const f32x4 v = ga[m][ni] * rs * gs;
                    u32x2 o2; o2.x = pk2(v[0], v[1]); o2.y = pk2(v[2], v[3]);
                    *(LDSP u32x2*)(lds + (16 * m + fr) * 2064 + 1024 + col * 2) = o2;
                }
            }
        }
        __syncthreads();
        f32x4 acc[4][8];
        const int n0 = 128 * w;
        rb_gemm<4, 8, 0>(acc, lds, 2064, a.w_outT + (size_t)n0 * 1024, 1024, lane);
        rb_gemm<4, 8, 4>(acc, lds, 2064, a.w_outT + (size_t)(n0 + 64) * 1024, 1024, lane);
        RB_FRESH();
        LDSP float* st = (LDSP float*)(lds + RB_STAT_OFF);
#pragma unroll
        for (int m = 0; m < 4; ++m) {
            const float* xr = a.x + (size_t)(m0 + 16 * m + fr) * 1024 + n0 + 4 * fq;
            float s1 = 0.f, s2 = 0.f;
#pragma unroll
            for (int ni = 0; ni < 8; ++ni) {
                const f32x4 xv = __builtin_nontemporal_load((const f32x4*)(xr + 16 * ni));
                const f32x4 v = xv * ALPHA + acc[m][ni]; acc[m][ni] = v;
                s1 += (v[0] + v[1]) + (v[2] + v[3]); s2 += (v[0] * v[0] + v[1] * v[1]) + (v[2] * v[2] + v[3] * v[3]);
            }
            s1 += __shfl_xor(s1, 16); s1 += __shfl_xor(s1, 32); s2 += __shfl_xor(s2, 16); s2 += __shfl_xor(s2, 32);
            if (fq == 0) { st[(w * 64 + 16 * m + fr) * 2] = s1; st[(w * 64 + 16 * m + fr) * 2 + 1] = s2; }
        }
        __syncthreads();
        RB_FRESH();
#pragma unroll
        for (int m = 0; m < 4; ++m) {
            float s1 = 0.f, s2 = 0.f;
#pragma unroll
            for (int v = 0; v < 8; ++v) { s1 += st[(v * 64 + 16 * m + fr) * 2]; s2 += st[(v * 64 + 16 * m + fr) * 2 + 1]; }
            const float mu = s1 * (1.f / 1024.f), var = s2 * (1.f / 1024.f) - mu * mu, rstd = rsqrtf(var + 1e-5f);
            LDSP unsigned char* hl = lds + (16 * m + fr) * 2064 + (n0 + 4 * fq) * 2;
#pragma unroll
            for (int ni = 0; ni < 8; ++ni) {
                const f32x4 gg = *(const f32x4*)(a.ln1_g + n0 + 16 * ni + 4 * fq), bb = *(const f32x4*)(a.ln1_b + n0 + 16 * ni + 4 * fq);
                const f32x4 y = (acc[m][ni] - mu) * rstd * gg + bb;
                u32x2 o; o.x = pk2(y[0], y[1]); o.y = pk2(y[2], y[3]);
                *(LDSP u32x2*)(hl + 32 * ni) = o;
            }
        }
        __syncthreads();
        {
            int tid0 = threadIdx.x; asm volatile("" : "+v"(tid0));
#pragma unroll 1
            for (int id = tid0; id < 64 * 128; id += 512) {
                const int r = id >> 7, c = id & 127; const u32x4 hv = *(const LDSP u32x4*)(lds + r * 2064 + c * 16);
                *(u32x4*)(a.h1b + (size_t)(m0 + r) * 1024 + c * 8) = hv;
                u32x2 q8;
                q8.x = pk4f8(bf2f(hv.x & 0xffff) * F8_SH, bf2f(hv.x >> 16) * F8_SH, bf2f(hv.y & 0xffff) * F8_SH, bf2f(hv.y >> 16) * F8_SH);
                q8.y = pk4f8(bf2f(hv.z & 0xffff) * F8_SH, bf2f(hv.z >> 16) * F8_SH, bf2f(hv.w & 0xffff) * F8_SH, bf2f(hv.w >> 16) * F8_SH);
                __builtin_nontemporal_store(q8, (u32x2*)(a.h1q + (size_t)(m0 + r) * 1024 + c * 8));
            }
        }
        RB_FRESH();
        {
            f32x4 rl[4][2];
            rb_gemm<2>(rl, lds, 2064, a.rsT + (size_t)(32 * w) * 1024, 1024, lane);
#pragma unroll
            for (int m = 0; m < 4; ++m)
#pragma unroll
                for (int ni = 0; ni < 2; ++ni) *(f32x4*)(a.logits + (size_t)(m0 + 16 * m + fr) * 256 + 32 * w + 16 * ni + 4 * fq) = rl[m][ni];
        }
        RB_FRESH();
        u32x2 actv[4][2];
        {
            f32x4 gu[4][4];
            rb_gemm<4>(gu, lds, 2064, a.rsT + (size_t)(256 + 64 * w) * 1024, 1024, lane);
#pragma unroll
            for (int m = 0; m < 4; ++m)
#pragma unroll
                for (int ni = 0; ni < 2; ++ni) {
                    const f32x4 g = gu[m][ni], up = gu[m][ni + 2];
                    actv[m][ni].x = pk2(silu_f(g[0]) * up[0], silu_f(g[1]) * up[1]); actv[m][ni].y = pk2(silu_f(g[2]) * up[2], silu_f(g[3]) * up[3]);
                }
        }
        asm volatile("s_waitcnt vmcnt(0)" ::: "memory");
        if (threadIdx.x < 256) ((LDSP int*)(lds + RB_HIST_OFF))[threadIdx.x] = 0;
        __syncthreads();
#pragma unroll
        for (int m = 0; m < 4; ++m)
#pragma unroll
            for (int ni = 0; ni < 2; ++ni) *(LDSP u32x2*)(lds + (16 * m + fr) * 528 + (32 * w + 16 * ni + 4 * fq) * 2) = actv[m][ni];
        RB_FRESH();
        {
            int e_my; route_tokens8(a.logits, a.router_bias, a.gate, m0 + 8 * w, lane, e_my);
            LDSP int* hist = (LDSP int*)(lds + RB_HIST_OFF); LDSP int* hbase = hist + 256;
            const int lpos = __hip_atomic_fetch_add(hist + e_my, 1, __ATOMIC_RELAXED, __HIP_MEMORY_SCOPE_WORKGROUP);
            __syncthreads();
            const int seg = blockIdx.x & (NSEG - 1);
            if (threadIdx.x < 256) { const int c = hist[threadIdx.x]; if (c > 0) hbase[threadIdx.x] = atomicAdd(&a.cntp[(size_t)(seg * 256 + threadIdx.x) * CNT_STRIDE], c); }
            __syncthreads();
            const int pos = hbase[e_my] + lpos, slot = (m0 + 8 * w) * TOPK + lane;
            a.list[(size_t)(e_my * NSEG + seg) * SEGCAP + pos] = slot;
            a.inv[slot] = (e_my << 16) | (seg << 11) | pos;
        }
        __syncthreads();
        RB_FRESH();
        {
            rb_gemm<4, 8, 0>(acc, lds, 528, a.sdT + (size_t)n0 * 256, 256, lane);
            rb_gemm<4, 8, 4>(acc, lds, 528, a.sdT + (size_t)(n0 + 64) * 256, 256, lane);
            __syncthreads();
            RB_FRESH();
#pragma unroll
            for (int m = 0; m < 4; ++m) {
                const size_t ro = (size_t)(m0 + 16 * m + fr) * 1024 + n0 + 4 * fq;
                LDSP unsigned char* pl = lds + (16 * m + fr) * 2064 + (n0 + 4 * fq) * 2;
#pragma unroll
                for (int ni = 0; ni < 8; ++ni) {
                    const u32x2 hw = *(const u32x2*)(a.h1b + ro + 16 * ni);
                    f32x4 hv; hv[0] = bf2f(hw.x & 0xffff); hv[1] = bf2f(hw.x >> 16); hv[2] = bf2f(hw.y & 0xffff); hv[3] = bf2f(hw.y >> 16);
                    const f32x4 y = hv * ALPHA + acc[m][ni];
                    u32x2 o; o.x = pk2(y[0], y[1]); o.y = pk2(y[2], y[3]);
                    *(LDSP u32x2*)(pl + 32 * ni) = o;
                }
            }
            __syncthreads();
            {
                int tid0 = threadIdx.x; asm volatile("" : "+v"(tid0));
#pragma unroll 1
                for (int id = tid0; id < 64 * 128; id += 512) { const int r = id >> 7, c = id & 127; __builtin_nontemporal_store(*(const LDSP u32x4*)(lds + r * 2064 + c * 16), (u32x4*)(a.pre2b + (size_t)(m0 + r) * 1024 + c * 8)); }
            }
        }
    }
    if (!cvf_) convert_experts(a, lds, 128, 192);
#undef RB_FRESH
}
template <bool RAGGED, class RowPtr>
__device__ __forceinline__ void swiglu_epi_pg(const f32x4 (&acc)[2][2][4][2], int wr, int wc, int fr, int fq, int nvalid, const RowPtr& rowp) {
    constexpr float us = 1.f / (F8_SH * F8_SW);
    asm volatile("" : "+v"(fr));
#pragma unroll
    for (int ai = 0; ai < 2; ++ai)
#pragma unroll
        for (int m = 0; m < 4; ++m) {
            const int r = RAGGED ? 16 * (2 * (4 * ai + m) + wr) + fr : 128 * ai + 64 * wr + 16 * m + fr;
            if (r < nvalid) {
                f32x4 o0, o1;
#pragma unroll
                for (int j = 0; j < 4; ++j) { o0[j] = silu_f(acc[ai][0][m][0][j] * us) * (acc[ai][1][m][0][j] * (us * F8_SA)); o1[j] = silu_f(acc[ai][0][m][1][j] * us) * (acc[ai][1][m][1][j] * (us * F8_SA)); }
                u32x2 w; w.x = pk4f8(o0[0], o0[1], o0[2], o0[3]); w.y = pk4f8(o1[0], o1[1], o1[2], o1[3]);
                *(u32x2*)(rowp(r) + 32 * wc + 8 * fq) = w;
            }
        }
}
__device__ __forceinline__ void phase_moe_up(const Params& a, LDSP unsigned char* lds) {
    LDSP int* ts = (LDSP int*)(lds + LDS_TS); LDSP int* ud = (LDSP int*)(lds + LDS_TS + MOE_UD_OFF);
    moe_tile_table<false>(a.cntp, a.ctab, lds, ts, threadIdx.x);
    int first, last, step; unit_range(2 * ts[256], first, last, step);
    const int nun = moe_build_units(ts, (const LDSP int*)(lds + LDS_CT), first, last, step, 2, ud, threadIdx.x);
    pg::gemm_phase<true, true, true, true>(lds, 512  , pg::sched([&](int i, pg::Unit& u) {
        if (i >= nun) return false;
        const LDSP int* d = ud + i * 5; const int e = d[0], pn = d[1];
        u.A = (const char*)a.h1q; u.B = (const char*)(a.w_gu8 + ((size_t)e * 512 + pn * 256) * 1024);
        u.x0 = pn; u.x1 = d[3]; u.x2 = d[4]; u.x3 = (e << 16) | d[2]; return true;
    }, [&](const pg::Unit& u) {
        const pg::LaneRC l = pg::lane_rc_fresh(); const int e = u.x3 >> 16, row0 = u.x3 & 0xffff, nvalid = u.x1; pg::VA v;
        const int r00 = pg::ragged_row(0, l.R0), r01 = pg::ragged_row(0, l.R1), r10 = pg::ragged_row(1, l.R0), r11 = pg::ragged_row(1, l.R1);
        const LDSP int* spe = (const LDSP int*)(lds + LDS_SP) + e * NSEG;
        const i32x4_t sa = *(const LDSP i32x4_t*)spe, sb = *(const LDSP i32x4_t*)(spe + 4);
        const int* lste = a.list + (size_t)e * NSEG * SEGCAP;
        auto tok_of = [&](int r) -> unsigned {
            if (r >= nvalid) return 0u;
            const int rr = row0 + r;
            int sg = 0, base = 0;
            if (rr >= sa[1]) { sg = 1; base = sa[1]; } if (rr >= sa[2]) { sg = 2; base = sa[2]; } if (rr >= sa[3]) { sg = 3; base = sa[3]; }
            if (rr >= sb[0]) { sg = 4; base = sb[0]; } if (rr >= sb[1]) { sg = 5; base = sb[1]; } if (rr >= sb[2]) { sg = 6; base = sb[2]; } if (rr >= sb[3]) { sg = 7; base = sb[3]; }
            return (unsigned)(lste[sg * SEGCAP + (rr - base)] >> 3);
        };
        v.v00 = tok_of(r00) * 1024u + l.C0 * 2; v.v01 = tok_of(r01) * 1024u + l.C1 * 2;
        v.v10 = tok_of(r10) * 1024u + l.C0 * 2; v.v11 = tok_of(r11) * 1024u + l.C1 * 2;
        return v;
    }), [&](const f32x4 (&acc)[2][2][4][2], const pg::Unit& u, int wr, int wc, int fr, int fq) {
        unsigned char* base = a.act8 + (size_t)u.x2 * 256 + 128 * u.x0;
        swiglu_epi_pg<true>(acc, wr, wc, fr, fq, u.x1, [&](int r) { return base + (size_t)r * 256; });
    });
}
__device__ __forceinline__ void phase_moe_down(const Params& a, LDSP unsigned char* lds) {
    LDSP int* ts = (LDSP int*)(lds + LDS_TS); LDSP int* ud = (LDSP int*)(lds + LDS_TS + MOE_UD_OFF);
    moe_tile_table<true>(a.cntp, a.ctab, lds, ts, threadIdx.x);
    int first, last, step; unit_range(4 * ts[256], first, last, step);
    const int nun = moe_build_units(ts, (const LDSP int*)(lds + LDS_CT), first, last, step, 4, ud, threadIdx.x);
    pg::gemm_phase<false, 2, true, true>(lds, 128  , pg::sched([&](int i, pg::Unit& u) {
        if (i >= nun) return false;
        const LDSP int* d = ud + i * 5; const int e = d[0], pn = d[1];
        u.A = (const char*)(a.act8 + (size_t)d[4] * 256); u.B = (const char*)(a.w_dn8 + ((size_t)e * 1024 + pn * 256) * 256);
        u.x0 = pn; u.x1 = d[3]; u.x2 = d[4]; u.x3 = 0; return true;
    }, [](const pg::Unit&) { const pg::LaneRC l = pg::lane_rc(); pg::VA v;
        v.v00 = pg::ragged_row(0, l.R0) * 256 + l.C0 * 2; v.v01 = pg::ragged_row(0, l.R1) * 256 + l.C1 * 2; v.v10 = pg::ragged_row(1, l.R0) * 256 + l.C0 * 2; v.v11 = pg::ragged_row(1, l.R1) * 256 + l.C1 * 2; return v;
    }), [&](const f32x4 (&acc)[2][2][4][2], const pg::Unit& u, int wr, int wc, int fr, int fq) {
        constexpr float cs = F8_SC / (F8_SA * F8_SW);
        asm volatile("" : "+v"(fr), "+v"(fq));
        const int nvalid = u.x1; unsigned char* base = a.contrib8 + (size_t)u.x2 * 1024 + u.x0 * 256 + 64 * wc + 16 * fq;
#pragma unroll
        for (int ai = 0; ai < 2; ++ai)
#pragma unroll
            for (int m = 0; m < 4; ++m) {
                const int r = 16 * (2 * (4 * ai + m) + wr) + fr;
                if (r < nvalid) {
                    const f32x4 c0 = acc[ai][0][m][0] * cs, c1 = acc[ai][0][m][1] * cs, c2 = acc[ai][1][m][0] * cs, c3 = acc[ai][1][m][1] * cs;
                    u32x4 w; w.x = pk4f8(c0[0], c0[1], c0[2], c0[3]); w.y = pk4f8(c1[0], c1[1], c1[2], c1[3]); w.z = pk4f8(c2[0], c2[1], c2[2], c2[3]); w.w = pk4f8(c3[0], c3[1], c3[2], c3[3]);
                    *(u32x4*)(base + (size_t)r * 1024) = w;
                }
            }
    });
}
__device__ __forceinline__ void phase_final(const Params& p, LDSP unsigned char* lds) {
    LDSP int* ts = (LDSP int*)(lds + LDS_TS);
    moe_tile_table<true>(p.cntp, p.ctab, lds, ts, threadIdx.x);
    FinArgs fa{p.pre2b, p.contrib8, p.gate, p.inv, p.ln2_g, p.ln2_b, p.out};
    const int lane = threadIdx.x & 63, wid = threadIdx.x >> 6;
    final_tokens(fa, ts + 260, (const LDSP int*)(lds + LDS_SP), blockIdx.x * 8 + wid, gridDim.x * 8, lane);
}

__global__ void __launch_bounds__(512, 2) k_mega(Params p) {
    extern __shared__ __attribute__((aligned(16))) unsigned char smem[];
    LDSP unsigned char* lds = (LDSP unsigned char*)smem;
    if (threadIdx.x == 0) *(LDSP u32x4*)(lds + LDS_XB) = (u32x4){0u, 0u, 0u, 0u};
    __syncthreads();
    XcdBarrier bar = xcd_barrier_post(p.bar, (volatile LAS unsigned*)(lds + LDS_XB));
#define PHASE(i, body) if (p.ph_lo <= (i) && (i) < p.ph_hi) { body; if ((i) + 1 < p.ph_hi) xcd_barrier(bar); }
    PHASE(0, phase_prologue(p, lds))
    PHASE(1, phase_proj(p, lds))
    PHASE(2, phase_mixers(p, lds))
    PHASE(5, phase_wout_ln(p, lds))
    PHASE(9, phase_moe_up(p, lds))
    PHASE(10, phase_moe_down(p, lds))
    PHASE(11, phase_final(p, lds))
#undef PHASE
}
}

#ifndef MK_PER_PHASE
#define MK_PER_PHASE 0
#endif
extern "C" void kernel_launch(void* const* d_in, const int* in_sizes, int n_in, void* d_out, int out_size, void* d_ws, size_t ws_size, hipStream_t stream) {
    static int grid = 0;
    if (!grid) {
        int dev = 0, cus = 0;
        if (hipGetDevice(&dev) != hipSuccess || hipDeviceGetAttribute(&cus, hipDeviceAttributeMultiprocessorCount, dev) != hipSuccess || cus < 1) return;
        if (hipFuncSetAttribute((const void*)k_mega, hipFuncAttributeMaxDynamicSharedMemorySize, LDS_TOTAL) != hipSuccess) return;
        grid = cus;
    }
    Params p{};
    const float** inp = (const float**)&p.x;
    for (int i = 0; i < 25; ++i) inp[i] = (const float*)d_in[i];
    p.out = (float*)d_out;
    char* ws = (char*)d_ws; size_t off = 0;
    auto take = [&](size_t bytes) { char* q = ws + off; off += (bytes + 255) & ~(size_t)255; return q; };
    p.bar = (unsigned*)take(XCD_BAR_WORDS * 4);
    const size_t ctl_bytes = off;
    p.cntp = (int*)take((size_t)NSEG * NE * CNT_STRIDE * 4);
    p.list = (int*)take((size_t)NE * NSEG * SEGCAP * 4); p.ctab = (int*)take((size_t)NE * NSEG * 4);
    p.xb = (bf16_t*)take((size_t)NT * 1024 * 2); p.w_inT = (bf16_t*)take((size_t)2048 * 1024 * 2); p.rope = (float*)take(2048 * 8 * 2 * 4);
    p.q = (bf16_t*)take((size_t)NT * 512 * 2); p.k = (bf16_t*)take((size_t)NT * 512 * 2); p.v = (bf16_t*)take((size_t)NT * 512 * 2); p.u = (bf16_t*)take((size_t)NT * 512 * 2);
    p.opart = (bf16_t*)take((size_t)3 * NT * 512 * 2); p.lse = (float*)take((size_t)3 * NT * 8 * 4);
    p.wendT = (bf16_t*)take((size_t)32 * 128 * 256 * 2); p.wcarT = (bf16_t*)take((size_t)32 * 256 * 128 * 2); p.klagT = (bf16_t*)take((size_t)32 * 16 * 256 * 2); p.a16 = (float*)take((size_t)32 * 64 * 2 * 4);
    p.w_gluT = (bf16_t*)take((size_t)512 * 512 * 2); p.yss = (bf16_t*)take((size_t)NT * 512 * 2);
    p.w_outT = (bf16_t*)take((size_t)1024 * 1024 * 2); p.rsT = (bf16_t*)take((size_t)768 * 1024 * 2); p.sdT = (bf16_t*)take((size_t)1024 * 256 * 2);
    p.h1b = (bf16_t*)take((size_t)NT * 1024 * 2); p.logits = (float*)take((size_t)NT * 256 * 4);
    p.pre2b = (bf16_t*)take((size_t)NT * 1024 * 2); p.h1q = (unsigned char*)take((size_t)NT * 1024); p.gate = (float*)take((size_t)NT * 8 * 4); p.inv = (int*)take((size_t)NT * 8 * 4);
    p.w_gu8 = (unsigned char*)take((size_t)256 * 512 * 1024); p.w_dn8 = (unsigned char*)take((size_t)256 * 1024 * 256);
    p.act8 = (unsigned char*)take((size_t)(NT * 8 + 256 * 16 + 512) * 256); p.contrib8 = (unsigned char*)take((size_t)(NT * 8 + 256 * 16 + 512) * 1024);
    if (off > ws_size) return;
    (void)hipMemsetAsync(ws, 0, ctl_bytes, stream);
#if MK_PER_PHASE
    for (int i = 0; i < N_PHASES; ++i) { p.ph_lo = i; p.ph_hi = i + 1; hipLaunchKernelGGL(k_mega, dim3(grid), dim3(512), LDS_TOTAL, stream, p); }
#else
    p.ph_lo = 0; p.ph_hi = N_PHASES;
    hipLaunchKernelGGL(k_mega, dim3(grid), dim3(512), LDS_TOTAL, stream, p);
#ifdef PROBE_PHASE
    (void)hipMemsetAsync(ws, 0, XCD_BAR_WORDS * 4, stream);
    p.ph_lo = PROBE_PHASE; p.ph_hi = PROBE_PHASE + 1;
    hipLaunchKernelGGL(k_mega, dim3(grid), dim3(512), LDS_TOTAL, stream, p);
#endif
#endif
}
```

```cpp
#include <hip/hip_runtime.h>
#include <stdint.h>

namespace {
constexpr int B_ = 8, L_ = 2048, D_ = 1024, NT = B_ * L_;
constexpr int NE = 256, TOPK = 8;
constexpr int NSEG = 8, SEGCAP = 2048, CNT_STRIDE = 64;
constexpr float ALPHA = 1.189207115002721f;

__device__ __forceinline__ float gelu_tanh(float x) {
    const float z2 = 1.5957691216057308f * (x + 0.044715f * x * x * x);
    return x / (1.f + __expf(-z2));
}
__device__ __forceinline__ float wave_sum(float v) {
#pragma unroll
    for (int s = 32; s >= 1; s >>= 1) v += __shfl_xor(v, s);
    return v;
}
#define XB_TMO      128
#define XB_XCNT(j)  (256  + 64 * (j))
#define XB_XSUB(j)  (1280 + 64 * (j))
#define XB_XGEN(j)  (2304 + 64 * (j))
#define XB_TOP      3328
#define XB_TOPGEN   3392
#define XCD_BAR_WORDS 3456
#define XB_SPIN_CAP (1u << 18)
#define LAS __attribute__((address_space(3)))

__device__ __forceinline__ unsigned xb_ld(unsigned* p)              { return __hip_atomic_load(p, __ATOMIC_RELAXED, __HIP_MEMORY_SCOPE_AGENT); }
__device__ __forceinline__ unsigned xb_add(unsigned* p, unsigned v) { return __hip_atomic_fetch_add(p, v, __ATOMIC_RELAXED, __HIP_MEMORY_SCOPE_AGENT); }
__device__ __forceinline__ unsigned xb_xcc_id() { return (unsigned)__builtin_amdgcn_s_getreg((3 << 11) | 20) & 0xFu; }
#define XB_SPIN(cond, bar) do { unsigned _sp = 0; while (cond) { __builtin_amdgcn_s_sleep(1); \
    if ((++_sp & 255u) == 0u) { if (xb_ld(&(bar)[XB_TMO])) break; if (_sp > XB_SPIN_CAP) { atomicAdd(&(bar)[XB_TMO], 1u); break; } } } } while (0)

struct XcdBarrier {
    unsigned* bar; unsigned x;
    volatile LAS unsigned* st;
};

__device__ __forceinline__ XcdBarrier xcd_barrier_post(unsigned* bar, volatile LAS unsigned* st) {
    XcdBarrier b; b.bar = bar; b.x = xb_xcc_id(); b.st = st;
    if (threadIdx.x == 0) (void)xb_add(&bar[XB_XCNT(b.x)], 1u);
    return b;
}
__device__ __forceinline__ void xcd_barrier_complete(unsigned* bar, unsigned x, unsigned& nloc, unsigned& nx) {
    const unsigned G = gridDim.x * gridDim.y * gridDim.z;
    unsigned sum, cnt, mine, sp = 0u;
    for (;;) {
        sum = 0u; cnt = 0u; mine = 0u;
#pragma unroll
        for (unsigned j = 0; j < 16; ++j) { const unsigned c = xb_ld(&bar[XB_XCNT(j)]); sum += c; cnt += (c > 0u) ? 1u : 0u; mine = (j == x) ? c : mine; }
        if (sum == G) break;
        __builtin_amdgcn_s_sleep(1);
        if ((++sp & 255u) == 0u) { if (xb_ld(&bar[XB_TMO])) break; if (sp > XB_SPIN_CAP) { atomicAdd(&bar[XB_TMO], 1u); break; } }
    }
    nloc = mine > 0u ? mine : 1u; nx = cnt > 0u ? cnt : 1u;
}

__device__ __forceinline__ void xcd_barrier(const XcdBarrier& b) {
    asm volatile("s_waitcnt vmcnt(0)" ::: "memory");
    __syncthreads();
    if (threadIdx.x == 0) {
        unsigned* bar = b.bar;
        __builtin_amdgcn_s_waitcnt(0);
        unsigned nloc = b.st[0], nx = b.st[1];
        if (nloc == 0u) { xcd_barrier_complete(bar, b.x, nloc, nx); b.st[0] = nloc; b.st[1] = nx; }
        const unsigned old = xb_add(&bar[XB_XSUB(b.x)], 1u);
        const unsigned gen = old / nloc;
        if (old + 1u == (gen + 1u) * nloc) {
            __builtin_amdgcn_fence(__ATOMIC_RELEASE, "agent");
            asm volatile("s_waitcnt vmcnt(0)" ::: "memory");
            const unsigned og = xb_add(&bar[XB_TOP], 1u);
            const unsigned tg = og / nx;
            if (og + 1u == (tg + 1u) * nx) xb_add(&bar[XB_TOPGEN], 1u);
            else XB_SPIN(xb_ld(&bar[XB_TOPGEN]) == tg, bar);
            __builtin_amdgcn_fence(__ATOMIC_ACQUIRE, "agent");
            xb_add(&bar[XB_XGEN(b.x)], 1u);
            asm volatile("s_waitcnt vmcnt(0)" ::: "memory");
        } else {
            XB_SPIN(xb_ld(&bar[XB_XGEN(b.x)]) == gen, bar);
            __builtin_amdgcn_fence(__ATOMIC_ACQUIRE, "agent");
            asm volatile("s_waitcnt vmcnt(0)" ::: "memory");
        }
    }
    __syncthreads();
}


typedef unsigned short bf16_t;
typedef short bf16x8 __attribute__((ext_vector_type(8)));
typedef float f32x4 __attribute__((ext_vector_type(4)));
typedef unsigned u32x2 __attribute__((ext_vector_type(2)));
typedef unsigned u32x4 __attribute__((ext_vector_type(4)));
#define LDSP __attribute__((address_space(3)))
typedef short s16x4 __attribute__((ext_vector_type(4)));
__device__ __forceinline__ s16x4 vtr(const LDSP unsigned char* p) { return __builtin_bit_cast(s16x4, __builtin_amdgcn_ds_read_tr16_b64_v4i16((LDSP s16x4*)p)); }

__device__ __forceinline__ unsigned f2bf(float f) { unsigned u = __builtin_bit_cast(unsigned, f); return (u + 0x7fffu + ((u >> 16) & 1u)) >> 16; }
typedef float f32x2_t __attribute__((ext_vector_type(2))); typedef __bf16 bf16x2_t __attribute__((ext_vector_type(2)));
__device__ __forceinline__ unsigned pk2(float lo, float hi) { f32x2_t v = {lo, hi}; bf16x2_t b = __builtin_convertvector(v, bf16x2_t); return __builtin_bit_cast(unsigned, b); }
__device__ __forceinline__ float bf2f(unsigned short b) { return __builtin_bit_cast(float, (unsigned)b << 16); }
typedef int i32x4_t __attribute__((ext_vector_type(4))); typedef int i32x8_t __attribute__((ext_vector_type(8)));
constexpr float F8_SH = 4.f, F8_SW = 64.f, F8_SA = 8.f, F8_SC = 16.f;
__device__ __forceinline__ float f8clamp(float x) { return __builtin_amdgcn_fmed3f(x, -448.f, 448.f); }
__device__ __forceinline__ unsigned pk4f8(float a, float b, float c, float d) {
    unsigned w = 0;
    w = __builtin_amdgcn_cvt_pk_fp8_f32(f8clamp(a), f8clamp(b), w, false);
    w = __builtin_amdgcn_cvt_pk_fp8_f32(f8clamp(c), f8clamp(d), w, true);
    return w;
}
__device__ __forceinline__ f32x2_t f8lo(unsigned w) { return __builtin_amdgcn_cvt_pk_f32_fp8(w, false); }
__device__ __forceinline__ f32x2_t f8hi(unsigned w) { return __builtin_amdgcn_cvt_pk_f32_fp8(w, true); }
__device__ __forceinline__ void mfma_f8(f32x4& c, i32x8_t a, i32x8_t b) { asm volatile("v_mfma_f32_16x16x128_f8f6f4 %0, %1, %2, %0" : "+v"(c) : "v"(a), "v"(b)); }
__device__ __forceinline__ i32x8_t cat8(bf16x8 lo, bf16x8 hi) { return __builtin_shufflevector(__builtin_bit_cast(i32x4_t, lo), __builtin_bit_cast(i32x4_t, hi), 0, 1, 2, 3, 4, 5, 6, 7); }

struct RowId { __device__ __forceinline__ int operator()(int n) const { return n; } };
struct RowGU64 { __device__ __forceinline__ int operator()(int j) const { const int up = j >> 8, jj = j & 255; return (jj >> 5) * 64 + up * 32 + (jj & 31); } };
struct RowGU { __device__ __forceinline__ int operator()(int j) const { const int up = j >> 8, jj = j & 255; return (jj >> 7) * 256 + up * 128 + (jj & 127); } };
constexpr float QSCALE = 0.125f * 1.4426950408889634f;
struct ARowDense { const unsigned char* base; size_t ld; __device__ __forceinline__ const unsigned char* operator()(int r) const { return base + (size_t)r * ld; } };
typedef float f32x16 __attribute__((ext_vector_type(16)));
constexpr int ATT_UNITS = 3 * 64 * 64;
constexpr int ATT_VROW = 192, ATT_WLDS = 32 * ATT_VROW;
struct AttArgs { const bf16_t* q; const bf16_t* k; const bf16_t* v; bf16_t* opart; float* lse; };

__device__ __forceinline__ void attn_unit(const AttArgs& A, int u, LDSP unsigned char* vs, int lane) {
    const int c = u >> 12, rem = u & 4095, bh = rem >> 6, j = rem & 63;
    const int dsh = 2 * c, d = 1 << dsh, nblk = 64 >> dsh;
    const int r = j / nblk, a = j % nblk;
    const int l31 = lane & 31, h2 = lane >> 5;
    const bf16_t* Qb = A.q + (size_t)bh * 2048 * 64;
    const bf16_t* Kb = A.k + (size_t)bh * 2048 * 64;
    const bf16_t* Vb = A.v + (size_t)bh * 2048 * 64;
    const int sq = 32 * a + l31;
    const int tq = sq * d + r;
    bf16x8 qf[4];
    {
        const bf16_t* qp = Qb + (size_t)tq * 64 + 8 * h2;
#pragma unroll
        for (int s = 0; s < 4; ++s) qf[s] = *(const bf16x8*)(qp + 16 * s);
    }
    bf16x8 kf[5][4];
#pragma unroll
    for (int kt = 0; kt < 5; ++kt) {
        const int k0 = 32 * a - 128 + 32 * kt;
        const int kr = k0 >= 0 ? k0 + l31 : 0;
        const bf16_t* kp = Kb + (size_t)(kr * d + r) * 64 + 8 * h2;
#pragma unroll
        for (int s = 0; s < 4; ++s) kf[kt][s] = *(const bf16x8*)(kp + 16 * s);
    }
    u32x4 vreg[4];
#define ATT_VLOAD(kt_) do { const int k0_ = 32 * a - 128 + 32 * (kt_); _Pragma("unroll") for (int i = 0; i < 4; ++i) { const int id = lane + 64 * i, row = id >> 3, ch = id & 7; \
        const int vr_ = k0_ >= 0 ? k0_ + row : 0; vreg[i] = *(const u32x4*)(Vb + (size_t)(vr_ * d + r) * 64 + ch * 8); } } while (0)
    ATT_VLOAD(0);
    f32x16 S[5];
#pragma unroll
    for (int kt = 0; kt < 5; ++kt) {
        const int k0 = 32 * a - 128 + 32 * kt;
        f32x16 acc;
#pragma unroll
        for (int i = 0; i < 16; ++i) acc[i] = 0.f;
#pragma unroll
        for (int s = 0; s < 4; ++s) acc = __builtin_amdgcn_mfma_f32_32x32x16_bf16(kf[kt][s], qf[s], acc, 0, 0, 0);
        if (kt == 0 || kt == 4) {
#pragma unroll
            for (int i = 0; i < 16; ++i) {
                const int keyrow = (i & 3) + 8 * (i >> 2) + 4 * h2;
                const int dist = sq - (k0 + keyrow);
                if (dist < 0 || dist > 128) acc[i] = -INFINITY;
            }
        }
        if (k0 < 0) {
#pragma unroll
            for (int i = 0; i < 16; ++i) acc[i] = -INFINITY;
        }
        S[kt] = acc;
    }
    float m = -INFINITY;
#pragma unroll
    for (int kt = 0; kt < 5; ++kt)
#pragma unroll
        for (int i = 0; i < 16; ++i) m = fmaxf(m, S[kt][i]);
    m = fmaxf(m, __shfl_xor(m, 32));
    float l = 0.f;
#pragma unroll
    for (int kt = 0; kt < 5; ++kt)
#pragma unroll
        for (int i = 0; i < 16; ++i) { const float p = exp2f(S[kt][i] - m); S[kt][i] = p; l += p; }
    l += __shfl_xor(l, 32);
    f32x16 O[2];
#pragma unroll
    for (int dt = 0; dt < 2; ++dt)
#pragma unroll
        for (int i = 0; i < 16; ++i) O[dt][i] = 0.f;
    const int g = lane >> 4, li = lane & 15;
    const LDSP unsigned char* vrd = vs + (4 * (g >> 1) + (li >> 2)) * ATT_VROW + (16 * (g & 1) + 4 * (li & 3)) * 2;
#pragma unroll
    for (int kt = 0; kt < 5; ++kt) {
#pragma unroll
        for (int i = 0; i < 4; ++i) { const int id = lane + 64 * i, row = id >> 3, ch = id & 7; *(LDSP u32x4*)(vs + row * ATT_VROW + ch * 16) = vreg[i]; }
        if (kt < 4) ATT_VLOAD(kt + 1);
#pragma unroll
        for (int sp = 0; sp < 2; ++sp) {
            bf16x8 pf;
            {
                u32x4 w;
                w.x = pk2(S[kt][8 * sp + 0], S[kt][8 * sp + 1]); w.y = pk2(S[kt][8 * sp + 2], S[kt][8 * sp + 3]);
                w.z = pk2(S[kt][8 * sp + 4], S[kt][8 * sp + 5]); w.w = pk2(S[kt][8 * sp + 6], S[kt][8 * sp + 7]);
                pf = __builtin_bit_cast(bf16x8, w);
            }
#pragma unroll
            for (int dt = 0; dt < 2; ++dt) {
                const s16x4 lo = vtr(vrd + (16 * sp) * ATT_VROW + dt * 64);
                const s16x4 hi = vtr(vrd + (16 * sp + 8) * ATT_VROW + dt * 64);
                const bf16x8 vf = (bf16x8){lo[0], lo[1], lo[2], lo[3], hi[0], hi[1], hi[2], hi[3]};
                O[dt] = __builtin_amdgcn_mfma_f32_32x32x16_bf16(vf, pf, O[dt], 0, 0, 0);
            }
        }
    }
#undef ATT_VLOAD
    const float il = 1.f / l;
    const int b = bh >> 3, h = bh & 7;
    const size_t tok = (size_t)b * 2048 + tq;
    bf16_t* op = A.opart + ((size_t)c * NT + tok) * 512 + h * 64 + 4 * h2;
#pragma unroll
    for (int dt = 0; dt < 2; ++dt)
#pragma unroll
        for (int g4 = 0; g4 < 4; ++g4) {
            u32x2 w; w.x = pk2(O[dt][4 * g4 + 0] * il, O[dt][4 * g4 + 1] * il); w.y = pk2(O[dt][4 * g4 + 2] * il, O[dt][4 * g4 + 3] * il);
            *(u32x2*)(op + 32 * dt + 8 * g4) = w;
        }
    if (h2 == 0) A.lse[((size_t)c * NT + tok) * 8 + h] = m + log2f(l);
}
constexpr int AW_UNITS = 3 * 64 * 8, AW_KP = 144, AW_VP = 192, AW_KBYTES = 384 * AW_KP;
struct AwPre { u32x4 k[6], v[6]; bf16x8 q[4]; };
__device__ __forceinline__ int aw_key_token(int c, int j, int kk) {
    if (c == 2) { const int rr = (kk >> 7) & 1, ks = kk & 127; return ks * 16 + 2 * j + rr; }
    const int d = c ? 4 : 1, r = c ? (j >> 1) : 0, A = c ? (j & 1) : j;
    int ks = 256 * A - 128 + kk; ks = ks < 0 ? 0 : ks;
    return ks * d + r;
}
__device__ __forceinline__ void aw_wave_coords(int c, int j, int w, int l31, int& d, int& r, int& sq, int& k00, int& lrow00) {
    if (c == 2) { const int rr = w >> 2, a = w & 3; d = 16; r = 2 * j + rr; sq = 32 * a + l31; k00 = 32 * a - 128; lrow00 = rr * 128 + k00; }
    else { d = c ? 4 : 1; r = c ? (j >> 1) : 0; const int A = c ? (j & 1) : j; sq = 256 * A + 32 * w + l31; k00 = 256 * A + 32 * w - 128; lrow00 = 32 * w; }
}
__device__ __forceinline__ void aw_prefetch(const AttArgs& A, int U, AwPre& P, int tid) {
    const int c = U >> 9, rem = U & 511, bh = rem >> 3, j = rem & 7;
    const bf16_t* Kb = A.k + (size_t)bh * 2048 * 64; const bf16_t* Vb = A.v + (size_t)bh * 2048 * 64;
    const int ch = tid & 7, row0 = tid >> 3;
#pragma unroll
    for (int i = 0; i < 6; ++i) {
        const size_t off = (size_t)aw_key_token(c, j, row0 + 64 * i) * 64 + ch * 8;
        P.k[i] = *(const u32x4*)(Kb + off); P.v[i] = *(const u32x4*)(Vb + off);
    }
    const int lane = tid & 63, w = tid >> 6, l31 = lane & 31, h2 = lane >> 5;
    int d, r, sq, k00, lrow00; aw_wave_coords(c, j, w, l31, d, r, sq, k00, lrow00);
    const bf16_t* qp = A.q + ((size_t)bh * 2048 + (size_t)sq * d + r) * 64 + 8 * h2;
#pragma unroll
    for (int s_ = 0; s_ < 4; ++s_) P.q[s_] = *(const bf16x8*)(qp + 16 * s_);
}
__device__ __forceinline__ void aw_stage(const AwPre& P, LDSP unsigned char* lds, int tid) {
    const int ch = tid & 7, row0 = tid >> 3;
#pragma unroll
    for (int i = 0; i < 6; ++i) {
        *(LDSP u32x4*)(lds + (row0 + 64 * i) * AW_KP + ch * 16) = P.k[i];
        *(LDSP u32x4*)(lds + AW_KBYTES + (row0 + 64 * i) * AW_VP + ch * 16) = P.v[i];
    }
}
__device__ __forceinline__ void aw_compute(const AttArgs& A, int U, const bf16x8 (&qf)[4], const LDSP unsigned char* lds, int tid) {
    const int c = U >> 9, rem = U & 511, bh = rem >> 3, j = rem & 7;
    const int lane = tid & 63, w = __builtin_amdgcn_readfirstlane(tid >> 6), l31 = lane & 31, h2 = lane >> 5;
    int d, r, sq, k00, lrow00; aw_wave_coords(c, j, w, l31, d, r, sq, k00, lrow00);
    const int tq = sq * d + r;
    f32x16 S[5];
#pragma unroll
    for (int kt = 0; kt < 5; ++kt) {
        const int k0 = k00 + 32 * kt;
        int lrow = lrow00 + 32 * kt; lrow = lrow < 0 ? 0 : lrow;
        const LDSP unsigned char* kp = lds + (lrow + l31) * AW_KP + 16 * h2;
        f32x16 acc;
#pragma unroll
        for (int i = 0; i < 16; ++i) acc[i] = 0.f;
#pragma unroll
        for (int s_ = 0; s_ < 4; ++s_) acc = __builtin_amdgcn_mfma_f32_32x32x16_bf16(*(const LDSP bf16x8*)(kp + 32 * s_), qf[s_], acc, 0, 0, 0);
        if (kt == 0 || kt == 4) {
#pragma unroll
            for (int i = 0; i < 16; ++i) {
                const int keyrow = (i & 3) + 8 * (i >> 2) + 4 * h2;
                const int dist = sq - (k0 + keyrow);
                if (dist < 0 || dist > 128) acc[i] = -INFINITY;
            }
        }
        if (k0 < 0) {
#pragma unroll
            for (int i = 0; i < 16; ++i) acc[i] = -INFINITY;
        }
        S[kt] = acc;
    }
    float m = -INFINITY;
#pragma unroll
    for (int kt = 0; kt < 5; ++kt)
#pragma unroll
        for (int i = 0; i < 16; ++i) m = fmaxf(m, S[kt][i]);
    m = fmaxf(m, __shfl_xor(m, 32));
    float l = 0.f;
#pragma unroll
    for (int kt = 0; kt < 5; ++kt)
#pragma unroll
        for (int i = 0; i < 16; ++i) { const float pe = exp2f(S[kt][i] - m); S[kt][i] = pe; l += pe; }
    l += __shfl_xor(l, 32);
    f32x16 O[2];
#pragma unroll
    for (int dt = 0; dt < 2; ++dt)
#pragma unroll
        for (int i = 0; i < 16; ++i) O[dt][i] = 0.f;
    const int g = lane >> 4, li = lane & 15;
    const int vro = (4 * (g >> 1) + (li >> 2)) * AW_VP + (16 * (g & 1) + 4 * (li & 3)) * 2;
#pragma unroll
    for (int kt = 0; kt < 5; ++kt) {
        int lrow = lrow00 + 32 * kt; lrow = lrow < 0 ? 0 : lrow;
        const LDSP unsigned char* vrd = lds + AW_KBYTES + lrow * AW_VP + vro;
#pragma unroll
        for (int sp = 0; sp < 2; ++sp) {
            bf16x8 pf;
            {
                u32x4 w4;
                w4.x = pk2(S[kt][8 * sp + 0], S[kt][8 * sp + 1]); w4.y = pk2(S[kt][8 * sp + 2], S[kt][8 * sp + 3]);
                w4.z = pk2(S[kt][8 * sp + 4], S[kt][8 * sp + 5]); w4.w = pk2(S[kt][8 * sp + 6], S[kt][8 * sp + 7]);
                pf = __builtin_bit_cast(bf16x8, w4);
            }
#pragma unroll
            for (int dt = 0; dt < 2; ++dt) {
                const s16x4 lo = vtr(vrd + (16 * sp) * AW_VP + dt * 64);
                const s16x4 hi = vtr(vrd + (16 * sp + 8) * AW_VP + dt * 64);
                const bf16x8 vf = (bf16x8){lo[0], lo[1], lo[2], lo[3], hi[0], hi[1], hi[2], hi[3]};
                O[dt] = __builtin_amdgcn_mfma_f32_32x32x16_bf16(vf, pf, O[dt], 0, 0, 0);
            }
        }
    }
    const float il = 1.f / l;
    const int b = bh >> 3, h = bh & 7;
    const size_t tok = (size_t)b * 2048 + tq;
    bf16_t* op = A.opart + ((size_t)c * NT + tok) * 512 + h * 64 + 4 * h2;
#pragma unroll
    for (int dt = 0; dt < 2; ++dt)
#pragma unroll
        for (int g4 = 0; g4 < 4; ++g4) {
            u32x2 w2; w2.x = pk2(O[dt][4 * g4 + 0] * il, O[dt][4 * g4 + 1] * il); w2.y = pk2(O[dt][4 * g4 + 2] * il, O[dt][4 * g4 + 3] * il);
            *(u32x2*)(op + 32 * dt + 8 * g4) = w2;
        }
    if (h2 == 0) A.lse[((size_t)c * NT + tok) * 8 + h] = m + log2f(l);
}
struct SsmTabArgs { const float* lam_re; const float* lam_im; const float* log_step; const float* b_re; const float* b_im; const float* c_re; const float* c_im;
                    bf16_t* wendT; bf16_t* wcarT; bf16_t* klagT; float* a16; };
__device__ __forceinline__ void ssm_apow(const SsmTabArgs& A, int g, int p, float k, float& pr, float& pi) {
    const float lr = A.lam_re[g * 64 + p], li = A.lam_im[g * 64 + p], step = expf(A.log_step[g]);
    const float e = expf(k * lr * step); pr = e * cosf(k * li * step); pi = e * sinf(k * li * step);
}
__device__ __forceinline__ void ssm_coef(const SsmTabArgs& A, int g, int p, float& cr, float& ci) {
    const float lr = A.lam_re[g * 64 + p], li = A.lam_im[g * 64 + p];
    float ar, ai; ssm_apow(A, g, p, 1.f, ar, ai);
    const float nr = ar - 1.f, ni = ai, den = lr * lr + li * li;
    cr = (nr * lr + ni * li) / den; ci = (ni * lr - nr * li) / den;
}
__device__ __forceinline__ size_t ft_off(int n, int k, int K) { return ((size_t)((n >> 4) * (K >> 5) + (k >> 5)) << 9) + (((k >> 3) & 3) << 7) + ((n & 15) << 3) + (k & 7); }
__device__ __forceinline__ void ssm_tab_item(const SsmTabArgs& A, int it) {
    if (it < 32768) {
        const int s = it & 15, p = (it >> 4) & 63, g = it >> 10;
        float pr, pi, cr, ci; ssm_apow(A, g, p, (float)(15 - s), pr, pi); ssm_coef(A, g, p, cr, ci);
        const float mr = pr * cr - pi * ci, mi = pr * ci + pi * cr;
        bf16_t* wb = A.wendT + (size_t)g * 128 * 256;
#pragma unroll
        for (int c = 0; c < 16; ++c) {
            const float br = A.b_re[((size_t)g * 64 + p) * 16 + c], bi = A.b_im[((size_t)g * 64 + p) * 16 + c];
            wb[ft_off(p, s * 16 + c, 256)] = (bf16_t)f2bf(mr * br - mi * bi); wb[ft_off(64 + p, s * 16 + c, 256)] = (bf16_t)f2bf(mr * bi + mi * br);
        }
    } else if (it < 65536) {
        const int j = it - 32768; const int t = j & 15, p = (j >> 4) & 63, g = j >> 10;
        float pr, pi; ssm_apow(A, g, p, (float)(t + 1), pr, pi);
#pragma unroll
        for (int co = 0; co < 16; ++co) {
            const float cr = A.c_re[((size_t)g * 16 + co) * 64 + p], ci = A.c_im[((size_t)g * 16 + co) * 64 + p];
            bf16_t* wb = A.wcarT + (size_t)g * 256 * 128;
            wb[ft_off(t * 16 + co, p, 128)] = (bf16_t)f2bf(cr * pr - ci * pi); wb[ft_off(t * 16 + co, 64 + p, 128)] = (bf16_t)f2bf(-(cr * pi + ci * pr));
        }
    } else {
        const int j = it - 65536; const int p = j & 63, g = j >> 6;
        float pr, pi; ssm_apow(A, g, p, 16.f, pr, pi);
        A.a16[(size_t)j * 2] = pr; A.a16[(size_t)j * 2 + 1] = pi;
    }
}
constexpr int SSM_TAB_ITEMS = 65536 + 2048;
__device__ __forceinline__ void ssm_klag_item(const SsmTabArgs& A, int it, LDSP float* scr, int tid) {
    const int g = it >> 4, lag = it & 15;
    LDSP float* Mr = scr; LDSP float* Mi = scr + 1024; LDSP float* Cr = scr + 2048; LDSP float* Ci = scr + 3072;
    __syncthreads();
    if (tid < 64) {
        const int p = tid; float pr, pi, cr, ci; ssm_apow(A, g, p, (float)lag, pr, pi); ssm_coef(A, g, p, cr, ci);
        const float mr = pr * cr - pi * ci, mi = pr * ci + pi * cr;
#pragma unroll
        for (int c = 0; c < 16; ++c) {
            const float br = A.b_re[((size_t)g * 64 + p) * 16 + c], bi = A.b_im[((size_t)g * 64 + p) * 16 + c];
            Mr[p * 16 + c] = mr * br - mi * bi; Mi[p * 16 + c] = mr * bi + mi * br;
            Cr[p * 16 + c] = A.c_re[((size_t)g * 16 + c) * 64 + p]; Ci[p * 16 + c] = A.c_im[((size_t)g * 16 + c) * 64 + p];
        }
    }
    __syncthreads();
    if (tid < 256) {
        const int co = tid >> 4, ci_ = tid & 15; float acc = 0.f;
        for (int p = 0; p < 64; ++p) acc += Cr[p * 16 + co] * Mr[p * 16 + ci_] - Ci[p * 16 + co] * Mi[p * 16 + ci_];
        A.klagT[(((size_t)g * 16 + lag) * 16 + co) * 16 + ci_] = (bf16_t)f2bf(acc);
    }
}

struct SsmArgs { const bf16_t* u; const bf16_t* wendT; const bf16_t* wcarT; const bf16_t* klagT; const float* a16; const float* d_skip; bf16_t* yss; };
__device__ __forceinline__ void ssm_stage_u(LDSP unsigned char* lds, const bf16_t* ubase  , int hh, int tid) {
#pragma unroll
    for (int i = 0; i < 4; ++i) {
        const int id = tid + 512 * i, row = id >> 5, ch = id & 31;
        const u32x4 w = *(const u32x4*)(ubase + (size_t)(64 * hh + row) * 256 + ch * 8);
        *(LDSP u32x4*)(lds + (ch >> 3) * 8192 + row * 128 + (((ch & 7) ^ (row & 7)) * 16)) = w;
    }
}
__device__ __forceinline__ void ssm_unit(const SsmArgs& A, int bg, LDSP unsigned char* lds) {
    const int tid = threadIdx.x, lane = tid & 63, w = __builtin_amdgcn_readfirstlane(tid >> 6), fr = lane & 15, fq = lane >> 4;
    const int g = bg & 31, b = bg >> 5;
    const bf16_t* ubase = A.u + (size_t)bg * 2048 * 16;
    LDSP unsigned char* Ebuf = lds + 32768; LDSP unsigned char* Xbuf = lds + 98304;
    const bf16_t* wend = A.wendT + (size_t)g * 128 * 256;
    const bf16_t* wcar = A.wcarT + (size_t)g * 256 * 128;
    const bf16_t* klag = A.klagT + (size_t)g * 16 * 256;
    for (int hh = 0; hh < 2; ++hh) {
        __syncthreads();
        ssm_stage_u(lds, ubase, hh, tid);
        __syncthreads();
        f32x4 acc[4];
#pragma unroll
        for (int mi = 0; mi < 4; ++mi) acc[mi] = (f32x4){0.f, 0.f, 0.f, 0.f};
#pragma unroll
        for (int kk = 0; kk < 8; ++kk) {
            const bf16x8 wf = *(const bf16x8*)(wend + ((size_t)(w * 8 + kk) << 9) + lane * 8);
#pragma unroll
            for (int mi = 0; mi < 4; ++mi) {
                const bf16x8 af = *(const LDSP bf16x8*)(lds + (kk >> 1) * 8192 + (16 * mi + fr) * 128 + (((((kk & 1) * 4) + fq) ^ (fr & 7)) * 16));
                acc[mi] = __builtin_amdgcn_mfma_f32_16x16x32_bf16(wf, af, acc[mi], 0, 0, 0);
            }
        }
#pragma unroll
        for (int mi = 0; mi < 4; ++mi) *(LDSP f32x4*)(Ebuf + ((64 * hh + 16 * mi + fr) * 128 + 16 * w + 4 * fq) * 4) = acc[mi];
    }
    __syncthreads();
    {
        const float ar = A.a16[((size_t)g * 64 + lane) * 2], ai = A.a16[((size_t)g * 64 + lane) * 2 + 1];
        LDSP float* Tb = (LDSP float*)(lds + 131072);
        float Lr[16], Li[16];
        float cr = 0.f, ci = 0.f;
#pragma unroll
        for (int j = 0; j < 16; ++j) {
            const int c = 16 * w + j;
            const float er = *(const LDSP float*)(Ebuf + (c * 128 + lane) * 4), ei = *(const LDSP float*)(Ebuf + (c * 128 + 64 + lane) * 4);
            Lr[j] = cr; Li[j] = ci;
            const float nr = ar * cr - ai * ci + er, ni = ar * ci + ai * cr + ei;
            cr = nr; ci = ni;
        }
        Tb[w * 128 + lane] = cr; Tb[w * 128 + 64 + lane] = ci;
        float pr = ar, pi = ai;
#pragma unroll
        for (int q = 0; q < 4; ++q) { const float tr = pr * pr - pi * pi, ti = 2.f * pr * pi; pr = tr; pi = ti; }
        __syncthreads();
        float gr = 0.f, gi = 0.f;
        for (int v = 0; v < w; ++v) {
            const float tr = Tb[v * 128 + lane], ti = Tb[v * 128 + 64 + lane];
            const float nr = pr * gr - pi * gi + tr, ni = pr * gi + pi * gr + ti;
            gr = nr; gi = ni;
        }
        const int xo = (lane >> 3), xb = (lane & 7) * 2;
        float qr = 1.f, qi = 0.f;
#pragma unroll
        for (int j = 0; j < 16; ++j) {
            const int c = 16 * w + j;
            const float xr = Lr[j] + qr * gr - qi * gi, xi = Li[j] + qr * gi + qi * gr;
            const int off = c * 128 + ((xo ^ (c & 7)) * 16) + xb;
            *(LDSP bf16_t*)(Xbuf + off) = (bf16_t)f2bf(xr);
            *(LDSP bf16_t*)(Xbuf + 16384 + off) = (bf16_t)f2bf(xi);
            const float tr = qr * ar - qi * ai, ti = qr * ai + qi * ar; qr = tr; qi = ti;
        }
    }
    __syncthreads();
    for (int hx = 0; hx < 2; ++hx) {
        const int hh = 1 - hx;
        if (hx == 1) { __syncthreads(); ssm_stage_u(lds, ubase, hh, tid); __syncthreads(); }
        f32x4 acc[4][2];
#pragma unroll
        for (int mi = 0; mi < 4; ++mi) { acc[mi][0] = (f32x4){0.f, 0.f, 0.f, 0.f}; acc[mi][1] = (f32x4){0.f, 0.f, 0.f, 0.f}; }
#pragma unroll
        for (int j = 0; j < 2; ++j) {
            const int t = j ? (15 - w) : w;
#pragma unroll
            for (int kk = 0; kk < 8; ++kk) {
                if (2 * kk <= t) {
                    const int s = 2 * kk + (fq >> 1);
                    bf16x8 wf = (bf16x8){0, 0, 0, 0, 0, 0, 0, 0};
                    if (s <= t) wf = *(const bf16x8*)(klag + ((size_t)(t - s) * 16 + fr) * 16 + 8 * (fq & 1));
#pragma unroll
                    for (int mi = 0; mi < 4; ++mi) {
                        const bf16x8 af = *(const LDSP bf16x8*)(lds + (kk >> 1) * 8192 + (16 * mi + fr) * 128 + (((((kk & 1) * 4) + fq) ^ (fr & 7)) * 16));
                        acc[mi][j] = __builtin_amdgcn_mfma_f32_16x16x32_bf16(wf, af, acc[mi][j], 0, 0, 0);
                    }
                }
            }
#pragma unroll
            for (int k2 = 0; k2 < 4; ++k2) {
                const bf16x8 wf = *(const bf16x8*)(wcar + ((size_t)(t * 4 + k2) << 9) + lane * 8);
#pragma unroll
                for (int mi = 0; mi < 4; ++mi) {
                    const int row = 64 * hh + 16 * mi + fr;
                    const bf16x8 xf = *(const LDSP bf16x8*)(Xbuf + (k2 >> 1) * 16384 + row * 128 + (((((k2 & 1) * 4) + fq) ^ (fr & 7)) * 16));
                    acc[mi][j] = __builtin_amdgcn_mfma_f32_16x16x32_bf16(wf, xf, acc[mi][j], 0, 0, 0);
                }
            }
        }
        const float4 dk = *(const float4*)(A.d_skip + g * 16 + 4 * fq);
#pragma unroll
        for (int j = 0; j < 2; ++j) {
            const int t = j ? (15 - w) : w;
#pragma unroll
            for (int mi = 0; mi < 4; ++mi) {
                const int tt = (64 * hh + 16 * mi + fr) * 16 + t;
                const u32x2 uw = *(const u32x2*)(ubase + (size_t)tt * 16 + 4 * fq);
                const f32x4 a = acc[mi][j];
                const float y0 = gelu_tanh(a[0] + dk.x * bf2f(uw.x & 0xffff)), y1 = gelu_tanh(a[1] + dk.y * bf2f(uw.x >> 16));
                const float y2 = gelu_tanh(a[2] + dk.z * bf2f(uw.y & 0xffff)), y3 = gelu_tanh(a[3] + dk.w * bf2f(uw.y >> 16));
                u32x2 o; o.x = pk2(y0, y1); o.y = pk2(y2, y3);
                *(u32x2*)(A.yss + ((size_t)b * 2048 + tt) * 512 + g * 16 + 4 * fq) = o;
            }
        }
    }
}
__device__ __forceinline__ float silu_f(float g) { return g / (1.f + __expf(-g)); }
constexpr int ME_LDS = 147456;
namespace pg {
constexpr int BM = 256, BK = 64, HALF = 128, HTB = HALF * BK * 2, STAGE_BYTES = 8 * HTB;
constexpr int VA_SLOT_OFF = 151552;
__device__ __forceinline__ int lds_byte(int r, int c) { const int st = (r >> 4) * 2 + (c >> 5), rr = r & 15, cc = c & 31, ob = rr * 64 + cc * 2; return st * 1024 + (ob ^ (((ob >> 9) & 1) << 5)); }
__device__ __forceinline__ void stage_rc(int b, int& R, int& C) { const int st = b / 1024, sb = b % 1024, swz = sb ^ (((sb >> 9) & 1) << 5); R = (st >> 1) * 16 + swz / 64; C = (st & 1) * 32 + (swz % 64) / 2; }
struct Unit { const char* A; const char* B; int x0, x1, x2, x3; };
struct LaneRC { int R0, C0, R1, C1; };
__device__ __forceinline__ LaneRC lane_rc() { LaneRC l; stage_rc(threadIdx.x * 16, l.R0, l.C0); stage_rc(threadIdx.x * 16 + 8192, l.R1, l.C1); return l; }
__device__ __forceinline__ LaneRC lane_rc_fresh() { int t = threadIdx.x; asm volatile("" : "+v"(t)); LaneRC l; stage_rc(t * 16, l.R0, l.C0); stage_rc(t * 16 + 8192, l.R1, l.C1); return l; }
struct VA { unsigned v00, v01, v10, v11; };
__device__ __forceinline__ VA dense_va(unsigned lda  ) {
    const LaneRC l = lane_rc(); VA v;
    v.v00 = l.R0 * lda + l.C0 * 2; v.v01 = l.R1 * lda + l.C1 * 2; v.v10 = (128 + l.R0) * lda + l.C0 * 2; v.v11 = (128 + l.R1) * lda + l.C1 * 2; return v;
}
__device__ __forceinline__ int perm32(int rho) { const int n = rho >> 4, i = rho & 15; return 8 * (i >> 2) + 4 * n + (i & 3); }
__device__ __forceinline__ int ragged_row(int h, int R) { return 16 * (2 * (4 * h + ((R >> 4) & 3)) + (R >> 6)) + (R & 15); }
template <bool GATHER, int PERM, bool RAGGED, bool F8, class Sched, class Epi>
__device__ __forceinline__ void gemm_phase(LDSP unsigned char* lds, const int K, const Sched& S, const Epi& E) {
    const int tid = threadIdx.x, wid = __builtin_amdgcn_readfirstlane(tid >> 6), lane = tid & 63, wr = wid >> 2, wc = wid & 3, fr = lane & 15, fq = lane >> 4;
    const int nt = K / BK;
    unsigned voffB[2];
    { int R, C; stage_rc(tid * 16, R, C); if (PERM == 1) R = (R & ~31) + perm32(R & 31); if (PERM == 2) R = 64 * (R >> 5) + 16 * ((R >> 2) & 3) + 4 * ((R >> 4) & 1) + (R & 3); voffB[0] = (unsigned)(R * K + C) * 2u;
      stage_rc(tid * 16 + 8192, R, C); if (PERM == 1) R = (R & ~31) + perm32(R & 31); if (PERM == 2) R = 64 * (R >> 5) + 16 * ((R >> 2) & 3) + 4 * ((R >> 4) & 1) + (R & 3); voffB[1] = (unsigned)(R * K + C) * 2u; }
    const size_t kstep = (size_t)(BK * 2), hstepB = (size_t)(PERM == 2 ? 8 : HALF) * K * 2;
    const unsigned ldsw = (unsigned)wid * 1024u;
    const int aoff = lds_byte(wr * 64 + fr, fq * 8), boff = lds_byte(wc * 32 + fr, fq * 8);
#define PG_SA(b, h) (((b) * 2 + (h)) * HTB)
#define PG_SB(b, h) ((4 + (b) * 2 + (h)) * HTB)
#define PG_STAGE(bufoff, gbase, v0, v1) do { \
        __builtin_amdgcn_global_load_lds((const unsigned*)((const char*)(gbase) + (v0)), (LDSP unsigned*)(lds + (bufoff) + ldsw), 16, 0, 0); \
        __builtin_amdgcn_global_load_lds((const unsigned*)((const char*)(gbase) + (v1)), (LDSP unsigned*)(lds + (bufoff) + ldsw + 8192), 16, 0, 0); } while (0)
#define PG_LDA(dst, b, h) do { _Pragma("unroll") for (int m = 0; m < 4; ++m) _Pragma("unroll") for (int k = 0; k < 2; ++k) dst[m][k] = *(const LDSP bf16x8*)(lds + PG_SA(b, h) + aoff + m * 2048 + k * 1024); } while (0)
#define PG_LDB(dst, b, h) do { _Pragma("unroll") for (int n = 0; n < 2; ++n) _Pragma("unroll") for (int k = 0; k < 2; ++k) dst[n][k] = *(const LDSP bf16x8*)(lds + PG_SB(b, h) + boff + n * 2048 + k * 1024); } while (0)
#define PG_MMA(ai, bj, At, Bt, ML) do { __builtin_amdgcn_s_setprio(1); _Pragma("unroll") for (int m = 0; m < (ML); ++m) { _Pragma("unroll") for (int n = 0; n < 2; ++n) { \
        if constexpr (F8) mfma_f8(acc[ai][bj][m][n], cat8(Bt[n][0], Bt[n][1]), cat8(At[m][0], At[m][1])); \
        else { _Pragma("unroll") for (int k = 0; k < 2; ++k) acc[ai][bj][m][n] = __builtin_amdgcn_mfma_f32_16x16x32_bf16(Bt[n][k], At[m][k], acc[ai][bj][m][n], 0, 0, 0); } } } __builtin_amdgcn_s_setprio(0); } while (0)
#define PG_WAIT_V(n) asm volatile("s_waitcnt vmcnt(" #n ")" ::: "memory")
#define PG_WAIT_L(n) asm volatile("s_waitcnt lgkmcnt(" #n ")" ::: "memory")
#define PG_BAR __builtin_amdgcn_s_barrier()
#define PG_SCHED __builtin_amdgcn_sched_barrier(0)
    Unit cur, nxt; int ui = 0;
    if (!S.next(0, cur)) return;
    f32x4 acc[2][2][4][2];
#pragma unroll
    for (int a = 0; a < 2; ++a)
#pragma unroll
        for (int b = 0; b < 2; ++b)
#pragma unroll
            for (int m = 0; m < 4; ++m)
#pragma unroll
                for (int n = 0; n < 2; ++n) acc[a][b][m][n] = (f32x4){0.f, 0.f, 0.f, 0.f};
    bf16x8 At[4][2], B0[2][2], B1[2][2];
    const char* cA = cur.A; const char* cB = cur.B;
    int nvc = RAGGED ? cur.x1 : 256;
    VA cva = S.va(cur);
    PG_STAGE(PG_SB(0, 0), cB, voffB[0], voffB[1]); PG_STAGE(PG_SB(0, 1), cB + hstepB, voffB[0], voffB[1]);
    PG_STAGE(PG_SA(0, 0), cA, cva.v00, cva.v01); PG_STAGE(PG_SA(0, 1), cA, cva.v10, cva.v11);
    if (wr == 1) PG_BAR;
    PG_WAIT_V(2); PG_BAR;
    PG_STAGE(PG_SB(1, 0), cB + kstep, voffB[0], voffB[1]); PG_STAGE(PG_SA(1, 0), cA + kstep, cva.v00, cva.v01); PG_STAGE(PG_SB(1, 1), cB + hstepB + kstep, voffB[0], voffB[1]);
    PG_WAIT_V(6); PG_BAR;
    for (;;) {
        const bool has_next = S.next(ui + 1, nxt);
        const char* nA = has_next ? nxt.A : cA; const char* nB = has_next ? nxt.B : cB;
        if constexpr (GATHER) {
            VA nva_ = cva; if (has_next) nva_ = S.va(nxt);
            *(LDSP u32x4*)(lds + VA_SLOT_OFF + tid * 16) = (u32x4){nva_.v00, nva_.v01, nva_.v10, nva_.v11};
        }
#define PG_BODY(M1) do { \
              \
            PG_LDB(B0, 0, 0); PG_LDB(B1, 0, 1); PG_SCHED; PG_LDA(At, 0, 0); PG_STAGE(PG_SA(1, 1), a1, cva.v10, cva.v11); \
            PG_WAIT_V(8); PG_WAIT_L(0); PG_BAR; PG_MMA(0, 0, At, B0, 4); PG_MMA(0, 1, At, B1, 4); PG_BAR; PG_SCHED; \
            PG_LDA(At, 0, 1); PG_STAGE(PG_SB(0, 0), b2, voffB[0], voffB[1]); PG_STAGE(PG_SB(0, 1), b2 + hstepB, voffB[0], voffB[1]); PG_STAGE(PG_SA(0, 0), a2, v00, v01); \
            PG_WAIT_V(8); PG_WAIT_L(0); PG_BAR; PG_MMA(1, 0, At, B0, M1); PG_MMA(1, 1, At, B1, M1); PG_BAR; PG_SCHED; \
              \
            PG_LDB(B0, 1, 0); PG_LDB(B1, 1, 1); PG_SCHED; PG_LDA(At, 1, 0); PG_STAGE(PG_SA(0, 1), a2, v10, v11); \
            PG_WAIT_V(8); PG_WAIT_L(0); PG_BAR; PG_MMA(0, 0, At, B0, 4); PG_MMA(0, 1, At, B1, 4); PG_BAR; PG_SCHED; \
            PG_LDA(At, 1, 1); PG_STAGE(PG_SB(1, 0), b3, voffB[0], voffB[1]); PG_STAGE(PG_SB(1, 1), b3 + hstepB, voffB[0], voffB[1]); PG_STAGE(PG_SA(1, 0), a3, v00, v01); \
            PG_WAIT_V(8); PG_WAIT_L(0); PG_BAR; PG_MMA(1, 0, At, B0, M1); PG_MMA(1, 1, At, B1, M1); PG_BAR; PG_SCHED; } while (0)
#define PG_TLOOP(M1) do { _Pragma("unroll 1") for (int t = 0; t < nt; t += 2) { \
            const bool last = (t == nt - 2); \
            const char* a1 = cA + (size_t)(t + 1) * kstep; \
            const char* a2 = last ? nA : cA + (size_t)(t + 2) * kstep; const char* b2 = last ? nB : cB + (size_t)(t + 2) * kstep; \
            const char* a3 = a2 + kstep; const char* b3 = b2 + kstep; \
            unsigned v00 = cva.v00, v01 = cva.v01, v10 = cva.v10, v11 = cva.v11; \
            asm volatile("" : "+v"(voffB[0]), "+v"(voffB[1]));        \
            if constexpr (GATHER) { if (last) { const u32x4 q_ = *(const LDSP u32x4*)(lds + VA_SLOT_OFF + tid * 16); v00 = q_.x; v01 = q_.y; v10 = q_.z; v11 = q_.w; } } \
            PG_BODY(M1); } } while (0)
        if constexpr (RAGGED) {
            if (nvc > 192) PG_TLOOP(4); else if (nvc > 128) PG_TLOOP(2); else PG_TLOOP(0);
        } else PG_TLOOP(4);
#undef PG_TLOOP
#undef PG_BODY
        if (wr == 0) PG_BAR;
        if constexpr (F8) asm volatile("s_nop 15\n\ts_nop 15" ::: "memory");
        E(acc, cur, wr, wc, fr, fq);
        if (!has_next) break;
#pragma unroll
        for (int a = 0; a < 2; ++a)
#pragma unroll
            for (int b = 0; b < 2; ++b)
#pragma unroll
                for (int m = 0; m < 4; ++m)
#pragma unroll
                    for (int n = 0; n < 2; ++n) acc[a][b][m][n] = (f32x4){0.f, 0.f, 0.f, 0.f};
        cur = nxt; cA = nA; cB = nB; ++ui; if (RAGGED) nvc = cur.x1;
        if constexpr (GATHER) { const u32x4 q_ = *(const LDSP u32x4*)(lds + VA_SLOT_OFF + tid * 16); cva.v00 = q_.x; cva.v01 = q_.y; cva.v10 = q_.z; cva.v11 = q_.w; }
        if (wr == 1) PG_BAR;
    }
    PG_WAIT_V(0);
    PG_BAR;
#undef PG_SA
#undef PG_SB
#undef PG_STAGE
#undef PG_LDA
#undef PG_LDB
#undef PG_MMA
#undef PG_WAIT_V
#undef PG_WAIT_L
#undef PG_BAR
#undef PG_SCHED
}
template <class F, class V> struct SchedF { F f; V v; __device__ __forceinline__ bool next(int i, Unit& u) const { return f(i, u); } __device__ __forceinline__ VA va(const Unit& u) const { return v(u); } };
template <class F, class V> __device__ __forceinline__ SchedF<F, V> sched(F f, V v) { return SchedF<F, V>{f, v}; }
template <class F> struct EpiFrag {
    F f;
    __device__ __forceinline__ void operator()(const f32x4 (&acc)[2][2][4][2], const Unit& u, int wr, int wc, int fr, int fq) const {
#pragma unroll
        for (int ai = 0; ai < 2; ++ai)
#pragma unroll
            for (int m = 0; m < 4; ++m) {
                int rr_ = 128 * ai + 64 * wr + 16 * m + fr;
                asm volatile("" : "+v"(rr_));
#pragma unroll
                for (int bj = 0; bj < 2; ++bj)
#pragma unroll
                    for (int n = 0; n < 2; ++n) f(u, rr_, 128 * bj + 32 * wc + 16 * n + 4 * fq, acc[ai][bj][m][n]);
                asm volatile("" ::: "memory");
            }
    }
};
template <class F> __device__ __forceinline__ EpiFrag<F> epi_frag(F f) { return EpiFrag<F>{f}; }
template <class F> struct EpiRow8 {
    F f;
    __device__ __forceinline__ void operator()(const f32x4 (&acc)[2][2][4][2], const Unit& u, int wr, int wc, int fr, int fq) const {
#pragma unroll
        for (int ai = 0; ai < 2; ++ai)
#pragma unroll
            for (int m = 0; m < 4; ++m) {
                int rr_ = 128 * ai + 64 * wr + 16 * m + fr;
                asm volatile("" : "+v"(rr_));
#pragma unroll
                for (int bj = 0; bj < 2; ++bj) f(u, rr_, 128 * bj + 32 * wc + 8 * fq, acc[ai][bj][m][0], acc[ai][bj][m][1]);
                asm volatile("" ::: "memory");
            }
    }
};
template <class F> __device__ __forceinline__ EpiRow8<F> epi_row8(F f) { return EpiRow8<F>{f}; }
__device__ __forceinline__ u32x4 pack8(f32x4 a, f32x4 b) { u32x4 w; w.x = pk2(a[0], a[1]); w.y = pk2(a[2], a[3]); w.z = pk2(b[0], b[1]); w.w = pk2(b[2], b[3]); return w; }
__device__ __forceinline__ bool static_tile(int i, int nM, int nN, int& pm, int& pn) {
    const int nwg = nM * nN; const long L = (long)i * gridDim.x + blockIdx.x; if (L >= nwg) return false;
    int wgid = (int)L; { const int q = nwg / 8, r = nwg % 8, xcd = wgid % 8, off = wgid / 8; wgid = (xcd < r ? xcd * (q + 1) : r * (q + 1) + (xcd - r) * q) + off; }
    const int nig = 8 * nN, gid = wgid / nig, fm = gid * 8, gsz = (nM - fm) < 8 ? (nM - fm) : 8;
    pm = fm + ((wgid % nig) % gsz); pn = (wgid % nig) / gsz; return true;
}
}

__device__ __forceinline__ int moe_ntiles(int c) { return (c + 255) >> 8; }
__device__ __forceinline__ void moe_tile_rows(int c, int j, int& row0, int& nvalid) {
    const int nte = (c + 255) >> 8, rpt = nte ? (((c + nte - 1) / nte + 15) & ~15) : 0;
    row0 = j * rpt; nvalid = min(c - row0, rpt);
}
constexpr int LDS_SP = 131072, LDS_CT = LDS_SP + 256 * NSEG * 4, LDS_WT = LDS_CT + 1024;
template <bool COMPACT>
__device__ __forceinline__ void moe_tile_table(const int* cntp, int* ctab, LDSP unsigned char* lds, LDSP int* ts, int tid) {
    LDSP int* sp = (LDSP int*)(lds + LDS_SP); LDSP int* ct = (LDSP int*)(lds + LDS_CT); LDSP int* wt = (LDSP int*)(lds + LDS_WT);
    const int lane = tid & 63, wid = tid >> 6;
    __syncthreads();
    int c = 0;
    if (tid < 256) {
        int v[NSEG];
        if constexpr (COMPACT) {
            const i32x4_t a0 = *(const i32x4_t*)(ctab + tid * NSEG), a1 = *(const i32x4_t*)(ctab + tid * NSEG + 4);
            v[0] = a0[0]; v[1] = a0[1]; v[2] = a0[2]; v[3] = a0[3]; v[4] = a1[0]; v[5] = a1[1]; v[6] = a1[2]; v[7] = a1[3];
        } else {
#pragma unroll
            for (int sg = 0; sg < NSEG; ++sg) v[sg] = __hip_atomic_load(cntp + (size_t)(sg * 256 + tid) * CNT_STRIDE, __ATOMIC_RELAXED, __HIP_MEMORY_SCOPE_AGENT);
            *(i32x4_t*)(ctab + tid * NSEG) = (i32x4_t){v[0], v[1], v[2], v[3]}; *(i32x4_t*)(ctab + tid * NSEG + 4) = (i32x4_t){v[4], v[5], v[6], v[7]};
        }
#pragma unroll
        for (int sg = 0; sg < NSEG; ++sg) { sp[tid * NSEG + sg] = c; c += v[sg]; }
        ct[tid] = c;
    }
    const int own_t = (c + 255) >> 8, own_a = (c + 15) & ~15;
    int st = own_t, sa = own_a;
#pragma unroll
    for (int d = 1; d < 64; d <<= 1) { const int x = __shfl_up(st, d), y = __shfl_up(sa, d); if (lane >= d) { st += x; sa += y; } }
    if (lane == 63 && wid < 4) { wt[wid * 2] = st; wt[wid * 2 + 1] = sa; }
    __syncthreads();
    if (tid < 256) {
        for (int w2 = 0; w2 < wid; ++w2) { st += wt[w2 * 2]; sa += wt[w2 * 2 + 1]; }
        ts[tid] = st - own_t; ts[260 + tid] = sa - own_a;
        if (tid == 255) ts[256] = st;
    }
    __syncthreads();
}
__device__ __forceinline__ int moe_find_expert(const LDSP int* ts, int tile) {
    int lo = 0, hi = 256;
    while (hi - lo > 1) { const int mid = (lo + hi) >> 1; if (ts[mid] <= tile) lo = mid; else hi = mid; }
    return lo;
}
struct MoeUnit { int e, pn, row0, nvalid, arow0; };
constexpr int MOE_UD_OFF = 2176, MOE_UD_MAX = 56;
__device__ __forceinline__ MoeUnit moe_unit(const LDSP int* ts, const LDSP int* ct, int o, int npn) {
    MoeUnit u; u.e = moe_find_expert(ts, o / npn);
    const int nte = ts[u.e + 1] - ts[u.e], local = o - npn * ts[u.e];
    u.pn = local / nte; const int j = local - u.pn * nte;
    const int c = ct[u.e];
    moe_tile_rows(c, j, u.row0, u.nvalid); u.arow0 = ts[260 + u.e] + u.row0;
    return u;
}
__device__ __forceinline__ int moe_build_units(const LDSP int* ts, const LDSP int* cnt, int first, int last, int step, int npn, LDSP int* ud, int tid) {
    const int n = first < last ? (last - first + step - 1) / step : 0;
    if (tid < n && tid < MOE_UD_MAX) { const MoeUnit mu = moe_unit(ts, cnt, first + tid * step, npn); LDSP int* d = ud + tid * 5; d[0] = mu.e; d[1] = mu.pn; d[2] = mu.row0; d[3] = mu.nvalid > 0 ? mu.nvalid : 0; d[4] = mu.arow0; }
    __syncthreads();
    return n < MOE_UD_MAX ? n : MOE_UD_MAX;
}
__device__ __forceinline__ void unit_range(int U, int& first, int& last, int& step) {
    const int G = gridDim.x;
    if (G & 7) { first = blockIdx.x; last = U; step = G; return; }
    const int x = blockIdx.x & 7, r = blockIdx.x >> 3;
    first = (int)(((long)x * U) >> 3) + r; last = (int)(((long)(x + 1) * U) >> 3); step = G >> 3;
}
struct FinArgs { const bf16_t* pre2b; const unsigned char* contrib8; const float* gate; const int* inv; const float* g; const float* b; float* out; };
struct FinRows { u32x2 c0[8], c1[8]; u32x4 p0, p1; };
__device__ __forceinline__ void fin_index(const FinArgs& A, const LDSP int* ab, const LDSP int* sp, int tok, int lane, int& rowk, float& gk) {
    const int l8 = lane & 7;
    const int w = A.inv[(size_t)tok * 8 + l8]; rowk = ab[w >> 16] + sp[(w >> 16) * NSEG + ((w >> 11) & (NSEG - 1))] + (w & 2047); gk = A.gate[(size_t)tok * 8 + l8] * (1.f / F8_SC);
}
__device__ __forceinline__ void fin_rows(const FinArgs& A, int rowk, int tok, int lane, FinRows& R) {
#pragma unroll
    for (int k = 0; k < 8; ++k) {
        const int row = __shfl(rowk, k);
        const unsigned char* cp = A.contrib8 + (size_t)row * 1024 + lane * 8;
        R.c0[k] = *(const u32x2*)cp; R.c1[k] = *(const u32x2*)(cp + 512);
    }
    const bf16_t* pp = A.pre2b + (size_t)tok * 1024 + lane * 8;
    R.p0 = *(const u32x4*)pp; R.p1 = *(const u32x4*)(pp + 512);
}
__device__ __forceinline__ void fin_finish(const FinArgs& A, const FinRows& R, float gk, int tok, int lane) {
    const u32x4 p0 = R.p0, p1 = R.p1;
    f32x4 v[4];
    v[0] = (f32x4){bf2f(p0.x & 0xffff), bf2f(p0.x >> 16), bf2f(p0.y & 0xffff), bf2f(p0.y >> 16)}; v[1] = (f32x4){bf2f(p0.z & 0xffff), bf2f(p0.z >> 16), bf2f(p0.w & 0xffff), bf2f(p0.w >> 16)};
    v[2] = (f32x4){bf2f(p1.x & 0xffff), bf2f(p1.x >> 16), bf2f(p1.y & 0xffff), bf2f(p1.y >> 16)}; v[3] = (f32x4){bf2f(p1.z & 0xffff), bf2f(p1.z >> 16), bf2f(p1.w & 0xffff), bf2f(p1.w >> 16)};
#pragma unroll
    for (int k = 0; k < 8; ++k) {
        const float gt = __shfl(gk, k);
        const unsigned w4[4] = {R.c0[k].x, R.c0[k].y, R.c1[k].x, R.c1[k].y};
#pragma unroll
        for (int i = 0; i < 4; ++i) {
            const f32x2_t lo = f8lo(w4[i]), hi = f8hi(w4[i]);
            v[i][0] += gt * lo[0]; v[i][1] += gt * lo[1]; v[i][2] += gt * hi[0]; v[i][3] += gt * hi[1];
        }
    }
    float s_ = 0.f;
#pragma unroll
    for (int i = 0; i < 4; ++i) s_ += (v[i][0] + v[i][1]) + (v[i][2] + v[i][3]);
    const float mu = wave_sum(s_) * (1.f / 1024.f);
    float q = 0.f;
#pragma unroll
    for (int i = 0; i < 4; ++i) { const f32x4 d = v[i] - mu; q += (d[0] * d[0] + d[1] * d[1]) + (d[2] * d[2] + d[3] * d[3]); }
    const float rstd = rsqrtf(wave_sum(q) * (1.f / 1024.f) + 1e-5f);
    const int co[4] = {lane * 8, lane * 8 + 4, 512 + lane * 8, 516 + lane * 8};
#pragma unroll
    for (int i = 0; i < 4; ++i) {
        const f32x4 gg = *(const f32x4*)(A.g + co[i]), bb = *(const f32x4*)(A.b + co[i]);
        *(f32x4*)(A.out + (size_t)tok * 1024 + co[i]) = (v[i] - mu) * rstd * gg + bb;
    }
}
__device__ __forceinline__ void final_tokens(const FinArgs& A, const LDSP int* ab, const LDSP int* sp, int t0, int S, int lane) {
    if (t0 >= NT) return;
    int tok = t0, rk0, rk1; float g0, g1;
    fin_index(A, ab, sp, tok, lane, rk0, g0);
    FinRows R0; fin_rows(A, rk0, tok, lane, R0);
    int tok1 = tok + S, tk1 = tok1 < NT ? tok1 : tok;
    fin_index(A, ab, sp, tk1, lane, rk1, g1);
#pragma unroll 1
    for (;;) {
        FinRows R1; fin_rows(A, rk1, tk1, lane, R1);
        const int tok2 = tok1 + S, tk2 = tok2 < NT ? tok2 : tk1;
        int rk2; float g2; fin_index(A, ab, sp, tk2, lane, rk2, g2);
        fin_finish(A, R0, g0, tok, lane);
        if (tok1 >= NT) break;
        R0 = R1; g0 = g1; tok = tok1; tok1 = tok2; tk1 = tk2; rk1 = rk2; g1 = g2;
    }
}
__device__ __forceinline__ void route_tokens8(const float* logits, const float* rbias, float* gate, int tok0, int lane, int& e_out) {
    const float4 rb = *(const float4*)(rbias + lane * 4);
    float4 lgs[8];
#pragma unroll
    for (int t = 0; t < 8; ++t) lgs[t] = *(const float4*)(logits + (size_t)(tok0 + t) * NE + lane * 4);
    int e_all = 0; float g_all = 0.f;
#pragma unroll
    for (int t = 0; t < 8; ++t) {
        const float4 lg = lgs[t];
        float sc[4], ch[4];
        sc[0] = 1.f / (1.f + expf(-lg.x)); sc[1] = 1.f / (1.f + expf(-lg.y)); sc[2] = 1.f / (1.f + expf(-lg.z)); sc[3] = 1.f / (1.f + expf(-lg.w));
        ch[0] = sc[0] + rb.x; ch[1] = sc[1] + rb.y; ch[2] = sc[2] + rb.z; ch[3] = sc[3] + rb.w;
        float t1 = -INFINITY, t2 = -INFINITY;
#pragma unroll
        for (int i = 0; i < 4; ++i) { const float v = ch[i]; if (v > t1) { t2 = t1; t1 = v; } else if (v > t2) t2 = v; }
#pragma unroll
        for (int s_ = 1; s_ <= 4; s_ <<= 1) {
            const float o1 = __shfl_xor(t1, s_), o2 = __shfl_xor(t2, s_);
            const float n1 = fmaxf(t1, o1);
            const float n2 = fmaxf(fminf(t1, o1), fmaxf(t2, o2));
            t1 = n1; t2 = n2;
        }
        const float gs = t1 + t2;
        const int mygrp = lane >> 3;
        int rank = 0;
#pragma unroll
        for (int g2 = 0; g2 < 8; ++g2) { const float og = __shfl(gs, g2 * 8); if (og > gs || (og == gs && g2 < mygrp)) ++rank; }
        const bool gsel = rank < 4;
#pragma unroll
        for (int i = 0; i < 4; ++i) if (!gsel) ch[i] = -INFINITY;
        float gsum = 0.f; float myg = 0.f; int mye = -1;
#pragma unroll 1
        for (int k = 0; k < TOPK; ++k) {
            float bv = ch[0]; int bi = 0;
#pragma unroll
            for (int i = 1; i < 4; ++i) if (ch[i] > bv) { bv = ch[i]; bi = i; }
            int be = lane * 4 + bi;
#pragma unroll
            for (int s_ = 32; s_ >= 1; s_ >>= 1) {
                const float ov = __shfl_xor(bv, s_); const int oe = __shfl_xor(be, s_);
                if (ov > bv || (ov == bv && oe < be)) { bv = ov; be = oe; }
            }
            const int ol = be >> 2, oi = be & 3;
            float sv = 0.f;
            if (lane == ol) {
#pragma unroll
                for (int i = 0; i < 4; ++i) if (i == oi) { sv = sc[i]; ch[i] = -INFINITY; }
            }
            sv = __shfl(sv, ol);
            gsum += sv;
            if (lane == k) { myg = sv; mye = be; }
        }
        const float gv = 2.5f * myg / (gsum + 1e-20f);
        const int eo = __shfl(mye, lane & 7); const float go = __shfl(gv, lane & 7);
        if ((lane >> 3) == t) { e_all = eo; g_all = go; }
    }
    gate[(size_t)tok0 * TOPK + lane] = g_all;
    e_out = e_all;
}


struct Params {
    const float* x; const float* w_in; const float* att_norm_g; const float* lam_re; const float* lam_im; const float* log_step;
    const float* b_re; const float* b_im; const float* c_re; const float* c_im; const float* d_skip; const float* w_glu; const float* b_glu;
    const float* ssm_norm_g; const float* w_out; const float* ln1_g; const float* ln1_b; const float* router_w; const float* router_bias;
    const float* w_gu; const float* w_down; const float* shared_w_gu; const float* shared_w_down; const float* ln2_g; const float* ln2_b;
    float* out;
    unsigned* bar; int* cntp; int* list; int* ctab;
    bf16_t* xb; bf16_t* w_inT; float* rope; bf16_t* q; bf16_t* k; bf16_t* v; bf16_t* u;
    bf16_t* opart; float* lse; bf16_t* wendT; bf16_t* wcarT; bf16_t* klagT; float* a16; bf16_t* w_gluT; bf16_t* yss; void* rsv0; void* rsv1;
    bf16_t* w_outT; bf16_t* rsT; bf16_t* sdT; unsigned char* h1q; bf16_t* h1b; float* logits; void* rsv2; bf16_t* pre2b; float* gate; int* inv;
    unsigned char* w_gu8; unsigned char* w_dn8; unsigned char* act8; unsigned char* contrib8;
    int ph_lo, ph_hi;
};
constexpr int LDS_TS = ME_LDS;
constexpr int LDS_XB = ME_LDS + 4096 + 8192;
constexpr int LDS_TOTAL = ME_LDS + 4096 + 8192 + 64;
static_assert(pg::VA_SLOT_OFF == ME_LDS + 4096 && LDS_TOTAL <= 163840, "LDS map");
constexpr int N_PHASES = 12;

template <class RM, bool NTS>
__device__ __forceinline__ void transpose_range(const float* W, int K, int N, unsigned char* Wt, int t0, int t1, LDSP unsigned char* lds) {
    const int tid = threadIdx.x, lane = tid & 63, wid = __builtin_amdgcn_readfirstlane(tid >> 6);
    LDSP float* scr = (LDSP float*)(lds + wid * 17408);
    const int tk = K >> 6; const RM rm = RM();
    const int lr = lane >> 4, lc = (lane & 15) * 4;
    const int rc = lane & 3, rn = lane >> 2;
#define TR_LOAD(V, t_) do { const int k0_ = ((t_) % tk) * 64, n0_ = ((t_) / tk) * 64; const float* sp_ = W + (size_t)(k0_ + lr) * N + n0_ + lc; \
        _Pragma("unroll") for (int i = 0; i < 16; ++i) V[i] = __builtin_nontemporal_load((const f32x4*)(sp_ + (size_t)(4 * i) * N)); } while (0)
#define TR_PROC(V, t_) do { const int k0_ = ((t_) % tk) * 64, n0_ = ((t_) / tk) * 64; \
        _Pragma("unroll") for (int i = 0; i < 16; ++i) { const int k = 4 * i + lr; *(LDSP f32x4*)(scr + k * 68 + (lc ^ (4 * ((k >> 3) & 7)))) = V[i]; } \
        _Pragma("unroll") for (int j = 0; j < 4; ++j) { \
            const int n = rn + 16 * j; \
            const LDSP float* pa = scr + (16 * rc) * 68 + (n ^ (8 * rc)), * pb = scr + (16 * rc + 8) * 68 + (n ^ (8 * rc + 4)); \
            u32x4 w; \
            w.x = pk4f8(pa[0] * F8_SW, pa[68] * F8_SW, pa[2 * 68] * F8_SW, pa[3 * 68] * F8_SW); w.y = pk4f8(pa[4 * 68] * F8_SW, pa[5 * 68] * F8_SW, pa[6 * 68] * F8_SW, pa[7 * 68] * F8_SW); \
            w.z = pk4f8(pb[0] * F8_SW, pb[68] * F8_SW, pb[2 * 68] * F8_SW, pb[3 * 68] * F8_SW); w.w = pk4f8(pb[4 * 68] * F8_SW, pb[5 * 68] * F8_SW, pb[6 * 68] * F8_SW, pb[7 * 68] * F8_SW); \
            if (NTS) __builtin_nontemporal_store(w, (u32x4*)(Wt + (size_t)rm(n0_ + n) * K + k0_ + 16 * rc)); else *(u32x4*)(Wt + (size_t)rm(n0_ + n) * K + k0_ + 16 * rc) = w; } } while (0)
    int t = t0 + wid;
    if (t >= t1) return;
    f32x4 va[16], vb[16];
    TR_LOAD(va, t);
#pragma unroll 1
    for (; t < t1; t += 16) {
        const int t2 = t + 8, t3 = t + 16;
        { const int tl = t2 < t1 ? t2 : t; TR_LOAD(vb, tl); }
        TR_PROC(va, t);
        if (t2 < t1) {
            { const int tl = t3 < t1 ? t3 : t2; TR_LOAD(va, tl); }
            TR_PROC(vb, t2);
        }
    }
#undef TR_LOAD
#undef TR_PROC
}
__device__ __forceinline__ void convert_experts(const Params& p, LDSP unsigned char* lds, int t0, int t1) {
    __syncthreads();
    for (int e = blockIdx.x; e < NE; e += gridDim.x) {
        if (t0 < 128) transpose_range<RowGU, false>(p.w_gu + (size_t)e * 1024 * 512, 1024, 512, p.w_gu8 + (size_t)e * 512 * 1024, t0, t1 < 128 ? t1 : 128, lds);
        if (t1 > 128) transpose_range<RowId, true>(p.w_down + (size_t)e * 256 * 1024, 256, 1024, p.w_dn8 + (size_t)e * 1024 * 256, (t0 > 128 ? t0 : 128) - 128, t1 - 128, lds);
    }
    __syncthreads();
}
__device__ __forceinline__ bool convert_first() { return ((blockIdx.x >> 3) & 1) == 0; }
template <class RM, bool FT>
__device__ __forceinline__ void transpose_tile_w(const float* W, int K, int N, bf16_t* Wt, int t, LDSP float* scr, int lane) {
    const int tn = N >> 6; const RM rm = RM();
    const int lr = lane >> 4, lc = (lane & 15) * 4;
    const int rc = lane & 7, rn = lane >> 3;
    const int k0 = (t / tn) * 64, n0 = (t % tn) * 64;
    const float* sp = W + (size_t)(k0 + lr) * N + n0 + lc;
    f32x4 v[16];
#pragma unroll
    for (int i = 0; i < 16; ++i) v[i] = *(const f32x4*)(sp + (size_t)(4 * i) * N);
#pragma unroll
    for (int i = 0; i < 16; ++i) { const int k = 4 * i + lr; *(LDSP f32x4*)(scr + k * 68 + (lc ^ (4 * ((k >> 3) & 7)))) = v[i]; }
#pragma unroll
    for (int j = 0; j < 8; ++j) {
        const int n = rn + 8 * j;
        const LDSP float* q = scr + (8 * rc) * 68 + (n ^ (4 * rc));
        u32x4 w;
        w.x = pk2(q[0], q[68]); w.y = pk2(q[2 * 68], q[3 * 68]); w.z = pk2(q[4 * 68], q[5 * 68]); w.w = pk2(q[6 * 68], q[7 * 68]);
        const int nn = rm(n0 + n);
        *(u32x4*)(Wt + (FT ? ft_off(nn, k0 + 8 * rc, K) : (size_t)nn * K + k0 + 8 * rc)) = w;
    }
}
__device__ __forceinline__ void phase_prologue(const Params& p, LDSP unsigned char* lds) {
    const int tid = threadIdx.x;
    {
        const int lane = tid & 63, wid = __builtin_amdgcn_readfirstlane(tid >> 6);
        LDSP float* scr = (LDSP float*)(lds + wid * 17408);
        for (int g = blockIdx.x * 8 + wid; g < 1088; g += gridDim.x * 8) {
            if (g < 512) transpose_tile_w<RowId, false>(p.w_in, 1024, 2048, p.w_inT, g, scr, lane);
            else if (g < 768) transpose_tile_w<RowId, true>(p.w_out, 1024, 1024, p.w_outT, g - 512, scr, lane);
            else if (g < 896) transpose_tile_w<RowGU64, true>(p.shared_w_gu, 1024, 512, p.rsT + (size_t)256 * 1024, g - 768, scr, lane);
            else if (g < 960) transpose_tile_w<RowId, true>(p.w_glu, 512, 512, p.w_gluT, g - 896, scr, lane);
            else if (g < 1024) transpose_tile_w<RowId, true>(p.router_w, 1024, 256, p.rsT, g - 960, scr, lane);
            else transpose_tile_w<RowId, true>(p.shared_w_down, 256, 1024, p.sdT, g - 1024, scr, lane);
        }
    }
    for (size_t i = ((size_t)blockIdx.x * 512 + tid) * 8; i < (size_t)NT * D_; i += (size_t)gridDim.x * 512 * 8) {
        const float4 v0 = *(const float4*)(p.x + i), v1 = *(const float4*)(p.x + i + 4);
        u32x4 w; w.x = pk2(v0.x, v0.y); w.y = pk2(v0.z, v0.w); w.z = pk2(v1.x, v1.y); w.w = pk2(v1.z, v1.w);
        *(u32x4*)(p.xb + i) = w;
    }
    for (int i = blockIdx.x * 512 + tid; i < 2048 * 8; i += gridDim.x * 512) {
        const int pos = i >> 3, f = i & 7;
        const float inv = powf(500000.0f, -(float)f / 8.0f);
        const float ang = (float)pos * inv;
        p.rope[2 * i] = cosf(ang); p.rope[2 * i + 1] = sinf(ang);
    }
    for (int i = blockIdx.x * 512 + tid; i < NSEG * NE; i += gridDim.x * 512) p.cntp[(size_t)i * CNT_STRIDE] = 0;
    SsmTabArgs sa{p.lam_re, p.lam_im, p.log_step, p.b_re, p.b_im, p.c_re, p.c_im, p.wendT, p.wcarT, p.klagT, p.a16};
    for (int it = blockIdx.x * 512 + tid; it < SSM_TAB_ITEMS; it += gridDim.x * 512) ssm_tab_item(sa, it);
    __syncthreads();
    for (int it = blockIdx.x; it < 512; it += gridDim.x) ssm_klag_item(sa, it, (LDSP float*)lds, tid);
    __syncthreads();
}
__device__ __forceinline__ void phase_proj(const Params& a, LDSP unsigned char* lds) {
    const bool cvf_ = convert_first();
    if (cvf_) convert_experts(a, lds, 0, 48);
    pg::gemm_phase<false, true, false, false>(lds, 1024, pg::sched([&](int i, pg::Unit& u) {
        int pm, pn; if (!pg::static_tile(i, 64, 8, pm, pn)) return false;
        u.A = (const char*)(a.xb + (size_t)pm * 256 * 1024); u.B = (const char*)(a.w_inT + (size_t)pn * 256 * 1024); u.x0 = pm; u.x1 = pn; u.x2 = 0; u.x3 = 0; return true;
    }, [](const pg::Unit&) { return pg::dense_va(2048); }), pg::epi_row8([&](const pg::Unit& u, int r, int c, f32x4 v0, f32x4 v1) {
        const int m = u.x0 * 256 + r, sec = u.x1 >> 1, cs = (u.x1 & 1) * 256 + c;
        const int b = m >> 11, t = m & 2047, sh = sec < 3 ? 6 : 4;
        bf16_t* dstb = sec == 0 ? a.q : (sec == 1 ? a.k : (sec == 2 ? a.v : a.u));
        if (sec == 0) { v0 = v0 * QSCALE; v1 = v1 * QSCALE; }
        if (sec < 2 && (c & 32) == 0) {
            f32x4 o0, o1;
#pragma unroll
            for (int j = 0; j < 4; ++j) { o0[j] = __shfl_xor(v0[j], 16); o1[j] = __shfl_xor(v1[j], 16); }
            if ((c & 16) == 0) {
                const float* rt = a.rope + (size_t)t * 16;
                const f32x4 c0 = *(const f32x4*)rt, c1 = *(const f32x4*)(rt + 4), c2 = *(const f32x4*)(rt + 8), c3 = *(const f32x4*)(rt + 12);
                const f32x4 cs0 = {c0[0], c0[2], c1[0], c1[2]}, cs1 = {c2[0], c2[2], c3[0], c3[2]}, sn0 = {c0[1], c0[3], c1[1], c1[3]}, sn1 = {c2[1], c2[3], c3[1], c3[3]};
                if ((c & 8) == 0) { v0 = v0 * cs0 - o0 * sn0; v1 = v1 * cs1 - o1 * sn1; }
                else { v0 = v0 * cs0 + o0 * sn0; v1 = v1 * cs1 + o1 * sn1; }
            }
        }
        const int grp = cs >> sh, within = cs & ((1 << sh) - 1);
        *(u32x4*)(dstb + ((((size_t)((b << (9 - sh)) + grp) << 11) + t) << sh) + within) = pg::pack8(v0, v1);
    }));
    if (!cvf_) convert_experts(a, lds, 0, 48);
}
__device__ __forceinline__ void phase_mixers(const Params& p, LDSP unsigned char* lds) {
    const bool cvf_ = convert_first();
    if (cvf_) convert_experts(p, lds, 48, 128);
    SsmArgs sa{p.u, p.wendT, p.wcarT, p.klagT, p.a16, p.d_skip, p.yss};
    for (int bg = blockIdx.x; bg < 256; bg += gridDim.x) ssm_unit(sa, bg, lds);
    __syncthreads();
    AttArgs aa{p.q, p.k, p.v, p.opart, p.lse};
    {
        const int tid = threadIdx.x;
        int U = blockIdx.x;
        AwPre P;
        if (U < AW_UNITS) aw_prefetch(aa, U, P, tid);
        while (U < AW_UNITS) {
            __syncthreads();
            aw_stage(P, lds, tid);
            bf16x8 qf[4];
#pragma unroll
            for (int s_ = 0; s_ < 4; ++s_) qf[s_] = P.q[s_];
            __syncthreads();
            const int Un = U + gridDim.x;
            aw_prefetch(aa, Un < AW_UNITS ? Un : U, P, tid);
            aw_compute(aa, U, qf, lds, tid);
            U = Un;
        }
        __syncthreads();
    }
    if (!cvf_) convert_experts(p, lds, 48, 128);
}
template <int NF, int NW = NF, int OFF = 0>
__device__ __forceinline__ void rb_gemm(f32x4 (&acc)[4][NW], const LDSP unsigned char* Alds, int apitch, const bf16_t* Bt, int K, int lane) {
    const int fr = lane & 15, fq = lane >> 4;
    const int nks = K >> 5;
    const char* bb = (const char*)Bt;
    unsigned bo = lane * 16;
    const unsigned nstride = (unsigned)nks * 1024u;
    const LDSP unsigned char* ap = Alds + fr * apitch + fq * 16;
#pragma unroll
    for (int m = 0; m < 4; ++m)
#pragma unroll
        for (int ni = 0; ni < NF; ++ni) acc[m][OFF + ni] = (f32x4){0.f, 0.f, 0.f, 0.f};
    bf16x8 b0[NF], b1[NF], b2[NF], b3[NF];
#define RB_LOADB(B_, step_) do { _Pragma("unroll") for (int ni = 0; ni < NF; ++ni) B_[ni] = *(const bf16x8*)(bb + (bo + (unsigned)(step_) * 1024u + ni * ns)); } while (0)
#define RB_MMA(B_, step_) do { bf16x8 af_[4]; _Pragma("unroll") for (int m = 0; m < 4; ++m) af_[m] = *(const LDSP bf16x8*)(ap + m * 16 * apitch + (step_) * 64); \
        _Pragma("unroll") for (int m = 0; m < 4; ++m) _Pragma("unroll") for (int ni = 0; ni < NF; ++ni) acc[m][OFF + ni] = __builtin_amdgcn_mfma_f32_16x16x32_bf16(B_[ni], af_[m], acc[m][OFF + ni], 0, 0, 0); } while (0)
    { unsigned ns = nstride; asm volatile("" : "+s"(ns), "+v"(bo)); RB_LOADB(b0, 0); RB_LOADB(b1, 1); RB_LOADB(b2, 2); }
#pragma unroll 1
    for (int ks = 0; ks < nks; ks += 4) {
        unsigned ns = nstride; asm volatile("" : "+s"(ns));
        RB_LOADB(b3, 3);
        RB_MMA(b0, 0);
        if (ks + 4 < nks) RB_LOADB(b0, 4);
        RB_MMA(b1, 1);
        if (ks + 4 < nks) RB_LOADB(b1, 5);
        RB_MMA(b2, 2);
        if (ks + 4 < nks) RB_LOADB(b2, 6);
        RB_MMA(b3, 3);
        bo += 4096u; ap += 256;
    }
#undef RB_LOADB
#undef RB_MMA
}
__device__ __forceinline__ void rb_stage_rows(LDSP unsigned char* dst, int lpitch, const bf16_t* src, size_t gpitch, int ncols) {
    const int cpr = ncols >> 3;
    int tid0 = threadIdx.x; asm volatile("" : "+v"(tid0));
    for (int id = tid0; id < 64 * cpr; id += 512) { const int r = id / cpr, c = id - r * cpr; *(LDSP u32x4*)(dst + r * lpitch + c * 16) = __builtin_nontemporal_load((const u32x4*)(src + (size_t)r * gpitch + c * 8)); }
}
constexpr int RB_HIST_OFF = 139264;
constexpr int RB_STAT_OFF = 64 * 2064;
__device__ __forceinline__ void phase_wout_ln(const Params& a, LDSP unsigned char* lds) {
    const bool cvf_ = convert_first();
    if (cvf_) convert_experts(a, lds, 128, 192);
    int lane = threadIdx.x & 63; const int w = __builtin_amdgcn_readfirstlane(threadIdx.x >> 6); int fr = lane & 15, fq = lane >> 4;
#define RB_FRESH() do { __builtin_amdgcn_sched_barrier(0); asm volatile("" : "+s"(m0), "+v"(fr), "+v"(fq), "+v"(lane)); } while (0)
    for (int tile = blockIdx.x; tile < NT / 64; tile += gridDim.x) {
        int m0 = tile * 64;
        asm volatile("" : "+s"(m0));
        __syncthreads();
#pragma unroll 1
        for (int tb = 0; tb < 8; tb += 4) {
            int ln = lane; asm volatile("" : "+v"(ln));
            const int h = ln >> 3;
            float ls[4][3]; u32x4 pv[4][3];
#pragma unroll
            for (int t = 0; t < 4; ++t) {
                const int tok = m0 + 8 * w + tb + t;
#pragma unroll
                for (int c = 0; c < 3; ++c) { ls[t][c] = a.lse[((size_t)c * NT + tok) * 8 + h]; pv[t][c] = __builtin_nontemporal_load((const u32x4*)(a.opart + ((size_t)c * NT + tok) * 512 + ln * 8)); }
            }
            const f32x4 ga0 = *(const f32x4*)(a.att_norm_g + ln * 8), ga1 = *(const f32x4*)(a.att_norm_g + ln * 8 + 4);
#pragma unroll
            for (int t = 0; t < 4; ++t) {
                const int row = 8 * w + tb + t;
                const float mx = fmaxf(ls[t][0], fmaxf(ls[t][1], ls[t][2]));
                float wg[3], ws = 0.f;
#pragma unroll
                for (int c = 0; c < 3; ++c) { wg[c] = exp2f(ls[t][c] - mx); ws += wg[c]; }
                const float iw = 1.f / ws;
                float o[8];
#pragma unroll
                for (int i = 0; i < 8; ++i) o[i] = 0.f;
#pragma unroll
                for (int c = 0; c < 3; ++c) {
                    const u32x4 v = pv[t][c]; const float wc = wg[c] * iw;
                    o[0] += wc * bf2f(v.x & 0xffff); o[1] += wc * bf2f(v.x >> 16); o[2] += wc * bf2f(v.y & 0xffff); o[3] += wc * bf2f(v.y >> 16);
                    o[4] += wc * bf2f(v.z & 0xffff); o[5] += wc * bf2f(v.z >> 16); o[6] += wc * bf2f(v.w & 0xffff); o[7] += wc * bf2f(v.w >> 16);
                }
                float sa = 0.f;
#pragma unroll
                for (int i = 0; i < 8; ++i) sa += o[i] * o[i];
                sa = wave_sum(sa);
                const float ra = rsqrtf(sa * (1.f / 512.f) + 1e-6f);
                u32x4 wa;
                wa.x = pk2(o[0] * ra * ga0[0], o[1] * ra * ga0[1]); wa.y = pk2(o[2] * ra * ga0[2], o[3] * ra * ga0[3]);
                wa.z = pk2(o[4] * ra * ga1[0], o[5] * ra * ga1[1]); wa.w = pk2(o[6] * ra * ga1[2], o[7] * ra * ga1[3]);
                *(LDSP u32x4*)(lds + row * 2064 + ln * 16) = wa;
            }
        }
        rb_stage_rows(lds + 1024, 2064, a.yss + (size_t)m0 * 512, 512, 512);
        __syncthreads();
        {
            f32x4 ga[4][4];
            rb_gemm<4>(ga, lds + 1024, 2064, a.w_gluT + (size_t)(64 * w) * 512, 512, lane);
            LDSP float* st = (LDSP float*)(lds + RB_STAT_OFF);
            RB_FRESH();
#pragma unroll
            for (int m = 0; m < 4; ++m) {
                float s2 = 0.f;
#pragma unroll
                for (int ni = 0; ni < 4; ++ni) {
                    const int col = 64 * w + 16 * ni + 4 * fq;
                    const u32x2 yw = *(const LDSP u32x2*)(lds + (16 * m + fr) * 2064 + 1024 + col * 2);
                    const f32x4 bb = *(const f32x4*)(a.b_glu + col);
                    f32x4 v = ga[m][ni];
                    v[0] = bf2f(yw.x & 0xffff) / (1.f + __expf(-(v[0] + bb[0]))); v[1] = bf2f(yw.x >> 16) / (1.f + __expf(-(v[1] + bb[1])));
                    v[2] = bf2f(yw.y & 0xffff) / (1.f + __expf(-(v[2] + bb[2]))); v[3] = bf2f(yw.y >> 16) / (1.f + __expf(-(v[3] + bb[3])));
                    ga[m][ni] = v; s2 += (v[0] * v[0] + v[1] * v[1]) + (v[2] * v[2] + v[3] * v[3]);
                }
                s2 += __shfl_xor(s2, 16); s2 += __shfl_xor(s2, 32);
                if (fq == 0) st[w * 64 + 16 * m + fr] = s2;
            }
            __syncthreads();
            RB_FRESH();
#pragma unroll
            for (int m = 0; m < 4; ++m) {
                float s2 = 0.f;
#pragma unroll
                for (int v = 0; v < 8; ++v) s2 += st[v * 64 + 16 * m + fr];
                const float rs = rsqrtf(s2 * (1.f / 512.f) + 1e-6f);
#pragma unroll
                for (int ni = 0; ni < 4; ++ni) {
                    const int col = 64 * w + 16 * ni + 4 * fq;
                    const f32x4 gs = *(const f32x4*)(a.ssm_norm_g + col);
                    const f32x4 v = ga[m][ni] * rs * gs;
                    u32x2 o2; o2.x = pk2(v[0], v[1]); o2.y = pk2(v[2], v[3]);
                    *(LDSP u32x2*)(lds + (16 * m + fr) * 2064 + 1024 + col * 2) = o2;
                }
            }
        }
        __syncthreads();
        f32x4 acc[4][8];
        const int n0 = 128 * w;
        rb_gemm<4, 8, 0>(acc, lds, 2064, a.w_outT + (size_t)n0 * 1024, 1024, lane);
        rb_gemm<4, 8, 4>(acc, lds, 2064, a.w_outT + (size_t)(n0 + 64) * 1024, 1024, lane);
        RB_FRESH();
        LDSP float* st = (LDSP float*)(lds + RB_STAT_OFF);
#pragma unroll
        for (int m = 0; m < 4; ++m) {
            const float* xr = a.x + (size_t)(m0 + 16 * m + fr) * 1024 + n0 + 4 * fq;
            float s1 = 0.f, s2 = 0.f;
#pragma unroll
            for (int ni = 0; ni < 8; ++ni) {
                const f32x4 xv = __builtin_nontemporal_load((const f32x4*)(xr + 16 * ni));
                const f32x4 v = xv * ALPHA + acc[m][ni]; acc[m][ni] = v;
                s1 += (v[0] + v[1]) + (v[2] + v[3]); s2 += (v[0] * v[0] + v[1] * v[1]) + (v[2] * v[2] + v[3] * v[3]);
            }
            s1 += __shfl_xor(s1, 16); s1 += __shfl_xor(s1, 32); s2 += __shfl_xor(s2, 16); s2 += __shfl_xor(s2, 32);
            if (fq == 0) { st[(w * 64 + 16 * m + fr) * 2] = s1; st[(w * 64 + 16 * m + fr) * 2 + 1] = s2; }
        }
        __syncthreads();
        RB_FRESH();
#pragma unroll
        for (int m = 0; m < 4; ++m) {
            float s1 = 0.f, s2 = 0.f;
#pragma unroll
            for (int v = 0; v < 8; ++v) { s1 += st[(v * 64 + 16 * m + fr) * 2]; s2 += st[(v * 64 + 16 * m + fr) * 2 + 1]; }
            const float mu = s1 * (1.f / 1024.f), var = s2 * (1.f / 1024.f) - mu * mu, rstd = rsqrtf(var + 1e-5f);
            LDSP unsigned char* hl = lds + (16 * m + fr) * 2064 + (n0 + 4 * fq) * 2;
#pragma unroll
            for (int ni = 0; ni < 8; ++ni) {
                const f32x4 gg = *(const f32x4*)(a.ln1_g + n0 + 16 * ni + 4 * fq), bb = *(const f32x4*)(a.ln1_b + n0 + 16 * ni + 4 * fq);
                const f32x4 y = (acc[m][ni] - mu) * rstd * gg + bb;
                u32x2 o; o.x = pk2(y[0], y[1]); o.y = pk2(y[2], y[3]);
                *(LDSP u32x2*)(hl + 32 * ni) = o;
            }
        }
        __syncthreads();
        {
            int tid0 = threadIdx.x; asm volatile("" : "+v"(tid0));
#pragma unroll 1
            for (int id = tid0; id < 64 * 128; id += 512) {
                const int r = id >> 7, c = id & 127; const u32x4 hv = *(const LDSP u32x4*)(lds + r * 2064 + c * 16);
                *(u32x4*)(a.h1b + (size_t)(m0 + r) * 1024 + c * 8) = hv;
                u32x2 q8;
                q8.x = pk4f8(bf2f(hv.x & 0xffff) * F8_SH, bf2f(hv.x >> 16) * F8_SH, bf2f(hv.y & 0xffff) * F8_SH, bf2f(hv.y >> 16) * F8_SH);
                q8.y = pk4f8(bf2f(hv.z & 0xffff) * F8_SH, bf2f(hv.z >> 16) * F8_SH, bf2f(hv.w & 0xffff) * F8_SH, bf2f(hv.w >> 16) * F8_SH);
                __builtin_nontemporal_store(q8, (u32x2*)(a.h1q + (size_t)(m0 + r) * 1024 + c * 8));
            }
        }
        RB_FRESH();
        {
            f32x4 rl[4][2];
            rb_gemm<2>(rl, lds, 2064, a.rsT + (size_t)(32 * w) * 1024, 1024, lane);
#pragma unroll
            for (int m = 0; m < 4; ++m)
#pragma unroll
                for (int ni = 0; ni < 2; ++ni) *(f32x4*)(a.logits + (size_t)(m0 + 16 * m + fr) * 256 + 32 * w + 16 * ni + 4 * fq) = rl[m][ni];
        }
        RB_FRESH();
        u32x2 actv[4][2];
        {
            f32x4 gu[4][4];
            rb_gemm<4>(gu, lds, 2064, a.rsT + (size_t)(256 + 64 * w) * 1024, 1024, lane);
#pragma unroll
            for (int m = 0; m < 4; ++m)
#pragma unroll
                for (int ni = 0; ni < 2; ++ni) {
                    const f32x4 g = gu[m][ni], up = gu[m][ni + 2];
                    actv[m][ni].x = pk2(silu_f(g[0]) * up[0], silu_f(g[1]) * up[1]); actv[m][ni].y = pk2(silu_f(g[2]) * up[2], silu_f(g[3]) * up[3]);
                }
        }
        asm volatile("s_waitcnt vmcnt(0)" ::: "memory");
        if (threadIdx.x < 256) ((LDSP int*)(lds + RB_HIST_OFF))[threadIdx.x] = 0;
        __syncthreads();
#pragma unroll
        for (int m = 0; m < 4; ++m)
#pragma unroll
            for (int ni = 0; ni < 2; ++ni) *(LDSP u32x2*)(lds + (16 * m + fr) * 528 + (32 * w + 16 * ni + 4 * fq) * 2) = actv[m][ni];
        RB_FRESH();
        {
            int e_my; route_tokens8(a.logits, a.router_bias, a.gate, m0 + 8 * w, lane, e_my);
            LDSP int* hist = (LDSP int*)(lds + RB_HIST_OFF); LDSP int* hbase = hist + 256;
            const int lpos = __hip_atomic_fetch_add(hist + e_my, 1, __ATOMIC_RELAXED, __HIP_MEMORY_SCOPE_WORKGROUP);
            __syncthreads();
            const int seg = blockIdx.x & (NSEG - 1);
            if (threadIdx.x < 256) { const int c = hist[threadIdx.x]; if (c > 0) hbase[threadIdx.x] = atomicAdd(&a.cntp[(size_t)(seg * 256 + threadIdx.x) * CNT_STRIDE], c); }
            __syncthreads();
            const int pos = hbase[e_my] + lpos, slot = (m0 + 8 * w) * TOPK + lane;
            a.list[(size_t)(e_my * NSEG + seg) * SEGCAP + pos] = slot;
            a.inv[slot] = (e_my << 16) | (seg << 11) | pos;
        }
        __syncthreads();
        RB_FRESH();
        {
            rb_gemm<4, 8, 0>(acc, lds, 528, a.sdT + (size_t)n0 * 256, 256, lane);
            rb_gemm<4, 8, 4>(acc, lds, 528, a.sdT + (size_t)(n0 + 64) * 256, 256, lane);
            __syncthreads();
            RB_FRESH();
#pragma unroll
            for (int m = 0; m < 4; ++m) {
                const size_t ro = (size_t)(m0 + 16 * m + fr) * 1024 + n0 + 4 * fq;
                LDSP unsigned char* pl = lds + (16 * m + fr) * 2064 + (n0 + 4 * fq) * 2;
#pragma unroll
                for (int ni = 0; ni < 8; ++ni) {
                    const u32x2 hw = *(const u32x2*)(a.h1b + ro + 16 * ni);
                    f32x4 hv; hv[0] = bf2f(hw.x & 0xffff); hv[1] = bf2f(hw.x >> 16); hv[2] = bf2f(hw.y & 0xffff); hv[3] = bf2f(hw.y >> 16);
                    const f32x4 y = hv * ALPHA + acc[m][ni];
                    u32x2 o; o.x = pk2(y[0], y[1]); o.y = pk2(y[2], y[3]);
                    *(LDSP u32x2*)(pl + 32 * ni) = o;
                }
            }
            __syncthreads();
            {
                int tid0 = threadIdx.x; asm volatile("" : "+v"(tid0));
#pragma unroll 1
                for (int id = tid0; id < 64 * 128; id += 512) { const int r = id >> 7, c = id & 127; __builtin_nontemporal_store(*(const LDSP u32x4*)(lds + r * 2064 + c * 16), (u32x4*)(a.pre2b + (size_t)(m0 + r) * 1024 + c * 8)); }
            }
        }
    }
    if (!cvf_) convert_experts(a, lds, 128, 192);
#undef RB_FRESH
}
template <bool RAGGED, class RowPtr>
__device__ __forceinline__ void swiglu_epi_pg(const f32x4 (&acc)[2][2][4][2], int wr, int wc, int fr, int fq, int nvalid, const RowPtr& rowp) {
    constexpr float us = 1.f / (F8_SH * F8_SW);
    asm volatile("" : "+v"(fr));
#pragma unroll
    for (int ai = 0; ai < 2; ++ai)
#pragma unroll
        for (int m = 0; m < 4; ++m) {
            const int r = RAGGED ? 16 * (2 * (4 * ai + m) + wr) + fr : 128 * ai + 64 * wr + 16 * m + fr;
            if (r < nvalid) {
                f32x4 o0, o1;
#pragma unroll
                for (int j = 0; j < 4; ++j) { o0[j] = silu_f(acc[ai][0][m][0][j] * us) * (acc[ai][1][m][0][j] * (us * F8_SA)); o1[j] = silu_f(acc[ai][0][m][1][j] * us) * (acc[ai][1][m][1][j] * (us * F8_SA)); }
                u32x2 w; w.x = pk4f8(o0[0], o0[1], o0[2], o0[3]); w.y = pk4f8(o1[0], o1[1], o1[2], o1[3]);
                *(u32x2*)(rowp(r) + 32 * wc + 8 * fq) = w;
            }
        }
}
__device__ __forceinline__ void phase_moe_up(const Params& a, LDSP unsigned char* lds) {
    LDSP int* ts = (LDSP int*)(lds + LDS_TS); LDSP int* ud = (LDSP int*)(lds + LDS_TS + MOE_UD_OFF);
    moe_tile_table<false>(a.cntp, a.ctab, lds, ts, threadIdx.x);
    int first, last, step; unit_range(2 * ts[256], first, last, step);
    const int nun = moe_build_units(ts, (const LDSP int*)(lds + LDS_CT), first, last, step, 2, ud, threadIdx.x);
    pg::gemm_phase<true, true, true, true>(lds, 512  , pg::sched([&](int i, pg::Unit& u) {
        if (i >= nun) return false;
        const LDSP int* d = ud + i * 5; const int e = d[0], pn = d[1];
        u.A = (const char*)a.h1q; u.B = (const char*)(a.w_gu8 + ((size_t)e * 512 + pn * 256) * 1024);
        u.x0 = pn; u.x1 = d[3]; u.x2 = d[4]; u.x3 = (e << 16) | d[2]; return true;
    }, [&](const pg::Unit& u) {
        const pg::LaneRC l = pg::lane_rc_fresh(); const int e = u.x3 >> 16, row0 = u.x3 & 0xffff, nvalid = u.x1; pg::VA v;
        const int r00 = pg::ragged_row(0, l.R0), r01 = pg::ragged_row(0, l.R1), r10 = pg::ragged_row(1, l.R0), r11 = pg::ragged_row(1, l.R1);
        const LDSP int* spe = (const LDSP int*)(lds + LDS_SP) + e * NSEG;
        const i32x4_t sa = *(const LDSP i32x4_t*)spe, sb = *(const LDSP i32x4_t*)(spe + 4);
        const int* lste = a.list + (size_t)e * NSEG * SEGCAP;
        auto tok_of = [&](int r) -> unsigned {
            if (r >= nvalid) return 0u;
            const int rr = row0 + r;
            int sg = 0, base = 0;
            if (rr >= sa[1]) { sg = 1; base = sa[1]; } if (rr >= sa[2]) { sg = 2; base = sa[2]; } if (rr >= sa[3]) { sg = 3; base = sa[3]; }
            if (rr >= sb[0]) { sg = 4; base = sb[0]; } if (rr >= sb[1]) { sg = 5; base = sb[1]; } if (rr >= sb[2]) { sg = 6; base = sb[2]; } if (rr >= sb[3]) { sg = 7; base = sb[3]; }
            return (unsigned)(lste[sg * SEGCAP + (rr - base)] >> 3);
        };
        v.v00 = tok_of(r00) * 1024u + l.C0 * 2; v.v01 = tok_of(r01) * 1024u + l.C1 * 2;
        v.v10 = tok_of(r10) * 1024u + l.C0 * 2; v.v11 = tok_of(r11) * 1024u + l.C1 * 2;
        return v;
    }), [&](const f32x4 (&acc)[2][2][4][2], const pg::Unit& u, int wr, int wc, int fr, int fq) {
        unsigned char* base = a.act8 + (size_t)u.x2 * 256 + 128 * u.x0;
        swiglu_epi_pg<true>(acc, wr, wc, fr, fq, u.x1, [&](int r) { return base + (size_t)r * 256; });
    });
}
__device__ __forceinline__ void phase_moe_down(const Params& a, LDSP unsigned char* lds) {
    LDSP int* ts = (LDSP int*)(lds + LDS_TS); LDSP int* ud = (LDSP int*)(lds + LDS_TS + MOE_UD_OFF);
    moe_tile_table<true>(a.cntp, a.ctab, lds, ts, threadIdx.x);
    int first, last, step; unit_range(4 * ts[256], first, last, step);
    const int nun = moe_build_units(ts, (const LDSP int*)(lds + LDS_CT), first, last, step, 4, ud, threadIdx.x);
    pg::gemm_phase<false, 2, true, true>(lds, 128  , pg::sched([&](int i, pg::Unit& u) {
        if (i >= nun) return false;
        const LDSP int* d = ud + i * 5; const int e = d[0], pn = d[1];
        u.A = (const char*)(a.act8 + (size_t)d[4] * 256); u.B = (const char*)(a.w_dn8 + ((size_t)e * 1024 + pn * 256) * 256);
        u.x0 = pn; u.x1 = d[3]; u.x2 = d[4]; u.x3 = 0; return true;
    }, [](const pg::Unit&) { const pg::LaneRC l = pg::lane_rc(); pg::VA v;
        v.v00 = pg::ragged_row(0, l.R0) * 256 + l.C0 * 2; v.v01 = pg::ragged_row(0, l.R1) * 256 + l.C1 * 2; v.v10 = pg::ragged_row(1, l.R0) * 256 + l.C0 * 2; v.v11 = pg::ragged_row(1, l.R1) * 256 + l.C1 * 2; return v;
    }), [&](const f32x4 (&acc)[2][2][4][2], const pg::Unit& u, int wr, int wc, int fr, int fq) {
        constexpr float cs = F8_SC / (F8_SA * F8_SW);
        asm volatile("" : "+v"(fr), "+v"(fq));
        const int nvalid = u.x1; unsigned char* base = a.contrib8 + (size_t)u.x2 * 1024 + u.x0 * 256 + 64 * wc + 16 * fq;
#pragma unroll
        for (int ai = 0; ai < 2; ++ai)
#pragma unroll
            for (int m = 0; m < 4; ++m) {
                const int r = 16 * (2 * (4 * ai + m) + wr) + fr;
                if (r < nvalid) {
                    const f32x4 c0 = acc[ai][0][m][0] * cs, c1 = acc[ai][0][m][1] * cs, c2 = acc[ai][1][m][0] * cs, c3 = acc[ai][1][m][1] * cs;
                    u32x4 w; w.x = pk4f8(c0[0], c0[1], c0[2], c0[3]); w.y = pk4f8(c1[0], c1[1], c1[2], c1[3]); w.z = pk4f8(c2[0], c2[1], c2[2], c2[3]); w.w = pk4f8(c3[0], c3[1], c3[2], c3[3]);
                    *(u32x4*)(base + (size_t)r * 1024) = w;
                }
            }
    });
}
__device__ __forceinline__ void phase_final(const Params& p, LDSP unsigned char* lds) {
    LDSP int* ts = (LDSP int*)(lds + LDS_TS);
    moe_tile_table<true>(p.cntp, p.ctab, lds, ts, threadIdx.x);
    FinArgs fa{p.pre2b, p.contrib8, p.gate, p.inv, p.ln2_g, p.ln2_b, p.out};
    const int lane = threadIdx.x & 63, wid = threadIdx.x >> 6;
    final_tokens(fa, ts + 260, (const LDSP int*)(lds + LDS_SP), blockIdx.x * 8 + wid, gridDim.x * 8, lane);
}

__global__ void __launch_bounds__(512, 2) k_mega(Params p) {
    extern __shared__ __attribute__((aligned(16))) unsigned char smem[];
    LDSP unsigned char* lds = (LDSP unsigned char*)smem;
    if (threadIdx.x == 0) *(LDSP u32x4*)(lds + LDS_XB) = (u32x4){0u, 0u, 0u, 0u};
    __syncthreads();
    XcdBarrier bar = xcd_barrier_post(p.bar, (volatile LAS unsigned*)(lds + LDS_XB));
#define PHASE(i, body) if (p.ph_lo <= (i) && (i) < p.ph_hi) { body; if ((i) + 1 < p.ph_hi) xcd_barrier(bar); }
    PHASE(0, phase_prologue(p, lds))
    PHASE(1, phase_proj(p, lds))
    PHASE(2, phase_mixers(p, lds))
    PHASE(5, phase_wout_ln(p, lds))
    PHASE(9, phase_moe_up(p, lds))
    PHASE(10, phase_moe_down(p, lds))
    PHASE(11, phase_final(p, lds))
#undef PHASE
}
}

#ifndef MK_PER_PHASE
#define MK_PER_PHASE 0
#endif
extern "C" void kernel_launch(void* const* d_in, const int* in_sizes, int n_in, void* d_out, int out_size, void* d_ws, size_t ws_size, hipStream_t stream) {
    static int grid = 0;
    if (!grid) {
        int dev = 0, cus = 0;
        if (hipGetDevice(&dev) != hipSuccess || hipDeviceGetAttribute(&cus, hipDeviceAttributeMultiprocessorCount, dev) != hipSuccess || cus < 1) return;
        if (hipFuncSetAttribute((const void*)k_mega, hipFuncAttributeMaxDynamicSharedMemorySize, LDS_TOTAL) != hipSuccess) return;
        grid = cus;
    }
    Params p{};
    const float** inp = (const float**)&p.x;
    for (int i = 0; i < 25; ++i) inp[i] = (const float*)d_in[i];
    p.out = (float*)d_out;
    char* ws = (char*)d_ws; size_t off = 0;
    auto take = [&](size_t bytes) { char* q = ws + off; off += (bytes + 255) & ~(size_t)255; return q; };
    p.bar = (unsigned*)take(XCD_BAR_WORDS * 4);
    const size_t ctl_bytes = off;
    p.cntp = (int*)take((size_t)NSEG * NE * CNT_STRIDE * 4);
    p.list = (int*)take((size_t)NE * NSEG * SEGCAP * 4); p.ctab = (int*)take((size_t)NE * NSEG * 4);
    p.xb = (bf16_t*)take((size_t)NT * 1024 * 2); p.w_inT = (bf16_t*)take((size_t)2048 * 1024 * 2); p.rope = (float*)take(2048 * 8 * 2 * 4);
    p.q = (bf16_t*)take((size_t)NT * 512 * 2); p.k = (bf16_t*)take((size_t)NT * 512 * 2); p.v = (bf16_t*)take((size_t)NT * 512 * 2); p.u = (bf16_t*)take((size_t)NT * 512 * 2);
    p.opart = (bf16_t*)take((size_t)3 * NT * 512 * 2); p.lse = (float*)take((size_t)3 * NT * 8 * 4);
    p.wendT = (bf16_t*)take((size_t)32 * 128 * 256 * 2); p.wcarT = (bf16_t*)take((size_t)32 * 256 * 128 * 2); p.klagT = (bf16_t*)take((size_t)32 * 16 * 256 * 2); p.a16 = (float*)take((size_t)32 * 64 * 2 * 4);
    p.w_gluT = (bf16_t*)take((size_t)512 * 512 * 2); p.yss = (bf16_t*)take((size_t)NT * 512 * 2);
    p.w_outT = (bf16_t*)take((size_t)1024 * 1024 * 2); p.rsT = (bf16_t*)take((size_t)768 * 1024 * 2); p.sdT = (bf16_t*)take((size_t)1024 * 256 * 2);
    p.h1b = (bf16_t*)take((size_t)NT * 1024 * 2); p.logits = (float*)take((size_t)NT * 256 * 4);
    p.pre2b = (bf16_t*)take((size_t)NT * 1024 * 2); p.h1q = (unsigned char*)take((size_t)NT * 1024); p.gate = (float*)take((size_t)NT * 8 * 4); p.inv = (int*)take((size_t)NT * 8 * 4);
    p.w_gu8 = (unsigned char*)take((size_t)256 * 512 * 1024); p.w_dn8 = (unsigned char*)take((size_t)256 * 1024 * 256);
    p.act8 = (unsigned char*)take((size_t)(NT * 8 + 256 * 16 + 512) * 256); p.contrib8 = (unsigned char*)take((size_t)(NT * 8 + 256 * 16 + 512) * 1024);
    if (off > ws_size) return;
    (void)hipMemsetAsync(ws, 0, ctl_bytes, stream);
#if MK_PER_PHASE
    for (int i = 0; i < N_PHASES; ++i) { p.ph_lo = i; p.ph_hi = i + 1; hipLaunchKernelGGL(k_mega, dim3(grid), dim3(512), LDS_TOTAL, stream, p); }
#else
    p.ph_lo = 0; p.ph_hi = N_PHASES;
    hipLaunchKernelGGL(k_mega, dim3(grid), dim3(512), LDS_TOTAL, stream, p);
#ifdef PROBE_PHASE
    (void)hipMemsetAsync(ws, 0, XCD_BAR_WORDS * 4, stream);
    p.ph_lo = PROBE_PHASE; p.ph_hi = PROBE_PHASE + 1;
    hipLaunchKernelGGL(k_mega, dim3(grid), dim3(512), LDS_TOTAL, stream, p);
#endif
#endif
}
```

```cpp
#include <hip/hip_runtime.h>
#include <stdint.h>

namespace {
constexpr int B_ = 8, L_ = 2048, D_ = 1024, NT = B_ * L_;
constexpr int NE = 256, TOPK = 8;
constexpr int NSEG = 8, SEGCAP = 2048, CNT_STRIDE = 64;
constexpr float ALPHA = 1.189207115002721f;

__device__ __forceinline__ float gelu_tanh(float x) {
    const float z2 = 1.5957691216057308f * (x + 0.044715f * x * x * x);
    return x / (1.f + __expf(-z2));
}
__device__ __forceinline__ float wave_sum(float v) {
#pragma unroll
    for (int s = 32; s >= 1; s >>= 1) v += __shfl_xor(v, s);
    return v;
}
#define XB_TMO      128
#define XB_XCNT(j)  (256  + 64 * (j))
#define XB_XSUB(j)  (1280 + 64 * (j))
#define XB_XGEN(j)  (2304 + 64 * (j))
#define XB_TOP      3328
#define XB_TOPGEN   3392
#define XCD_BAR_WORDS 3456
#define XB_SPIN_CAP (1u << 18)
#define LAS __attribute__((address_space(3)))

__device__ __forceinline__ unsigned xb_ld(unsigned* p)              { return __hip_atomic_load(p, __ATOMIC_RELAXED, __HIP_MEMORY_SCOPE_AGENT); }
__device__ __forceinline__ unsigned xb_add(unsigned* p, unsigned v) { return __hip_atomic_fetch_add(p, v, __ATOMIC_RELAXED, __HIP_MEMORY_SCOPE_AGENT); }
__device__ __forceinline__ unsigned xb_xcc_id() { return (unsigned)__builtin_amdgcn_s_getreg((3 << 11) | 20) & 0xFu; }
#define XB_SPIN(cond, bar) do { unsigned _sp = 0; while (cond) { __builtin_amdgcn_s_sleep(1); \
    if ((++_sp & 255u) == 0u) { if (xb_ld(&(bar)[XB_TMO])) break; if (_sp > XB_SPIN_CAP) { atomicAdd(&(bar)[XB_TMO], 1u); break; } } } } while (0)

struct XcdBarrier {
    unsigned* bar; unsigned x;
    volatile LAS unsigned* st;
};

__device__ __forceinline__ XcdBarrier xcd_barrier_post(unsigned* bar, volatile LAS unsigned* st) {
    XcdBarrier b; b.bar = bar; b.x = xb_xcc_id(); b.st = st;
    if (threadIdx.x == 0) (void)xb_add(&bar[XB_XCNT(b.x)], 1u);
    return b;
}
__device__ __forceinline__ void xcd_barrier_complete(unsigned* bar, unsigned x, unsigned& nloc, unsigned& nx) {
    const unsigned G = gridDim.x * gridDim.y * gridDim.z;
    unsigned sum, cnt, mine, sp = 0u;
    for (;;) {
        sum = 0u; cnt = 0u; mine = 0u;
#pragma unroll
        for (unsigned j = 0; j < 16; ++j) { const unsigned c = xb_ld(&bar[XB_XCNT(j)]); sum += c; cnt += (c > 0u) ? 1u : 0u; mine = (j == x) ? c : mine; }
        if (sum == G) break;
        __builtin_amdgcn_s_sleep(1);
        if ((++sp & 255u) == 0u) { if (xb_ld(&bar[XB_TMO])) break; if (sp > XB_SPIN_CAP) { atomicAdd(&bar[XB_TMO], 1u); break; } }
    }
    nloc = mine > 0u ? mine : 1u; nx = cnt > 0u ? cnt : 1u;
}

__device__ __forceinline__ void xcd_barrier(const XcdBarrier& b) {
    asm volatile("s_waitcnt vmcnt(0)" ::: "memory");
    __syncthreads();
    if (threadIdx.x == 0) {
        unsigned* bar = b.bar;
        __builtin_amdgcn_s_waitcnt(0);
        unsigned nloc = b.st[0], nx = b.st[1];
        if (nloc == 0u) { xcd_barrier_complete(bar, b.x, nloc, nx); b.st[0] = nloc; b.st[1] = nx; }
        const unsigned old = xb_add(&bar[XB_XSUB(b.x)], 1u);
        const unsigned gen = old / nloc;
        if (old + 1u == (gen + 1u) * nloc) {
            __builtin_amdgcn_fence(__ATOMIC_RELEASE, "agent");
            asm volatile("s_waitcnt vmcnt(0)" ::: "memory");
            const unsigned og = xb_add(&bar[XB_TOP], 1u);
            const unsigned tg = og / nx;
            if (og + 1u == (tg + 1u) * nx) xb_add(&bar[XB_TOPGEN], 1u);
            else XB_SPIN(xb_ld(&bar[XB_TOPGEN]) == tg, bar);
            __builtin_amdgcn_fence(__ATOMIC_ACQUIRE, "agent");
            xb_add(&bar[XB_XGEN(b.x)], 1u);
            asm volatile("s_waitcnt vmcnt(0)" ::: "memory");
        } else {
            XB_SPIN(xb_ld(&bar[XB_XGEN(b.x)]) == gen, bar);
            __builtin_amdgcn_fence(__ATOMIC_ACQUIRE, "agent");
            asm volatile("s_waitcnt vmcnt(0)" ::: "memory");
        }
    }
    __syncthreads();
}


typedef unsigned short bf16_t;
typedef short bf16x8 __attribute__((ext_vector_type(8)));
typedef float f32x4 __attribute__((ext_vector_type(4)));
typedef unsigned u32x2 __attribute__((ext_vector_type(2)));
typedef unsigned u32x4 __attribute__((ext_vector_type(4)));
#define LDSP __attribute__((address_space(3)))
typedef short s16x4 __attribute__((ext_vector_type(4)));
__device__ __forceinline__ s16x4 vtr(const LDSP unsigned char* p) { return __builtin_bit_cast(s16x4, __builtin_amdgcn_ds_read_tr16_b64_v4i16((LDSP s16x4*)p)); }

__device__ __forceinline__ unsigned f2bf(float f) { unsigned u = __builtin_bit_cast(unsigned, f); return (u + 0x7fffu + ((u >> 16) & 1u)) >> 16; }
typedef float f32x2_t __attribute__((ext_vector_type(2))); typedef __bf16 bf16x2_t __attribute__((ext_vector_type(2)));
__device__ __forceinline__ unsigned pk2(float lo, float hi) { f32x2_t v = {lo, hi}; bf16x2_t b = __builtin_convertvector(v, bf16x2_t); return __builtin_bit_cast(unsigned, b); }
__device__ __forceinline__ float bf2f(unsigned short b) { return __builtin_bit_cast(float, (unsigned)b << 16); }
typedef int i32x4_t __attribute__((ext_vector_type(4))); typedef int i32x8_t __attribute__((ext_vector_type(8)));
constexpr float F8_SH = 4.f, F8_SW = 64.f, F8_SA = 8.f, F8_SC = 16.f;
__device__ __forceinline__ float f8clamp(float x) { return __builtin_amdgcn_fmed3f(x, -448.f, 448.f); }
__device__ __forceinline__ unsigned pk4f8(float a, float b, float c, float d) {
    unsigned w = 0;
    w = __builtin_amdgcn_cvt_pk_fp8_f32(f8clamp(a), f8clamp(b), w, false);
    w = __builtin_amdgcn_cvt_pk_fp8_f32(f8clamp(c), f8clamp(d), w, true);
    return w;
}
__device__ __forceinline__ f32x2_t f8lo(unsigned w) { return __builtin_amdgcn_cvt_pk_f32_fp8(w, false); }
__device__ __forceinline__ f32x2_t f8hi(unsigned w) { return __builtin_amdgcn_cvt_pk_f32_fp8(w, true); }
__device__ __forceinline__ void mfma_f8(f32x4& c, i32x8_t a, i32x8_t b) { asm volatile("v_mfma_f32_16x16x128_f8f6f4 %0, %1, %2, %0" : "+v"(c) : "v"(a), "v"(b)); }
__device__ __forceinline__ i32x8_t cat8(bf16x8 lo, bf16x8 hi) { return __builtin_shufflevector(__builtin_bit_cast(i32x4_t, lo), __builtin_bit_cast(i32x4_t, hi), 0, 1, 2, 3, 4, 5, 6, 7); }

struct RowId { __device__ __forceinline__ int operator()(int n) const { return n; } };
struct RowGU64 { __device__ __forceinline__ int operator()(int j) const { const int up = j >> 8, jj = j & 255; return (jj >> 5) * 64 + up * 32 + (jj & 31); } };
struct RowGU { __device__ __forceinline__ int operator()(int j) const { const int up = j >> 8, jj = j & 255; return (jj >> 7) * 256 + up * 128 + (jj & 127); } };
constexpr float QSCALE = 0.125f * 1.4426950408889634f;
struct ARowDense { const unsigned char* base; size_t ld; __device__ __forceinline__ const unsigned char* operator()(int r) const { return base + (size_t)r * ld; } };
typedef float f32x16 __attribute__((ext_vector_type(16)));
constexpr int ATT_UNITS = 3 * 64 * 64;
constexpr int ATT_VROW = 192, ATT_WLDS = 32 * ATT_VROW;
struct AttArgs { const bf16_t* q; const bf16_t* k; const bf16_t* v; bf16_t* opart; float* lse; };

__device__ __forceinline__ void attn_unit(const AttArgs& A, int u, LDSP unsigned char* vs, int lane) {
    const int c = u >> 12, rem = u & 4095, bh = rem >> 6, j = rem & 63;
    const int dsh = 2 * c, d = 1 << dsh, nblk = 64 >> dsh;
    const int r = j / nblk, a = j % nblk;
    const int l31 = lane & 31, h2 = lane >> 5;
    const bf16_t* Qb = A.q + (size_t)bh * 2048 * 64;
    const bf16_t* Kb = A.k + (size_t)bh * 2048 * 64;
    const bf16_t* Vb = A.v + (size_t)bh * 2048 * 64;
    const int sq = 32 * a + l31;
    const int tq = sq * d + r;
    bf16x8 qf[4];
    {
        const bf16_t* qp = Qb + (size_t)tq * 64 + 8 * h2;
#pragma unroll
        for (int s = 0; s < 4; ++s) qf[s] = *(const bf16x8*)(qp + 16 * s);
    }
    bf16x8 kf[5][4];
#pragma unroll
    for (int kt = 0; kt < 5; ++kt) {
        const int k0 = 32 * a - 128 + 32 * kt;
        const int kr = k0 >= 0 ? k0 + l31 : 0;
        const bf16_t* kp = Kb + (size_t)(kr * d + r) * 64 + 8 * h2;
#pragma unroll
        for (int s = 0; s < 4; ++s) kf[kt][s] = *(const bf16x8*)(kp + 16 * s);
    }
    u32x4 vreg[4];
#define ATT_VLOAD(kt_) do { const int k0_ = 32 * a - 128 + 32 * (kt_); _Pragma("unroll") for (int i = 0; i < 4; ++i) { const int id = lane + 64 * i, row = id >> 3, ch = id & 7; \
        const int vr_ = k0_ >= 0 ? k0_ + row : 0; vreg[i] = *(const u32x4*)(Vb + (size_t)(vr_ * d + r) * 64 + ch * 8); } } while (0)
    ATT_VLOAD(0);
    f32x16 S[5];
#pragma unroll
    for (int kt = 0; kt < 5; ++kt) {
        const int k0 = 32 * a - 128 + 32 * kt;
        f32x16 acc;
#pragma unroll
        for (int i = 0; i < 16; ++i) acc[i] = 0.f;
#pragma unroll
        for (int s = 0; s < 4; ++s) acc = __builtin_amdgcn_mfma_f32_32x32x16_bf16(kf[kt][s], qf[s], acc, 0, 0, 0);
        if (kt == 0 || kt == 4) {
#pragma unroll
            for (int i = 0; i < 16; ++i) {
                const int keyrow = (i & 3) + 8 * (i >> 2) + 4 * h2;
                const int dist = sq - (k0 + keyrow);
                if (dist < 0 || dist > 128) acc[i] = -INFINITY;
            }
        }
        if (k0 < 0) {
#pragma unroll
            for (int i = 0; i < 16; ++i) acc[i] = -INFINITY;
        }
        S[kt] = acc;
    }
    float m = -INFINITY;
#pragma unroll
    for (int kt = 0; kt < 5; ++kt)
#pragma unroll
        for (int i = 0; i < 16; ++i) m = fmaxf(m, S[kt][i]);
    m = fmaxf(m, __shfl_xor(m, 32));
    float l = 0.f;
#pragma unroll
    for (int kt = 0; kt < 5; ++kt)
#pragma unroll
        for (int i = 0; i < 16; ++i) { const float p = exp2f(S[kt][i] - m); S[kt][i] = p; l += p; }
    l += __shfl_xor(l, 32);
    f32x16 O[2];
#pragma unroll
    for (int dt = 0; dt < 2; ++dt)
#pragma unroll
        for (int i = 0; i < 16; ++i) O[dt][i] = 0.f;
    const int g = lane >> 4, li = lane & 15;
    const LDSP unsigned char* vrd = vs + (4 * (g >> 1) + (li >> 2)) * ATT_VROW + (16 * (g & 1) + 4 * (li & 3)) * 2;
#pragma unroll
    for (int kt = 0; kt < 5; ++kt) {
#pragma unroll
        for (int i = 0; i < 4; ++i) { const int id = lane + 64 * i, row = id >> 3, ch = id & 7; *(LDSP u32x4*)(vs + row * ATT_VROW + ch * 16) = vreg[i]; }
        if (kt < 4) ATT_VLOAD(kt + 1);
#pragma unroll
        for (int sp = 0; sp < 2; ++sp) {
            bf16x8 pf;
            {
                u32x4 w;
                w.x = pk2(S[kt][8 * sp + 0], S[kt][8 * sp + 1]); w.y = pk2(S[kt][8 * sp + 2], S[kt][8 * sp + 3]);
                w.z = pk2(S[kt][8 * sp + 4], S[kt][8 * sp + 5]); w.w = pk2(S[kt][8 * sp + 6], S[kt][8 * sp + 7]);
                pf = __builtin_bit_cast(bf16x8, w);
            }
#pragma unroll
            for (int dt = 0; dt < 2; ++dt) {
                const s16x4 lo = vtr(vrd + (16 * sp) * ATT_VROW + dt * 64);
                const s16x4 hi = vtr(vrd + (16 * sp + 8) * ATT_VROW + dt * 64);
                const bf16x8 vf = (bf16x8){lo[0], lo[1], lo[2], lo[3], hi[0], hi[1], hi[2], hi[3]};
                O[dt] = __builtin_amdgcn_mfma_f32_32x32x16_bf16(vf, pf, O[dt], 0, 0, 0);
            }
        }
    }
#undef ATT_VLOAD
    const float il = 1.f / l;
    const int b = bh >> 3, h = bh & 7;
    const size_t tok = (size_t)b * 2048 + tq;
    bf16_t* op = A.opart + ((size_t)c * NT + tok) * 512 + h * 64 + 4 * h2;
#pragma unroll
    for (int dt = 0; dt < 2; ++dt)
#pragma unroll
        for (int g4 = 0; g4 < 4; ++g4) {
            u32x2 w; w.x = pk2(O[dt][4 * g4 + 0] * il, O[dt][4 * g4 + 1] * il); w.y = pk2(O[dt][4 * g4 + 2] * il, O[dt][4 * g4 + 3] * il);
            *(u32x2*)(op + 32 * dt + 8 * g4) = w;
        }
    if (h2 == 0) A.lse[((size_t)c * NT + tok) * 8 + h] = m + log2f(l);
}
constexpr int AW_UNITS = 3 * 64 * 8, AW_KP = 144, AW_VP = 192, AW_KBYTES = 384 * AW_KP;
struct AwPre { u32x4 k[6], v[6]; bf16x8 q[4]; };
__device__ __forceinline__ int aw_key_token(int c, int j, int kk) {
    if (c == 2) { const int rr = (kk >> 7) & 1, ks = kk & 127; return ks * 16 + 2 * j + rr; }
    const int d = c ? 4 : 1, r = c ? (j >> 1) : 0, A = c ? (j & 1) : j;
    int ks = 256 * A - 128 + kk; ks = ks < 0 ? 0 : ks;
    return ks * d + r;
}
__device__ __forceinline__ void aw_wave_coords(int c, int j, int w, int l31, int& d, int& r, int& sq, int& k00, int& lrow00) {
    if (c == 2) { const int rr = w >> 2, a = w & 3; d = 16; r = 2 * j + rr; sq = 32 * a + l31; k00 = 32 * a - 128; lrow00 = rr * 128 + k00; }
    else { d = c ? 4 : 1; r = c ? (j >> 1) : 0; const int A = c ? (j & 1) : j; sq = 256 * A + 32 * w + l31; k00 = 256 * A + 32 * w - 128; lrow00 = 32 * w; }
}
__device__ __forceinline__ void aw_prefetch(const AttArgs& A, int U, AwPre& P, int tid) {
    const int c = U >> 9, rem = U & 511, bh = rem >> 3, j = rem & 7;
    const bf16_t* Kb = A.k + (size_t)bh * 2048 * 64; const bf16_t* Vb = A.v + (size_t)bh * 2048 * 64;
    const int ch = tid & 7, row0 = tid >> 3;
#pragma unroll
    for (int i = 0; i < 6; ++i) {
        const size_t off = (size_t)aw_key_token(c, j, row0 + 64 * i) * 64 + ch * 8;
        P.k[i] = *(const u32x4*)(Kb + off); P.v[i] = *(const u32x4*)(Vb + off);
    }
    const int lane = tid & 63, w = tid >> 6, l31 = lane & 31, h2 = lane >> 5;
    int d, r, sq, k00, lrow00; aw_wave_coords(c, j, w, l31, d, r, sq, k00, lrow00);
    const bf16_t* qp = A.q + ((size_t)bh * 2048 + (size_t)sq * d + r) * 64 + 8 * h2;
#pragma unroll
    for (int s_ = 0; s_ < 4; ++s_) P.q[s_] = *(const bf16x8*)(qp + 16 * s_);
}
__device__ __forceinline__ void aw_stage(const AwPre& P, LDSP unsigned char* lds, int tid) {
    const int ch = tid & 7, row0 = tid >> 3;
#pragma unroll
    for (int i = 0; i < 6; ++i) {
        *(LDSP u32x4*)(lds + (row0 + 64 * i) * AW_KP + ch * 16) = P.k[i];
        *(LDSP u32x4*)(lds + AW_KBYTES + (row0 + 64 * i) * AW_VP + ch * 16) = P.v[i];
    }
}
__device__ __forceinline__ void aw_compute(const AttArgs& A, int U, const bf16x8 (&qf)[4], const LDSP unsigned char* lds, int tid) {
    const int c = U >> 9, rem = U & 511, bh = rem >> 3, j = rem & 7;
    const int lane = tid & 63, w = __builtin_amdgcn_readfirstlane(tid >> 6), l31 = lane & 31, h2 = lane >> 5;
    int d, r, sq, k00, lrow00; aw_wave_coords(c, j, w, l31, d, r, sq, k00, lrow00);
    const int tq = sq * d + r;
    f32x16 S[5];
#pragma unroll
    for (int kt = 0; kt < 5; ++kt) {
        const int k0 = k00 + 32 * kt;
        int lrow = lrow00 + 32 * kt; lrow = lrow < 0 ? 0 : lrow;
        const LDSP unsigned char* kp = lds + (lrow + l31) * AW_KP + 16 * h2;
        f32x16 acc;
#pragma unroll
        for (int i = 0; i < 16; ++i) acc[i] = 0.f;
#pragma unroll
        for (int s_ = 0; s_ < 4; ++s_) acc = __builtin_amdgcn_mfma_f32_32x32x16_bf16(*(const LDSP bf16x8*)(kp + 32 * s_), qf[s_], acc, 0, 0, 0);
        if (kt == 0 || kt == 4) {
#pragma unroll
            for (int i = 0; i < 16; ++i) {
                const int keyrow = (i & 3) + 8 * (i >> 2) + 4 * h2;
                const int dist = sq - (k0 + keyrow);
                if (dist < 0 || dist > 128) acc[i] = -INFINITY;
            }
        }
        if (k0 < 0) {
#pragma unroll
            for (int i = 0; i < 16; ++i) acc[i] = -INFINITY;
        }
        S[kt] = acc;
    }
    float m = -INFINITY;
#pragma unroll
    for (int kt = 0; kt < 5; ++kt)
#pragma unroll
        for (int i = 0; i < 16; ++i) m = fmaxf(m, S[kt][i]);
    m = fmaxf(m, __shfl_xor(m, 32));
    float l = 0.f;
#pragma unroll
    for (int kt = 0; kt < 5; ++kt)
#pragma unroll
        for (int i = 0; i < 16; ++i) { const float pe = exp2f(S[kt][i] - m); S[kt][i] = pe; l += pe; }
    l += __shfl_xor(l, 32);
    f32x16 O[2];
#pragma unroll
    for (int dt = 0; dt < 2; ++dt)
#pragma unroll
        for (int i = 0; i < 16; ++i) O[dt][i] = 0.f;
    const int g = lane >> 4, li = lane & 15;
    const int vro = (4 * (g >> 1) + (li >> 2)) * AW_VP + (16 * (g & 1) + 4 * (li & 3)) * 2;
#pragma unroll
    for (int kt = 0; kt < 5; ++kt) {
        int lrow = lrow00 + 32 * kt; lrow = lrow < 0 ? 0 : lrow;
        const LDSP unsigned char* vrd = lds + AW_KBYTES + lrow * AW_VP + vro;
#pragma unroll
        for (int sp = 0; sp < 2; ++sp) {
            bf16x8 pf;
            {
                u32x4 w4;
                w4.x = pk2(S[kt][8 * sp + 0], S[kt][8 * sp + 1]); w4.y = pk2(S[kt][8 * sp + 2], S[kt][8 * sp + 3]);
                w4.z = pk2(S[kt][8 * sp + 4], S[kt][8 * sp + 5]); w4.w = pk2(S[kt][8 * sp + 6], S[kt][8 * sp + 7]);
                pf = __builtin_bit_cast(bf16x8, w4);
            }
#pragma unroll
            for (int dt = 0; dt < 2; ++dt) {
                const s16x4 lo = vtr(vrd + (16 * sp) * AW_VP + dt * 64);
                const s16x4 hi = vtr(vrd + (16 * sp + 8) * AW_VP + dt * 64);
                const bf16x8 vf = (bf16x8){lo[0], lo[1], lo[2], lo[3], hi[0], hi[1], hi[2], hi[3]};
                O[dt] = __builtin_amdgcn_mfma_f32_32x32x16_bf16(vf, pf, O[dt], 0, 0, 0);
            }
        }
    }
    const float il = 1.f / l;
    const int b = bh >> 3, h = bh & 7;
    const size_t tok = (size_t)b * 2048 + tq;
    bf16_t* op = A.opart + ((size_t)c * NT + tok) * 512 + h * 64 + 4 * h2;
#pragma unroll
    for (int dt = 0; dt < 2; ++dt)
#pragma unroll
        for (int g4 = 0; g4 < 4; ++g4) {
            u32x2 w2; w2.x = pk2(O[dt][4 * g4 + 0] * il, O[dt][4 * g4 + 1] * il); w2.y = pk2(O[dt][4 * g4 + 2] * il, O[dt][4 * g4 + 3] * il);
            *(u32x2*)(op + 32 * dt + 8 * g4) = w2;
        }
    if (h2 == 0) A.lse[((size_t)c * NT + tok) * 8 + h] = m + log2f(l);
}
struct SsmTabArgs { const float* lam_re; const float* lam_im; const float* log_step; const float* b_re; const float* b_im; const float* c_re; const float* c_im;
                    bf16_t* wendT; bf16_t* wcarT; bf16_t* klagT; float* a16; };
__device__ __forceinline__ void ssm_apow(const SsmTabArgs& A, int g, int p, float k, float& pr, float& pi) {
    const float lr = A.lam_re[g * 64 + p], li = A.lam_im[g * 64 + p], step = expf(A.log_step[g]);
    const float e = expf(k * lr * step); pr = e * cosf(k * li * step); pi = e * sinf(k * li * step);
}
__device__ __forceinline__ void ssm_coef(const SsmTabArgs& A, int g, int p, float& cr, float& ci) {
    const float lr = A.lam_re[g * 64 + p], li = A.lam_im[g * 64 + p];
    float ar, ai; ssm_apow(A, g, p, 1.f, ar, ai);
    const float nr = ar - 1.f, ni = ai, den = lr * lr + li * li;
    cr = (nr * lr + ni * li) / den; ci = (ni * lr - nr * li) / den;
}
__device__ __forceinline__ size_t ft_off(int n, int k, int K) { return ((size_t)((n >> 4) * (K >> 5) + (k >> 5)) << 9) + (((k >> 3) & 3) << 7) + ((n & 15) << 3) + (k & 7); }
__device__ __forceinline__ void ssm_tab_item(const SsmTabArgs& A, int it) {
    if (it < 32768) {
        const int s = it & 15, p = (it >> 4) & 63, g = it >> 10;
        float pr, pi, cr, ci; ssm_apow(A, g, p, (float)(15 - s), pr, pi); ssm_coef(A, g, p, cr, ci);
        const float mr = pr * cr - pi * ci, mi = pr * ci + pi * cr;
        bf16_t* wb = A.wendT + (size_t)g * 128 * 256;
#pragma unroll
        for (int c = 0; c < 16; ++c) {
            const float br = A.b_re[((size_t)g * 64 + p) * 16 + c], bi = A.b_im[((size_t)g * 64 + p) * 16 + c];
            wb[ft_off(p, s * 16 + c, 256)] = (bf16_t)f2bf(mr * br - mi * bi); wb[ft_off(64 + p, s * 16 + c, 256)] = (bf16_t)f2bf(mr * bi + mi * br);
        }
    } else if (it < 65536) {
        const int j = it - 32768; const int t = j & 15, p = (j >> 4) & 63, g = j >> 10;
        float pr, pi; ssm_apow(A, g, p, (float)(t + 1), pr, pi);
#pragma unroll
        for (int co = 0; co < 16; ++co) {
            const float cr = A.c_re[((size_t)g * 16 + co) * 64 + p], ci = A.c_im[((size_t)g * 16 + co) * 64 + p];
            bf16_t* wb = A.wcarT + (size_t)g * 256 * 128;
            wb[ft_off(t * 16 + co, p, 128)] = (bf16_t)f2bf(cr * pr - ci * pi); wb[ft_off(t * 16 + co, 64 + p, 128)] = (bf16_t)f2bf(-(cr * pi + ci * pr));
        }
    } else {
        const int j = it - 65536; const int p = j & 63, g = j >> 6;
        float pr, pi; ssm_apow(A, g, p, 16.f, pr, pi);
        A.a16[(size_t)j * 2] = pr; A.a16[(size_t)j * 2 + 1] = pi;
    }
}
constexpr int SSM_TAB_ITEMS = 65536 + 2048;
__device__ __forceinline__ void ssm_klag_item(const SsmTabArgs& A, int it, LDSP float* scr, int tid) {
    const int g = it >> 4, lag = it & 15;
    LDSP float* Mr = scr; LDSP float* Mi = scr + 1024; LDSP float* Cr = scr + 2048; LDSP float* Ci = scr + 3072;
    __syncthreads();
    if (tid < 64) {
        const int p = tid; float pr, pi, cr, ci; ssm_apow(A, g, p, (float)lag, pr, pi); ssm_coef(A, g, p, cr, ci);
        const float mr = pr * cr - pi * ci, mi = pr * ci + pi * cr;
#pragma unroll
        for (int c = 0; c < 16; ++c) {
            const float br = A.b_re[((size_t)g * 64 + p) * 16 + c], bi = A.b_im[((size_t)g * 64 + p) * 16 + c];
            Mr[p * 16 + c] = mr * br - mi * bi; Mi[p * 16 + c] = mr * bi + mi * br;
            Cr[p * 16 + c] = A.c_re[((size_t)g * 16 + c) * 64 + p]; Ci[p * 16 + c] = A.c_im[((size_t)g * 16 + c) * 64 + p];
        }
    }
    __syncthreads();
    if (tid < 256) {
        const int co = tid >> 4, ci_ = tid & 15; float acc = 0.f;
        for (int p = 0; p < 64; ++p) acc += Cr[p * 16 + co] * Mr[p * 16 + ci_] - Ci[p * 16 + co] * Mi[p * 16 + ci_];
        A.klagT[(((size_t)g * 16 + lag) * 16 + co) * 16 + ci_] = (bf16_t)f2bf(acc);
    }
}

struct SsmArgs { const bf16_t* u; const bf16_t* wendT; const bf16_t* wcarT; const bf16_t* klagT; const float* a16; const float* d_skip; bf16_t* yss; };
__device__ __forceinline__ void ssm_stage_u(LDSP unsigned char* lds, const bf16_t* ubase  , int hh, int tid) {
#pragma unroll
    for (int i = 0; i < 4; ++i) {
        const int id = tid + 512 * i, row = id >> 5, ch = id & 31;
        const u32x4 w = *(const u32x4*)(ubase + (size_t)(64 * hh + row) * 256 + ch * 8);
        *(LDSP u32x4*)(lds + (ch >> 3) * 8192 + row * 128 + (((ch & 7) ^ (row & 7)) * 16)) = w;
    }
}
__device__ __forceinline__ void ssm_unit(const SsmArgs& A, int bg, LDSP unsigned char* lds) {
    const int tid = threadIdx.x, lane = tid & 63, w = __builtin_amdgcn_readfirstlane(tid >> 6), fr = lane & 15, fq = lane >> 4;
    const int g = bg & 31, b = bg >> 5;
    const bf16_t* ubase = A.u + (size_t)bg * 2048 * 16;
    LDSP unsigned char* Ebuf = lds + 32768; LDSP unsigned char* Xbuf = lds + 98304;
    const bf16_t* wend = A.wendT + (size_t)g * 128 * 256;
    const bf16_t* wcar = A.wcarT + (size_t)g * 256 * 128;
    const bf16_t* klag = A.klagT + (size_t)g * 16 * 256;
    for (int hh = 0; hh < 2; ++hh) {
        __syncthreads();
        ssm_stage_u(lds, ubase, hh, tid);
        __syncthreads();
        f32x4 acc[4];
#pragma unroll
        for (int mi = 0; mi < 4; ++mi) acc[mi] = (f32x4){0.f, 0.f, 0.f, 0.f};
#pragma unroll
        for (int kk = 0; kk < 8; ++kk) {
            const bf16x8 wf = *(const bf16x8*)(wend + ((size_t)(w * 8 + kk) << 9) + lane * 8);
#pragma unroll
            for (int mi = 0; mi < 4; ++mi) {
                const bf16x8 af = *(const LDSP bf16x8*)(lds + (kk >> 1) * 8192 + (16 * mi + fr) * 128 + (((((kk & 1) * 4) + fq) ^ (fr & 7)) * 16));
                acc[mi] = __builtin_amdgcn_mfma_f32_16x16x32_bf16(wf, af, acc[mi], 0, 0, 0);
            }
        }
#pragma unroll
        for (int mi = 0; mi < 4; ++mi) *(LDSP f32x4*)(Ebuf + ((64 * hh + 16 * mi + fr) * 128 + 16 * w + 4 * fq) * 4) = acc[mi];
    }
    __syncthreads();
    {
        const float ar = A.a16[((size_t)g * 64 + lane) * 2], ai = A.a16[((size_t)g * 64 + lane) * 2 + 1];
        LDSP float* Tb = (LDSP float*)(lds + 131072);
        float Lr[16], Li[16];
        float cr = 0.f, ci = 0.f;
#pragma unroll
        for (int j = 0; j < 16; ++j) {
            const int c = 16 * w + j;
            const float er = *(const LDSP float*)(Ebuf + (c * 128 + lane) * 4), ei = *(const LDSP float*)(Ebuf + (c * 128 + 64 + lane) * 4);
            Lr[j] = cr; Li[j] = ci;
            const float nr = ar * cr - ai * ci + er, ni = ar * ci + ai * cr + ei;
            cr = nr; ci = ni;
        }
        Tb[w * 128 + lane] = cr; Tb[w * 128 + 64 + lane] = ci;
        float pr = ar, pi = ai;
#pragma unroll
        for (int q = 0; q < 4; ++q) { const float tr = pr * pr - pi * pi, ti = 2.f * pr * pi; pr = tr; pi = ti; }
        __syncthreads();
        float gr = 0.f, gi = 0.f;
        for (int v = 0; v < w; ++v) {
            const float tr = Tb[v * 128 + lane], ti = Tb[v * 128 + 64 + lane];
            const float nr = pr * gr - pi * gi + tr, ni = pr * gi + pi * gr + ti;
            gr = nr; gi = ni;
        }
        const int xo = (lane >> 3), xb = (lane & 7) * 2;
        float qr = 1.f, qi = 0.f;
#pragma unroll
        for (int j = 0; j < 16; ++j) {
            const int c = 16 * w + j;
            const float xr = Lr[j] + qr * gr - qi * gi, xi = Li[j] + qr * gi + qi * gr;
            const int off = c * 128 + ((xo ^ (c & 7)) * 16) + xb;
            *(LDSP bf16_t*)(Xbuf + off) = (bf16_t)f2bf(xr);
            *(LDSP bf16_t*)(Xbuf + 16384 + off) = (bf16_t)f2bf(xi);
            const float tr = qr * ar - qi * ai, ti = qr * ai + qi * ar; qr = tr; qi = ti;
        }
    }
    __syncthreads();
    for (int hx = 0; hx < 2; ++hx) {
        const int hh = 1 - hx;
        if (hx == 1) { __syncthreads(); ssm_stage_u(lds, ubase, hh, tid); __syncthreads(); }
        f32x4 acc[4][2];
#pragma unroll
        for (int mi = 0; mi < 4; ++mi) { acc[mi][0] = (f32x4){0.f, 0.f, 0.f, 0.f}; acc[mi][1] = (f32x4){0.f, 0.f, 0.f, 0.f}; }
#pragma unroll
        for (int j = 0; j < 2; ++j) {
            const int t = j ? (15 - w) : w;
#pragma unroll
            for (int kk = 0; kk < 8; ++kk) {
                if (2 * kk <= t) {
                    const int s = 2 * kk + (fq >> 1);
                    bf16x8 wf = (bf16x8){0, 0, 0, 0, 0, 0, 0, 0};
                    if (s <= t) wf = *(const bf16x8*)(klag + ((size_t)(t - s) * 16 + fr) * 16 + 8 * (fq & 1));
#pragma unroll
                    for (int mi = 0; mi < 4; ++mi) {
                        const bf16x8 af = *(const LDSP bf16x8*)(lds + (kk >> 1) * 8192 + (16 * mi + fr) * 128 + (((((kk & 1) * 4) + fq) ^ (fr & 7)) * 16));
                        acc[mi][j] = __builtin_amdgcn_mfma_f32_16x16x32_bf16(wf, af, acc[mi][j], 0, 0, 0);
                    }
                }
            }
#pragma unroll
            for (int k2 = 0; k2 < 4; ++k2) {
                const bf16x8 wf = *(const bf16x8*)(wcar + ((size_t)(t * 4 + k2) << 9) + lane * 8);
#pragma unroll
                for (int mi = 0; mi < 4; ++mi) {
                    const int row = 64 * hh + 16 * mi + fr;
                    const bf16x8 xf = *(const LDSP bf16x8*)(Xbuf + (k2 >> 1) * 16384 + row * 128 + (((((k2 & 1) * 4) + fq) ^ (fr & 7)) * 16));
                    acc[mi][j] = __builtin_amdgcn_mfma_f32_16x16x32_bf16(wf, xf, acc[mi][j], 0, 0, 0);
                }
            }
        }
        const float4 dk = *(const float4*)(A.d_skip + g * 16 + 4 * fq);
#pragma unroll
        for (int j = 0; j < 2; ++j) {
            const int t = j ? (15 - w) : w;
#pragma unroll
            for (int mi = 0; mi < 4; ++mi) {
                const int tt = (64 * hh + 16 * mi + fr) * 16 + t;
                const u32x2 uw = *(const u32x2*)(ubase + (size_t)tt * 16 + 4 * fq);
                const f32x4 a = acc[mi][j];
                const float y0 = gelu_tanh(a[0] + dk.x * bf2f(uw.x & 0xffff)), y1 = gelu_tanh(a[1] + dk.y * bf2f(uw.x >> 16));
                const float y2 = gelu_tanh(a[2] + dk.z * bf2f(uw.y & 0xffff)), y3 = gelu_tanh(a[3] + dk.w * bf2f(uw.y >> 16));
                u32x2 o; o.x = pk2(y0, y1); o.y = pk2(y2, y3);
                *(u32x2*)(A.yss + ((size_t)b * 2048 + tt) * 512 + g * 16 + 4 * fq) = o;
            }
        }
    }
}
__device__ __forceinline__ float silu_f(float g) { return g / (1.f + __expf(-g)); }
constexpr int ME_LDS = 147456;
namespace pg {
constexpr int BM = 256, BK = 64, HALF = 128, HTB = HALF * BK * 2, STAGE_BYTES = 8 * HTB;
constexpr int VA_SLOT_OFF = 151552;
__device__ __forceinline__ int lds_byte(int r, int c) { const int st = (r >> 4) * 2 + (c >> 5), rr = r & 15, cc = c & 31, ob = rr * 64 + cc * 2; return st * 1024 + (ob ^ (((ob >> 9) & 1) << 5)); }
__device__ __forceinline__ void stage_rc(int b, int& R, int& C) { const int st = b / 1024, sb = b % 1024, swz = sb ^ (((sb >> 9) & 1) << 5); R = (st >> 1) * 16 + swz / 64; C = (st & 1) * 32 + (swz % 64) / 2; }
struct Unit { const char* A; const char* B; int x0, x1, x2, x3; };
struct LaneRC { int R0, C0, R1, C1; };
__device__ __forceinline__ LaneRC lane_rc() { LaneRC l; stage_rc(threadIdx.x * 16, l.R0, l.C0); stage_rc(threadIdx.x * 16 + 8192, l.R1, l.C1); return l; }
__device__ __forceinline__ LaneRC lane_rc_fresh() { int t = threadIdx.x; asm volatile("" : "+v"(t)); LaneRC l; stage_rc(t * 16, l.R0, l.C0); stage_rc(t * 16 + 8192, l.R1, l.C1); return l; }
struct VA { unsigned v00, v01, v10, v11; };
__device__ __forceinline__ VA dense_va(unsigned lda  ) {
    const LaneRC l = lane_rc(); VA v;
    v.v00 = l.R0 * lda + l.C0 * 2; v.v01 = l.R1 * lda + l.C1 * 2; v.v10 = (128 + l.R0) * lda + l.C0 * 2; v.v11 = (128 + l.R1) * lda + l.C1 * 2; return v;
}
__device__ __forceinline__ int perm32(int rho) { const int n = rho >> 4, i = rho & 15; return 8 * (i >> 2) + 4 * n + (i & 3); }
__device__ __forceinline__ int ragged_row(int h, int R) { return 16 * (2 * (4 * h + ((R >> 4) & 3)) + (R >> 6)) + (R & 15); }
template <bool GATHER, int PERM, bool RAGGED, bool F8, class Sched, class Epi>
__device__ __forceinline__ void gemm_phase(LDSP unsigned char* lds, const int K, const Sched& S, const Epi& E) {
    const int tid = threadIdx.x, wid = __builtin_amdgcn_readfirstlane(tid >> 6), lane = tid & 63, wr = wid >> 2, wc = wid & 3, fr = lane & 15, fq = lane >> 4;
    const int nt = K / BK;
    unsigned voffB[2];
    { int R, C; stage_rc(tid * 16, R, C); if (PERM == 1) R = (R & ~31) + perm32(R & 31); if (PERM == 2) R = 64 * (R >> 5) + 16 * ((R >> 2) & 3) + 4 * ((R >> 4) & 1) + (R & 3); voffB[0] = (unsigned)(R * K + C) * 2u;
      stage_rc(tid * 16 + 8192, R, C); if (PERM == 1) R = (R & ~31) + perm32(R & 31); if (PERM == 2) R = 64 * (R >> 5) + 16 * ((R >> 2) & 3) + 4 * ((R >> 4) & 1) + (R & 3); voffB[1] = (unsigned)(R * K + C) * 2u; }
    const size_t kstep = (size_t)(BK * 2), hstepB = (size_t)(PERM == 2 ? 8 : HALF) * K * 2;
    const unsigned ldsw = (unsigned)wid * 1024u;
    const int aoff = lds_byte(wr * 64 + fr, fq * 8), boff = lds_byte(wc * 32 + fr, fq * 8);
#define PG_SA(b, h) (((b) * 2 + (h)) * HTB)
#define PG_SB(b, h) ((4 + (b) * 2 + (h)) * HTB)
#define PG_STAGE(bufoff, gbase, v0, v1) do { \
        __builtin_amdgcn_global_load_lds((const unsigned*)((const char*)(gbase) + (v0)), (LDSP unsigned*)(lds + (bufoff) + ldsw), 16, 0, 0); \
        __builtin_amdgcn_global_load_lds((const unsigned*)((const char*)(gbase) + (v1)), (LDSP unsigned*)(lds + (bufoff) + ldsw + 8192), 16, 0, 0); } while (0)
#define PG_LDA(dst, b, h) do { _Pragma("unroll") for (int m = 0; m < 4; ++m) _Pragma("unroll") for (int k = 0; k < 2; ++k) dst[m][k] = *(const LDSP bf16x8*)(lds + PG_SA(b, h) + aoff + m * 2048 + k * 1024); } while (0)
#define PG_LDB(dst, b, h) do { _Pragma("unroll") for (int n = 0; n < 2; ++n) _Pragma("unroll") for (int k = 0; k < 2; ++k) dst[n][k] = *(const LDSP bf16x8*)(lds + PG_SB(b, h) + boff + n * 2048 + k * 1024); } while (0)
#define PG_MMA(ai, bj, At, Bt, ML) do { __builtin_amdgcn_s_setprio(1); _Pragma("unroll") for (int m = 0; m < (ML); ++m) { _Pragma("unroll") for (int n = 0; n < 2; ++n) { \
        if constexpr (F8) mfma_f8(acc[ai][bj][m][n], cat8(Bt[n][0], Bt[n][1]), cat8(At[m][0], At[m][1])); \
        else { _Pragma("unroll") for (int k = 0; k < 2; ++k) acc[ai][bj][m][n] = __builtin_amdgcn_mfma_f32_16x16x32_bf16(Bt[n][k], At[m][k], acc[ai][bj][m][n], 0, 0, 0); } } } __builtin_amdgcn_s_setprio(0); } while (0)
#define PG_WAIT_V(n) asm volatile("s_waitcnt vmcnt(" #n ")" ::: "memory")
#define PG_WAIT_L(n) asm volatile("s_waitcnt lgkmcnt(" #n ")" ::: "memory")
#define PG_BAR __builtin_amdgcn_s_barrier()
#define PG_SCHED __builtin_amdgcn_sched_barrier(0)
    Unit cur, nxt; int ui = 0;
    if (!S.next(0, cur)) return;
    f32x4 acc[2][2][4][2];
#pragma unroll
    for (int a = 0; a < 2; ++a)
#pragma unroll
        for (int b = 0; b < 2; ++b)
#pragma unroll
            for (int m = 0; m < 4; ++m)
#pragma unroll
                for (int n = 0; n < 2; ++n) acc[a][b][m][n] = (f32x4){0.f, 0.f, 0.f, 0.f};
    bf16x8 At[4][2], B0[2][2], B1[2][2];
    const char* cA = cur.A; const char* cB = cur.B;
    int nvc = RAGGED ? cur.x1 : 256;
    VA cva = S.va(cur);
    PG_STAGE(PG_SB(0, 0), cB, voffB[0], voffB[1]); PG_STAGE(PG_SB(0, 1), cB + hstepB, voffB[0], voffB[1]);
    PG_STAGE(PG_SA(0, 0), cA, cva.v00, cva.v01); PG_STAGE(PG_SA(0, 1), cA, cva.v10, cva.v11);
    if (wr == 1) PG_BAR;
    PG_WAIT_V(2); PG_BAR;
    PG_STAGE(PG_SB(1, 0), cB + kstep, voffB[0], voffB[1]); PG_STAGE(PG_SA(1, 0), cA + kstep, cva.v00, cva.v01); PG_STAGE(PG_SB(1, 1), cB + hstepB + kstep, voffB[0], voffB[1]);
    PG_WAIT_V(6); PG_BAR;
    for (;;) {
        const bool has_next = S.next(ui + 1, nxt);
        const char* nA = has_next ? nxt.A : cA; const char* nB = has_next ? nxt.B : cB;
        VA nva_ = cva;
        if constexpr (GATHER) {
            if (has_next) nva_ = S.va(nxt);
            if (nt <= 2) *(LDSP u32x4*)(lds + VA_SLOT_OFF + tid * 16) = (u32x4){nva_.v00, nva_.v01, nva_.v10, nva_.v11};
        }
#define PG_BODY(M1) do { \
              \
            PG_LDB(B0, 0, 0); PG_LDB(B1, 0, 1); PG_SCHED; PG_LDA(At, 0, 0); PG_STAGE(PG_SA(1, 1), a1, cva.v10, cva.v11); \
            PG_WAIT_V(8); PG_WAIT_L(0); PG_BAR; PG_MMA(0, 0, At, B0, 4); PG_MMA(0, 1, At, B1, 4); PG_BAR; PG_SCHED; \
            PG_LDA(At, 0, 1); PG_STAGE(PG_SB(0, 0), b2, voffB[0], voffB[1]); PG_STAGE(PG_SB(0, 1), b2 + hstepB, voffB[0], voffB[1]); PG_STAGE(PG_SA(0, 0), a2, v00, v01); \
            PG_WAIT_V(8); PG_WAIT_L(0); PG_BAR; PG_MMA(1, 0, At, B0, M1); PG_MMA(1, 1, At, B1, M1); PG_BAR; PG_SCHED; \
              \
            PG_LDB(B0, 1, 0); PG_LDB(B1, 1, 1); PG_SCHED; PG_LDA(At, 1, 0); PG_STAGE(PG_SA(0, 1), a2, v10, v11); \
            PG_WAIT_V(8); PG_WAIT_L(0); PG_BAR; PG_MMA(0, 0, At, B0, 4); PG_MMA(0, 1, At, B1, 4); PG_BAR; PG_SCHED; \
            PG_LDA(At, 1, 1); PG_STAGE(PG_SB(1, 0), b3, voffB[0], voffB[1]); PG_STAGE(PG_SB(1, 1), b3 + hstepB, voffB[0], voffB[1]); PG_STAGE(PG_SA(1, 0), a3, v00, v01); \
            PG_WAIT_V(8); PG_WAIT_L(0); PG_BAR; PG_MMA(1, 0, At, B0, M1); PG_MMA(1, 1, At, B1, M1); PG_BAR; PG_SCHED; } while (0)
#define PG_TLOOP(M1) do { _Pragma("unroll 1") for (int t = 0; t < nt; t += 2) { \
            const bool last = (t == nt - 2); \
            const char* a1 = cA + (size_t)(t + 1) * kstep; \
            const char* a2 = last ? nA : cA + (size_t)(t + 2) * kstep; const char* b2 = last ? nB : cB + (size_t)(t + 2) * kstep; \
            const char* a3 = a2 + kstep; const char* b3 = b2 + kstep; \
            unsigned v00 = cva.v00, v01 = cva.v01, v10 = cva.v10, v11 = cva.v11; \
            asm volatile("" : "+v"(voffB[0]), "+v"(voffB[1]));        \
            if constexpr (GATHER) { if (last) { const u32x4 q_ = *(const LDSP u32x4*)(lds + VA_SLOT_OFF + tid * 16); v00 = q_.x; v01 = q_.y; v10 = q_.z; v11 = q_.w; } } \
            PG_BODY(M1); \
            if constexpr (GATHER) { if (t == 0 && nt > 2) *(LDSP u32x4*)(lds + VA_SLOT_OFF + tid * 16) = (u32x4){nva_.v00, nva_.v01, nva_.v10, nva_.v11}; } } } while (0)
        if constexpr (RAGGED) {
            if (nvc > 192) PG_TLOOP(4); else if (nvc > 128) PG_TLOOP(2); else PG_TLOOP(0);
        } else PG_TLOOP(4);
#undef PG_TLOOP
#undef PG_BODY
        if (wr == 0) PG_BAR;
        if constexpr (F8) asm volatile("s_nop 15\n\ts_nop 15" ::: "memory");
        E(acc, cur, wr, wc, fr, fq);
        if (!has_next) break;
#pragma unroll
        for (int a = 0; a < 2; ++a)
#pragma unroll
            for (int b = 0; b < 2; ++b)
#pragma unroll
                for (int m = 0; m < 4; ++m)
#pragma unroll
                    for (int n = 0; n < 2; ++n) acc[a][b][m][n] = (f32x4){0.f, 0.f, 0.f, 0.f};
        cur = nxt; cA = nA; cB = nB; ++ui; if (RAGGED) nvc = cur.x1;
        if constexpr (GATHER) { const u32x4 q_ = *(const LDSP u32x4*)(lds + VA_SLOT_OFF + tid * 16); cva.v00 = q_.x; cva.v01 = q_.y; cva.v10 = q_.z; cva.v11 = q_.w; }
        if (wr == 1) PG_BAR;
    }
    PG_WAIT_V(0);
    PG_BAR;
#undef PG_SA
#undef PG_SB
#undef PG_STAGE
#undef PG_LDA
#undef PG_LDB
#undef PG_MMA
#undef PG_WAIT_V
#undef PG_WAIT_L
#undef PG_BAR
#undef PG_SCHED
}
template <class F, class V> struct SchedF { F f; V v; __device__ __forceinline__ bool next(int i, Unit& u) const { return f(i, u); } __device__ __forceinline__ VA va(const Unit& u) const { return v(u); } };
template <class F, class V> __device__ __forceinline__ SchedF<F, V> sched(F f, V v) { return SchedF<F, V>{f, v}; }
template <class F> struct EpiFrag {
    F f;
    __device__ __forceinline__ void operator()(const f32x4 (&acc)[2][2][4][2], const Unit& u, int wr, int wc, int fr, int fq) const {
#pragma unroll
        for (int ai = 0; ai < 2; ++ai)
#pragma unroll
            for (int m = 0; m < 4; ++m) {
                int rr_ = 128 * ai + 64 * wr + 16 * m + fr;
                asm volatile("" : "+v"(rr_));
#pragma unroll
                for (int bj = 0; bj < 2; ++bj)
#pragma unroll
                    for (int n = 0; n < 2; ++n) f(u, rr_, 128 * bj + 32 * wc + 16 * n + 4 * fq, acc[ai][bj][m][n]);
                asm volatile("" ::: "memory");
            }
    }
};
template <class F> __device__ __forceinline__ EpiFrag<F> epi_frag(F f) { return EpiFrag<F>{f}; }
template <class F> struct EpiRow8 {
    F f;
    __device__ __forceinline__ void operator()(const f32x4 (&acc)[2][2][4][2], const Unit& u, int wr, int wc, int fr, int fq) const {
#pragma unroll
        for (int ai = 0; ai < 2; ++ai)
#pragma unroll
            for (int m = 0; m < 4; ++m) {
                int rr_ = 128 * ai + 64 * wr + 16 * m + fr;
                asm volatile("" : "+v"(rr_));
#pragma unroll
                for (int bj = 0; bj < 2; ++bj) f(u, rr_, 128 * bj + 32 * wc + 8 * fq, acc[ai][bj][m][0], acc[ai][bj][m][1]);
                asm volatile("" ::: "memory");
            }
    }
};
template <class F> __device__ __forceinline__ EpiRow8<F> epi_row8(F f) { return EpiRow8<F>{f}; }
__device__ __forceinline__ u32x4 pack8(f32x4 a, f32x4 b) { u32x4 w; w.x = pk2(a[0], a[1]); w.y = pk2(a[2], a[3]); w.z = pk2(b[0], b[1]); w.w = pk2(b[2], b[3]); return w; }
__device__ __forceinline__ bool static_tile(int i, int nM, int nN, int& pm, int& pn) {
    const int nwg = nM * nN; const long L = (long)i * gridDim.x + blockIdx.x; if (L >= nwg) return false;
    int wgid = (int)L; { const int q = nwg / 8, r = nwg % 8, xcd = wgid % 8, off = wgid / 8; wgid = (xcd < r ? xcd * (q + 1) : r * (q + 1) + (xcd - r) * q) + off; }
    const int nig = 8 * nN, gid = wgid / nig, fm = gid * 8, gsz = (nM - fm) < 8 ? (nM - fm) : 8;
    pm = fm + ((wgid % nig) % gsz); pn = (wgid % nig) / gsz; return true;
}
}

__device__ __forceinline__ int moe_ntiles(int c) { return (c + 255) >> 8; }
__device__ __forceinline__ void moe_tile_rows(int c, int j, int& row0, int& nvalid) {
    const int nte = (c + 255) >> 8, rpt = nte ? (((c + nte - 1) / nte + 15) & ~15) : 0;
    row0 = j * rpt; nvalid = min(c - row0, rpt);
}
constexpr int LDS_SP = 131072, LDS_CT = LDS_SP + 256 * NSEG * 4, LDS_WT = LDS_CT + 1024;
template <bool COMPACT>
__device__ __forceinline__ void moe_tile_table(const int* cntp, int* ctab, LDSP unsigned char* lds, LDSP int* ts, int tid) {
    LDSP int* sp = (LDSP int*)(lds + LDS_SP); LDSP int* ct = (LDSP int*)(lds + LDS_CT); LDSP int* wt = (LDSP int*)(lds + LDS_WT);
    const int lane = tid & 63, wid = tid >> 6;
    __syncthreads();
    int c = 0;
    if (tid < 256) {
        int v[NSEG];
        if constexpr (COMPACT) {
            const i32x4_t a0 = *(const i32x4_t*)(ctab + tid * NSEG), a1 = *(const i32x4_t*)(ctab + tid * NSEG + 4);
            v[0] = a0[0]; v[1] = a0[1]; v[2] = a0[2]; v[3] = a0[3]; v[4] = a1[0]; v[5] = a1[1]; v[6] = a1[2]; v[7] = a1[3];
        } else {
#pragma unroll
            for (int sg = 0; sg < NSEG; ++sg) v[sg] = __hip_atomic_load(cntp + (size_t)(sg * 256 + tid) * CNT_STRIDE, __ATOMIC_RELAXED, __HIP_MEMORY_SCOPE_AGENT);
            *(i32x4_t*)(ctab + tid * NSEG) = (i32x4_t){v[0], v[1], v[2], v[3]}; *(i32x4_t*)(ctab + tid * NSEG + 4) = (i32x4_t){v[4], v[5], v[6], v[7]};
        }
#pragma unroll
        for (int sg = 0; sg < NSEG; ++sg) { sp[tid * NSEG + sg] = c; c += v[sg]; }
        ct[tid] = c;
    }
    const int own_t = (c + 255) >> 8, own_a = (c + 15) & ~15;
    int st = own_t, sa = own_a;
#pragma unroll
    for (int d = 1; d < 64; d <<= 1) { const int x = __shfl_up(st, d), y = __shfl_up(sa, d); if (lane >= d) { st += x; sa += y; } }
    if (lane == 63 && wid < 4) { wt[wid * 2] = st; wt[wid * 2 + 1] = sa; }
    __syncthreads();
    if (tid < 256) {
        for (int w2 = 0; w2 < wid; ++w2) { st += wt[w2 * 2]; sa += wt[w2 * 2 + 1]; }
        ts[tid] = st - own_t; ts[260 + tid] = sa - own_a;
        if (tid == 255) ts[256] = st;
    }
    __syncthreads();
}
__device__ __forceinline__ int moe_find_expert(const LDSP int* ts, int tile) {
    int lo = 0, hi = 256;
    while (hi - lo > 1) { const int mid = (lo + hi) >> 1; if (ts[mid] <= tile) lo = mid; else hi = mid; }
    return lo;
}
struct MoeUnit { int e, pn, row0, nvalid, arow0; };
constexpr int MOE_UD_OFF = 2176, MOE_UD_MAX = 56;
__device__ __forceinline__ MoeUnit moe_unit(const LDSP int* ts, const LDSP int* ct, int o, int npn) {
    MoeUnit u; u.e = moe_find_expert(ts, o / npn);
    const int nte = ts[u.e + 1] - ts[u.e], local = o - npn * ts[u.e];
    u.pn = local / nte; const int j = local - u.pn * nte;
    const int c = ct[u.e];
    moe_tile_rows(c, j, u.row0, u.nvalid); u.arow0 = ts[260 + u.e] + u.row0;
    return u;
}
__device__ __forceinline__ int moe_build_units(const LDSP int* ts, const LDSP int* cnt, int first, int last, int step, int npn, LDSP int* ud, int tid) {
    const int n = first < last ? (last - first + step - 1) / step : 0;
    if (tid < n && tid < MOE_UD_MAX) { const MoeUnit mu = moe_unit(ts, cnt, first + tid * step, npn); LDSP int* d = ud + tid * 5; d[0] = mu.e; d[1] = mu.pn; d[2] = mu.row0; d[3] = mu.nvalid > 0 ? mu.nvalid : 0; d[4] = mu.arow0; }
    __syncthreads();
    return n < MOE_UD_MAX ? n : MOE_UD_MAX;
}
__device__ __forceinline__ void unit_range(int U, int& first, int& last, int& step) {
    const int G = gridDim.x;
    if (G & 7) { first = blockIdx.x; last = U; step = G; return; }
    const int x = blockIdx.x & 7, r = blockIdx.x >> 3;
    first = (int)(((long)x * U) >> 3) + r; last = (int)(((long)(x + 1) * U) >> 3); step = G >> 3;
}
struct FinArgs { const bf16_t* pre2b; const unsigned char* contrib8; const float* gate; const int* inv; const float* g; const float* b; float* out; };
struct FinRows { u32x2 c0[8], c1[8]; u32x4 p0, p1; };
__device__ __forceinline__ void fin_index(const FinArgs& A, const LDSP int* ab, const LDSP int* sp, int tok, int lane, int& rowk, float& gk) {
    const int l8 = lane & 7;
    const int w = A.inv[(size_t)tok * 8 + l8]; rowk = ab[w >> 16] + sp[(w >> 16) * NSEG + ((w >> 11) & (NSEG - 1))] + (w & 2047); gk = A.gate[(size_t)tok * 8 + l8] * (1.f / F8_SC);
}
__device__ __forceinline__ void fin_rows(const FinArgs& A, int rowk, int tok, int lane, FinRows& R) {
#pragma unroll
    for (int k = 0; k < 8; ++k) {
        const int row = __shfl(rowk, k);
        const unsigned char* cp = A.contrib8 + (size_t)row * 1024 + lane * 8;
        R.c0[k] = *(const u32x2*)cp; R.c1[k] = *(const u32x2*)(cp + 512);
    }
    const bf16_t* pp = A.pre2b + (size_t)tok * 1024 + lane * 8;
    R.p0 = *(const u32x4*)pp; R.p1 = *(const u32x4*)(pp + 512);
}
__device__ __forceinline__ void fin_finish(const FinArgs& A, const FinRows& R, float gk, int tok, int lane) {
    const u32x4 p0 = R.p0, p1 = R.p1;
    f32x4 v[4];
    v[0] = (f32x4){bf2f(p0.x & 0xffff), bf2f(p0.x >> 16), bf2f(p0.y & 0xffff), bf2f(p0.y >> 16)}; v[1] = (f32x4){bf2f(p0.z & 0xffff), bf2f(p0.z >> 16), bf2f(p0.w & 0xffff), bf2f(p0.w >> 16)};
    v[2] = (f32x4){bf2f(p1.x & 0xffff), bf2f(p1.x >> 16), bf2f(p1.y & 0xffff), bf2f(p1.y >> 16)}; v[3] = (f32x4){bf2f(p1.z & 0xffff), bf2f(p1.z >> 16), bf2f(p1.w & 0xffff), bf2f(p1.w >> 16)};
#pragma unroll
    for (int k = 0; k < 8; ++k) {
        const float gt = __shfl(gk, k);
        const unsigned w4[4] = {R.c0[k].x, R.c0[k].y, R.c1[k].x, R.c1[k].y};
#pragma unroll
        for (int i = 0; i < 4; ++i) {
            const f32x2_t lo = f8lo(w4[i]), hi = f8hi(w4[i]);
            v[i][0] += gt * lo[0]; v[i][1] += gt * lo[1]; v[i][2] += gt * hi[0]; v[i][3] += gt * hi[1];
        }
    }
    float s_ = 0.f;
#pragma unroll
    for (int i = 0; i < 4; ++i) s_ += (v[i][0] + v[i][1]) + (v[i][2] + v[i][3]);
    const float mu = wave_sum(s_) * (1.f / 1024.f);
    float q = 0.f;
#pragma unroll
    for (int i = 0; i < 4; ++i) { const f32x4 d = v[i] - mu; q += (d[0] * d[0] + d[1] * d[1]) + (d[2] * d[2] + d[3] * d[3]); }
    const float rstd = rsqrtf(wave_sum(q) * (1.f / 1024.f) + 1e-5f);
    const int co[4] = {lane * 8, lane * 8 + 4, 512 + lane * 8, 516 + lane * 8};
#pragma unroll
    for (int i = 0; i < 4; ++i) {
        const f32x4 gg = *(const f32x4*)(A.g + co[i]), bb = *(const f32x4*)(A.b + co[i]);
        *(f32x4*)(A.out + (size_t)tok * 1024 + co[i]) = (v[i] - mu) * rstd * gg + bb;
    }
}
__device__ __forceinline__ void final_tokens(const FinArgs& A, const LDSP int* ab, const LDSP int* sp, int t0, int S, int lane) {
    if (t0 >= NT) return;
    int tok = t0, rk0, rk1; float g0, g1;
    fin_index(A, ab, sp, tok, lane, rk0, g0);
    FinRows R0; fin_rows(A, rk0, tok, lane, R0);
    int tok1 = tok + S, tk1 = tok1 < NT ? tok1 : tok;
    fin_index(A, ab, sp, tk1, lane, rk1, g1);
#pragma unroll 1
    for (;;) {
        FinRows R1; fin_rows(A, rk1, tk1, lane, R1);
        const int tok2 = tok1 + S, tk2 = tok2 < NT ? tok2 : tk1;
        int rk2; float g2; fin_index(A, ab, sp, tk2, lane, rk2, g2);
        fin_finish(A, R0, g0, tok, lane);
        if (tok1 >= NT) break;
        R0 = R1; g0 = g1; tok = tok1; tok1 = tok2; tk1 = tk2; rk1 = rk2; g1 = g2;
    }
}
__device__ __forceinline__ void route_tokens8(const float* logits, const float* rbias, float* gate, int tok0, int lane, int& e_out) {
    const float4 rb = *(const float4*)(rbias + lane * 4);
    float4 lgs[8];
#pragma unroll
    for (int t = 0; t < 8; ++t) lgs[t] = *(const float4*)(logits + (size_t)(tok0 + t) * NE + lane * 4);
    int e_all = 0; float g_all = 0.f;
#pragma unroll
    for (int t = 0; t < 8; ++t) {
        const float4 lg = lgs[t];
        float sc[4], ch[4];
        sc[0] = 1.f / (1.f + expf(-lg.x)); sc[1] = 1.f / (1.f + expf(-lg.y)); sc[2] = 1.f / (1.f + expf(-lg.z)); sc[3] = 1.f / (1.f + expf(-lg.w));
        ch[0] = sc[0] + rb.x; ch[1] = sc[1] + rb.y; ch[2] = sc[2] + rb.z; ch[3] = sc[3] + rb.w;
        float t1 = -INFINITY, t2 = -INFINITY;
#pragma unroll
        for (int i = 0; i < 4; ++i) { const float v = ch[i]; if (v > t1) { t2 = t1; t1 = v; } else if (v > t2) t2 = v; }
#pragma unroll
        for (int s_ = 1; s_ <= 4; s_ <<= 1) {
            const float o1 = __shfl_xor(t1, s_), o2 = __shfl_xor(t2, s_);
            const float n1 = fmaxf(t1, o1);
            const float n2 = fmaxf(fminf(t1, o1), fmaxf(t2, o2));
            t1 = n1; t2 = n2;
        }
        const float gs = t1 + t2;
        const int mygrp = lane >> 3;
        int rank = 0;
#pragma unroll
        for (int g2 = 0; g2 < 8; ++g2) { const float og = __shfl(gs, g2 * 8); if (og > gs || (og == gs && g2 < mygrp)) ++rank; }
        const bool gsel = rank < 4;
#pragma unroll
        for (int i = 0; i < 4; ++i) if (!gsel) ch[i] = -INFINITY;
        float gsum = 0.f; float myg = 0.f; int mye = -1;
#pragma unroll 1
        for (int k = 0; k < TOPK; ++k) {
            float bv = ch[0]; int bi = 0;
#pragma unroll
            for (int i = 1; i < 4; ++i) if (ch[i] > bv) { bv = ch[i]; bi = i; }
            int be = lane * 4 + bi;
#pragma unroll
            for (int s_ = 32; s_ >= 1; s_ >>= 1) {
                const float ov = __shfl_xor(bv, s_); const int oe = __shfl_xor(be, s_);
                if (ov > bv || (ov == bv && oe < be)) { bv = ov; be = oe; }
            }
            const int ol = be >> 2, oi = be & 3;
            float sv = 0.f;
            if (lane == ol) {
#pragma unroll
                for (int i = 0; i < 4; ++i) if (i == oi) { sv = sc[i]; ch[i] = -INFINITY; }
            }
            sv = __shfl(sv, ol);
            gsum += sv;
            if (lane == k) { myg = sv; mye = be; }
        }
        const float gv = 2.5f * myg / (gsum + 1e-20f);
        const int eo = __shfl(mye, lane & 7); const float go = __shfl(gv, lane & 7);
        if ((lane >> 3) == t) { e_all = eo; g_all = go; }
    }
    gate[(size_t)tok0 * TOPK + lane] = g_all;
    e_out = e_all;
}


struct Params {
    const float* x; const float* w_in; const float* att_norm_g; const float* lam_re; const float* lam_im; const float* log_step;
    const float* b_re; const float* b_im; const float* c_re; const float* c_im; const float* d_skip; const float* w_glu; const float* b_glu;
    const float* ssm_norm_g; const float* w_out; const float* ln1_g; const float* ln1_b; const float* router_w; const float* router_bias;
    const float* w_gu; const float* w_down; const float* shared_w_gu; const float* shared_w_down; const float* ln2_g; const float* ln2_b;
    float* out;
    unsigned* bar; int* cntp; int* list; int* ctab;
    bf16_t* xb; bf16_t* w_inT; float* rope; bf16_t* q; bf16_t* k; bf16_t* v; bf16_t* u;
    bf16_t* opart; float* lse; bf16_t* wendT; bf16_t* wcarT; bf16_t* klagT; float* a16; bf16_t* w_gluT; bf16_t* yss; void* rsv0; void* rsv1;
    bf16_t* w_outT; bf16_t* rsT; bf16_t* sdT; unsigned char* h1q; bf16_t* h1b; float* logits; void* rsv2; bf16_t* pre2b; float* gate; int* inv;
    unsigned char* w_gu8; unsigned char* w_dn8; unsigned char* act8; unsigned char* contrib8;
    int ph_lo, ph_hi;
};
constexpr int LDS_TS = ME_LDS;
constexpr int LDS_XB = ME_LDS + 4096 + 8192;
constexpr int LDS_TOTAL = ME_LDS + 4096 + 8192 + 64;
static_assert(pg::VA_SLOT_OFF == ME_LDS + 4096 && LDS_TOTAL <= 163840, "LDS map");
constexpr int N_PHASES = 12;

template <class RM>
__device__ __forceinline__ void transpose_range(const float* W, int K, int N, unsigned char* Wt, int t0, int t1, LDSP unsigned char* lds) {
    const int tid = threadIdx.x, lane = tid & 63, wid = __builtin_amdgcn_readfirstlane(tid >> 6);
    LDSP float* scr = (LDSP float*)(lds + wid * 17408);
    const int tk = K >> 6; const RM rm = RM();
    const int lr = lane >> 4, lc = (lane & 15) * 4;
    const int rc = lane & 3, rn = lane >> 2;
#define TR_LOAD(V, t_) do { const int k0_ = ((t_) % tk) * 64, n0_ = ((t_) / tk) * 64; const float* sp_ = W + (size_t)(k0_ + lr) * N + n0_ + lc; \
        _Pragma("unroll") for (int i = 0; i < 16; ++i) V[i] = __builtin_nontemporal_load((const f32x4*)(sp_ + (size_t)(4 * i) * N)); } while (0)
#define TR_PROC(V, t_) do { const int k0_ = ((t_) % tk) * 64, n0_ = ((t_) / tk) * 64; \
        _Pragma("unroll") for (int i = 0; i < 16; ++i) { const int k = 4 * i + lr; *(LDSP f32x4*)(scr + k * 68 + (lc ^ (4 * ((k >> 3) & 7)))) = V[i]; } \
        _Pragma("unroll") for (int j = 0; j < 4; ++j) { \
            const int n = rn + 16 * j; \
            const LDSP float* pa = scr + (16 * rc) * 68 + (n ^ (8 * rc)), * pb = scr + (16 * rc + 8) * 68 + (n ^ (8 * rc + 4)); \
            u32x4 w; \
            w.x = pk4f8(pa[0] * F8_SW, pa[68] * F8_SW, pa[2 * 68] * F8_SW, pa[3 * 68] * F8_SW); w.y = pk4f8(pa[4 * 68] * F8_SW, pa[5 * 68] * F8_SW, pa[6 * 68] * F8_SW, pa[7 * 68] * F8_SW); \
            w.z = pk4f8(pb[0] * F8_SW, pb[68] * F8_SW, pb[2 * 68] * F8_SW, pb[3 * 68] * F8_SW); w.w = pk4f8(pb[4 * 68] * F8_SW, pb[5 * 68] * F8_SW, pb[6 * 68] * F8_SW, pb[7 * 68] * F8_SW); \
            __builtin_nontemporal_store(w, (u32x4*)(Wt + (size_t)rm(n0_ + n) * K + k0_ + 16 * rc)); } } while (0)
    int t = t0 + wid;
    if (t >= t1) return;
    f32x4 va[16], vb[16];
    TR_LOAD(va, t);
#pragma unroll 1
    for (; t < t1; t += 16) {
        const int t2 = t + 8, t3 = t + 16;
        { const int tl = t2 < t1 ? t2 : t; TR_LOAD(vb, tl); }
        TR_PROC(va, t);
        if (t2 < t1) {
            { const int tl = t3 < t1 ? t3 : t2; TR_LOAD(va, tl); }
            TR_PROC(vb, t2);
        }
    }
#undef TR_LOAD
#undef TR_PROC
}
__device__ __forceinline__ void convert_experts(const Params& p, LDSP unsigned char* lds, int t0, int t1) {
    __syncthreads();
    for (int e = blockIdx.x; e < NE; e += gridDim.x) {
        if (t0 < 128) transpose_range<RowGU>(p.w_gu + (size_t)e * 1024 * 512, 1024, 512, p.w_gu8 + (size_t)e * 512 * 1024, t0, t1 < 128 ? t1 : 128, lds);
        if (t1 > 128) transpose_range<RowId>(p.w_down + (size_t)e * 256 * 1024, 256, 1024, p.w_dn8 + (size_t)e * 1024 * 256, (t0 > 128 ? t0 : 128) - 128, t1 - 128, lds);
    }
    __syncthreads();
}
__device__ __forceinline__ bool convert_first() { return ((blockIdx.x >> 3) & 1) == 0; }
template <class RM, bool FT>
__device__ __forceinline__ void transpose_tile_w(const float* W, int K, int N, bf16_t* Wt, int t, LDSP float* scr, int lane) {
    const int tn = N >> 6; const RM rm = RM();
    const int lr = lane >> 4, lc = (lane & 15) * 4;
    const int rc = lane & 7, rn = lane >> 3;
    const int k0 = (t / tn) * 64, n0 = (t % tn) * 64;
    const float* sp = W + (size_t)(k0 + lr) * N + n0 + lc;
    f32x4 v[16];
#pragma unroll
    for (int i = 0; i < 16; ++i) v[i] = *(const f32x4*)(sp + (size_t)(4 * i) * N);
#pragma unroll
    for (int i = 0; i < 16; ++i) { const int k = 4 * i + lr; *(LDSP f32x4*)(scr + k * 68 + (lc ^ (4 * ((k >> 3) & 7)))) = v[i]; }
#pragma unroll
    for (int j = 0; j < 8; ++j) {
        const int n = rn + 8 * j;
        const LDSP float* q = scr + (8 * rc) * 68 + (n ^ (4 * rc));
        u32x4 w;
        w.x = pk2(q[0], q[68]); w.y = pk2(q[2 * 68], q[3 * 68]); w.z = pk2(q[4 * 68], q[5 * 68]); w.w = pk2(q[6 * 68], q[7 * 68]);
        const int nn = rm(n0 + n);
        *(u32x4*)(Wt + (FT ? ft_off(nn, k0 + 8 * rc, K) : (size_t)nn * K + k0 + 8 * rc)) = w;
    }
}
__device__ __forceinline__ void phase_prologue(const Params& p, LDSP unsigned char* lds) {
    const int tid = threadIdx.x;
    {
        const int lane = tid & 63, wid = __builtin_amdgcn_readfirstlane(tid >> 6);
        LDSP float* scr = (LDSP float*)(lds + wid * 17408);
        for (int g = blockIdx.x * 8 + wid; g < 1088; g += gridDim.x * 8) {
            if (g < 512) transpose_tile_w<RowId, false>(p.w_in, 1024, 2048, p.w_inT, g, scr, lane);
            else if (g < 768) transpose_tile_w<RowId, true>(p.w_out, 1024, 1024, p.w_outT, g - 512, scr, lane);
            else if (g < 896) transpose_tile_w<RowGU64, true>(p.shared_w_gu, 1024, 512, p.rsT + (size_t)256 * 1024, g - 768, scr, lane);
            else if (g < 960) transpose_tile_w<RowId, true>(p.w_glu, 512, 512, p.w_gluT, g - 896, scr, lane);
            else if (g < 1024) transpose_tile_w<RowId, true>(p.router_w, 1024, 256, p.rsT, g - 960, scr, lane);
            else transpose_tile_w<RowId, true>(p.shared_w_down, 256, 1024, p.sdT, g - 1024, scr, lane);
        }
    }
    for (size_t i = ((size_t)blockIdx.x * 512 + tid) * 8; i < (size_t)NT * D_; i += (size_t)gridDim.x * 512 * 8) {
        const float4 v0 = *(const float4*)(p.x + i), v1 = *(const float4*)(p.x + i + 4);
        u32x4 w; w.x = pk2(v0.x, v0.y); w.y = pk2(v0.z, v0.w); w.z = pk2(v1.x, v1.y); w.w = pk2(v1.z, v1.w);
        *(u32x4*)(p.xb + i) = w;
    }
    for (int i = blockIdx.x * 512 + tid; i < 2048 * 8; i += gridDim.x * 512) {
        const int pos = i >> 3, f = i & 7;
        const float inv = powf(500000.0f, -(float)f / 8.0f);
        const float ang = (float)pos * inv;
        p.rope[2 * i] = cosf(ang); p.rope[2 * i + 1] = sinf(ang);
    }
    for (int i = blockIdx.x * 512 + tid; i < NSEG * NE; i += gridDim.x * 512) p.cntp[(size_t)i * CNT_STRIDE] = 0;
    SsmTabArgs sa{p.lam_re, p.lam_im, p.log_step, p.b_re, p.b_im, p.c_re, p.c_im, p.wendT, p.wcarT, p.klagT, p.a16};
    for (int it = blockIdx.x * 512 + tid; it < SSM_TAB_ITEMS; it += gridDim.x * 512) ssm_tab_item(sa, it);
    __syncthreads();
    for (int it = blockIdx.x; it < 512; it += gridDim.x) ssm_klag_item(sa, it, (LDSP float*)lds, tid);
    __syncthreads();
}
__device__ __forceinline__ void phase_proj(const Params& a, LDSP unsigned char* lds) {
    const bool cvf_ = convert_first();
    if (cvf_) convert_experts(a, lds, 0, 48);
    pg::gemm_phase<false, true, false, false>(lds, 1024, pg::sched([&](int i, pg::Unit& u) {
        int pm, pn; if (!pg::static_tile(i, 64, 8, pm, pn)) return false;
        u.A = (const char*)(a.xb + (size_t)pm * 256 * 1024); u.B = (const char*)(a.w_inT + (size_t)pn * 256 * 1024); u.x0 = pm; u.x1 = pn; u.x2 = 0; u.x3 = 0; return true;
    }, [](const pg::Unit&) { return pg::dense_va(2048); }), pg::epi_row8([&](const pg::Unit& u, int r, int c, f32x4 v0, f32x4 v1) {
        const int m = u.x0 * 256 + r, sec = u.x1 >> 1, cs = (u.x1 & 1) * 256 + c;
        const int b = m >> 11, t = m & 2047, sh = sec < 3 ? 6 : 4;
        bf16_t* dstb = sec == 0 ? a.q : (sec == 1 ? a.k : (sec == 2 ? a.v : a.u));
        if (sec == 0) { v0 = v0 * QSCALE; v1 = v1 * QSCALE; }
        if (sec < 2 && (c & 32) == 0) {
            f32x4 o0, o1;
#pragma unroll
            for (int j = 0; j < 4; ++j) { o0[j] = __shfl_xor(v0[j], 16); o1[j] = __shfl_xor(v1[j], 16); }
            if ((c & 16) == 0) {
                const float* rt = a.rope + (size_t)t * 16;
                const f32x4 c0 = *(const f32x4*)rt, c1 = *(const f32x4*)(rt + 4), c2 = *(const f32x4*)(rt + 8), c3 = *(const f32x4*)(rt + 12);
                const f32x4 cs0 = {c0[0], c0[2], c1[0], c1[2]}, cs1 = {c2[0], c2[2], c3[0], c3[2]}, sn0 = {c0[1], c0[3], c1[1], c1[3]}, sn1 = {c2[1], c2[3], c3[1], c3[3]};
                if ((c & 8) == 0) { v0 = v0 * cs0 - o0 * sn0; v1 = v1 * cs1 - o1 * sn1; }
                else { v0 = v0 * cs0 + o0 * sn0; v1 = v1 * cs1 + o1 * sn1; }
            }
        }
        const int grp = cs >> sh, within = cs & ((1 << sh) - 1);
        *(u32x4*)(dstb + ((((size_t)((b << (9 - sh)) + grp) << 11) + t) << sh) + within) = pg::pack8(v0, v1);
    }));
    if (!cvf_) convert_experts(a, lds, 0, 48);
}
__device__ __forceinline__ void phase_mixers(const Params& p, LDSP unsigned char* lds) {
    const bool cvf_ = convert_first();
    if (cvf_) convert_experts(p, lds, 48, 128);
    SsmArgs sa{p.u, p.wendT, p.wcarT, p.klagT, p.a16, p.d_skip, p.yss};
    for (int bg = blockIdx.x; bg < 256; bg += gridDim.x) ssm_unit(sa, bg, lds);
    __syncthreads();
    AttArgs aa{p.q, p.k, p.v, p.opart, p.lse};
    {
        const int tid = threadIdx.x;
        int U = blockIdx.x;
        AwPre P;
        if (U < AW_UNITS) aw_prefetch(aa, U, P, tid);
        while (U < AW_UNITS) {
            __syncthreads();
            aw_stage(P, lds, tid);
            bf16x8 qf[4];
#pragma unroll
            for (int s_ = 0; s_ < 4; ++s_) qf[s_] = P.q[s_];
            __syncthreads();
            const int Un = U + gridDim.x;
            aw_prefetch(aa, Un < AW_UNITS ? Un : U, P, tid);
            aw_compute(aa, U, qf, lds, tid);
            U = Un;
        }
        __syncthreads();
    }
    if (!cvf_) convert_experts(p, lds, 48, 128);
}
template <int NF, int NW = NF, int OFF = 0>
__device__ __forceinline__ void rb_gemm(f32x4 (&acc)[4][NW], const LDSP unsigned char* Alds, int apitch, const bf16_t* Bt, int K, int lane) {
    const int fr = lane & 15, fq = lane >> 4;
    const int nks = K >> 5;
    const char* bb = (const char*)Bt;
    unsigned bo = lane * 16;
    const unsigned nstride = (unsigned)nks * 1024u;
    const LDSP unsigned char* ap = Alds + fr * apitch + fq * 16;
#pragma unroll
    for (int m = 0; m < 4; ++m)
#pragma unroll
        for (int ni = 0; ni < NF; ++ni) acc[m][OFF + ni] = (f32x4){0.f, 0.f, 0.f, 0.f};
    bf16x8 b0[NF], b1[NF], b2[NF], b3[NF];
#define RB_LOADB(B_, step_) do { _Pragma("unroll") for (int ni = 0; ni < NF; ++ni) B_[ni] = *(const bf16x8*)(bb + (bo + (unsigned)(step_) * 1024u + ni * ns)); } while (0)
#define RB_MMA(B_, step_) do { bf16x8 af_[4]; _Pragma("unroll") for (int m = 0; m < 4; ++m) af_[m] = *(const LDSP bf16x8*)(ap + m * 16 * apitch + (step_) * 64); \
        _Pragma("unroll") for (int m = 0; m < 4; ++m) _Pragma("unroll") for (int ni = 0; ni < NF; ++ni) acc[m][OFF + ni] = __builtin_amdgcn_mfma_f32_16x16x32_bf16(B_[ni], af_[m], acc[m][OFF + ni], 0, 0, 0); } while (0)
    { unsigned ns = nstride; asm volatile("" : "+s"(ns), "+v"(bo)); RB_LOADB(b0, 0); RB_LOADB(b1, 1); RB_LOADB(b2, 2); }
#pragma unroll 1
    for (int ks = 0; ks < nks; ks += 4) {
        unsigned ns = nstride; asm volatile("" : "+s"(ns));
        RB_LOADB(b3, 3);
        RB_MMA(b0, 0);
        if (ks + 4 < nks) RB_LOADB(b0, 4);
        RB_MMA(b1, 1);
        if (ks + 4 < nks) RB_LOADB(b1, 5);
        RB_MMA(b2, 2);
        if (ks + 4 < nks) RB_LOADB(b2, 6);
        RB_MMA(b3, 3);
        bo += 4096u; ap += 256;
    }
#undef RB_LOADB
#undef RB_MMA
}
__device__ __forceinline__ void rb_stage_rows(LDSP unsigned char* dst, int lpitch, const bf16_t* src, size_t gpitch, int ncols) {
    const int cpr = ncols >> 3;
    int tid0 = threadIdx.x; asm volatile("" : "+v"(tid0));
    for (int id = tid0; id < 64 * cpr; id += 512) { const int r = id / cpr, c = id - r * cpr; *(LDSP u32x4*)(dst + r * lpitch + c * 16) = __builtin_nontemporal_load((const u32x4*)(src + (size_t)r * gpitch + c * 8)); }
}
constexpr int RB_HIST_OFF = 139264;
constexpr int RB_STAT_OFF = 64 * 2064;
__device__ __forceinline__ void phase_wout_ln(const Params& a, LDSP unsigned char* lds) {
    const bool cvf_ = convert_first();
    if (cvf_) convert_experts(a, lds, 128, 192);
    int lane = threadIdx.x & 63; const int w = __builtin_amdgcn_readfirstlane(threadIdx.x >> 6); int fr = lane & 15, fq = lane >> 4;
#define RB_FRESH() do { __builtin_amdgcn_sched_barrier(0); asm volatile("" : "+s"(m0), "+v"(fr), "+v"(fq), "+v"(lane)); } while (0)
    for (int tile = blockIdx.x; tile < NT / 64; tile += gridDim.x) {
        int m0 = tile * 64;
        asm volatile("" : "+s"(m0));
        __syncthreads();
#pragma unroll 1
        for (int tb = 0; tb < 8; tb += 4) {
            int ln = lane; asm volatile("" : "+v"(ln));
            const int h = ln >> 3;
            float ls[4][3]; u32x4 pv[4][3];
#pragma unroll
            for (int t = 0; t < 4; ++t) {
                const int tok = m0 + 8 * w + tb + t;
#pragma unroll
                for (int c = 0; c < 3; ++c) { ls[t][c] = a.lse[((size_t)c * NT + tok) * 8 + h]; pv[t][c] = __builtin_nontemporal_load((const u32x4*)(a.opart + ((size_t)c * NT + tok) * 512 + ln * 8)); }
            }
            const f32x4 ga0 = *(const f32x4*)(a.att_norm_g + ln * 8), ga1 = *(const f32x4*)(a.att_norm_g + ln * 8 + 4);
#pragma unroll
            for (int t = 0; t < 4; ++t) {
                const int row = 8 * w + tb + t;
                const float mx = fmaxf(ls[t][0], fmaxf(ls[t][1], ls[t][2]));
                float wg[3], ws = 0.f;
#pragma unroll
                for (int c = 0; c < 3; ++c) { wg[c] = exp2f(ls[t][c] - mx); ws += wg[c]; }
                const float iw = 1.f / ws;
                float o[8];
#pragma unroll
                for (int i = 0; i < 8; ++i) o[i] = 0.f;
#pragma unroll
                for (int c = 0; c < 3; ++c) {
                    const u32x4 v = pv[t][c]; const float wc = wg[c] * iw;
                    o[0] += wc * bf2f(v.x & 0xffff); o[1] += wc * bf2f(v.x >> 16); o[2] += wc * bf2f(v.y & 0xffff); o[3] += wc * bf2f(v.y >> 16);
                    o[4] += wc * bf2f(v.z & 0xffff); o[5] += wc * bf2f(v.z >> 16); o[6] += wc * bf2f(v.w & 0xffff); o[7] += wc * bf2f(v.w >> 16);
                }
                float sa = 0.f;
#pragma unroll
                for (int i = 0; i < 8; ++i) sa += o[i] * o[i];
                sa = wave_sum(sa);
                const float ra = rsqrtf(sa * (1.f / 512.f) + 1e-6f);
                u32x4 wa;
                wa.x = pk2(o[0] * ra * ga0[0], o[1] * ra * ga0[1]); wa.y = pk2(o[2] * ra * ga0[2], o[3] * ra * ga0[3]);
                wa.z = pk2(o[4] * ra * ga1[0], o[5] * ra * ga1[1]); wa.w = pk2(o[6] * ra * ga1[2], o[7] * ra * ga1[3]);
                *(LDSP u32x4*)(lds + row * 2064 + ln * 16) = wa;
            }
        }
        rb_stage_rows(lds + 1024, 2064, a.yss + (size_t)m0 * 512, 512, 512);
        __syncthreads();
        {
            f32x4 ga[4][4];
            rb_gemm<4>(ga, lds + 1024, 2064, a.w_gluT + (size_t)(64 * w) * 512, 512, lane);
            LDSP float* st = (LDSP float*)(lds + RB_STAT_OFF);
            RB_FRESH();
#pragma unroll
            for (int m = 0; m < 4; ++m) {
                float s2 = 0.f;
#pragma unroll
                for (int ni = 0; ni < 4; ++ni) {
                    const int col = 64 * w + 16 * ni + 4 * fq;
                    const u32x2 yw = *(const LDSP u32x2*)(lds + (16 * m + fr) * 2064 + 1024 + col * 2);
                    const f32x4 bb = *(const f32x4*)(a.b_glu + col);
                    f32x4 v = ga[m][ni];
                    v[0] = bf2f(yw.x & 0xffff) / (1.f + __expf(-(v[0] + bb[0]))); v[1] = bf2f(yw.x >> 16) / (1.f + __expf(-(v[1] + bb[1])));
                    v[2] = bf2f(yw.y & 0xffff) / (1.f + __expf(-(v[2] + bb[2]))); v[3] = bf2f(yw.y >> 16) / (1.f + __expf(-(v[3] + bb[3])));
                    ga[m][ni] = v; s2 += (v[0] * v[0] + v[1] * v[1]) + (v[2] * v[2] + v[3] * v[3]);
                }
                s2 += __shfl_xor(s2, 16); s2 += __shfl_xor(s2, 32);
                if (fq == 0) st[w * 64 + 16 * m + fr] = s2;
            }
            __syncthreads();
            RB_FRESH();
#pragma unroll
            for (int m = 0; m < 4; ++m) {
                float s2 = 0.f;
#pragma unroll
                for (int v = 0; v < 8; ++v) s2 += st[v * 64 + 16 * m + fr];
                const float rs = rsqrtf(s2 * (1.f / 512.f) + 1e-6f);
#pragma unroll
                for (int ni = 0; ni < 4; ++ni) {
                    const int col = 64 * w + 16 * ni + 4 * fq;
                    const f32x4 gs = *(const f32x4*)(a.ssm_norm_g + col);
                    const f32x4 v = ga[m][ni] * rs * gs;
                    u32x2 o2; o2.x = pk2(v[0], v[1]); o2.y = pk2(v[2], v[3]);
                    *(LDSP u32x2*)(lds + (16 * m + fr) * 2064 + 1024 + col * 2) = o2;
                }
            }
        }
        __syncthreads();
        f32x4 acc[4][8];
        const int n0 = 128 * w;
        rb_gemm<4, 8, 0>(acc, lds, 2064, a.w_outT + (size_t)n0 * 1024, 1024, lane);
        rb_gemm<4, 8, 4>(acc, lds, 2064, a.w_outT + (size_t)(n0 + 64) * 1024, 1024, lane);
        RB_FRESH();
        LDSP float* st = (LDSP float*)(lds + RB_STAT_OFF);
#pragma unroll
        for (int m = 0; m < 4; ++m) {
            const float* xr = a.x + (size_t)(m0 + 16 * m + fr) * 1024 + n0 + 4 * fq;
            float s1 = 0.f, s2 = 0.f;
#pragma unroll
            for (int ni = 0; ni < 8; ++ni) {
                const f32x4 xv = __builtin_nontemporal_load((const f32x4*)(xr + 16 * ni));
                const f32x4 v = xv * ALPHA + acc[m][ni]; acc[m][ni] = v;
                s1 += (v[0] + v[1]) + (v[2] + v[3]); s2 += (v[0] * v[0] + v[1] * v[1]) + (v[2] * v[2] + v[3] * v[3]);
            }
            s1 += __shfl_xor(s1, 16); s1 += __shfl_xor(s1, 32); s2 += __shfl_xor(s2, 16); s2 += __shfl_xor(s2, 32);
            if (fq == 0) { st[(w * 64 + 16 * m + fr) * 2] = s1; st[(w * 64 + 16 * m + fr) * 2 + 1] = s2; }
        }
        __syncthreads();
        RB_FRESH();
#pragma unroll
        for (int m = 0; m < 4; ++m) {
            float s1 = 0.f, s2 = 0.f;
#pragma unroll
            for (int v = 0; v < 8; ++v) { s1 += st[(v * 64 + 16 * m + fr) * 2]; s2 += st[(v * 64 + 16 * m + fr) * 2 + 1]; }
            const float mu = s1 * (1.f / 1024.f), var = s2 * (1.f / 1024.f) - mu * mu, rstd = rsqrtf(var + 1e-5f);
            LDSP unsigned char* hl = lds + (16 * m + fr) * 2064 + (n0 + 4 * fq) * 2;
#pragma unroll
            for (int ni = 0; ni < 8; ++ni) {
                const f32x4 gg = *(const f32x4*)(a.ln1_g + n0 + 16 * ni + 4 * fq), bb = *(const f32x4*)(a.ln1_b + n0 + 16 * ni + 4 * fq);
                const f32x4 y = (acc[m][ni] - mu) * rstd * gg + bb;
                u32x2 o; o.x = pk2(y[0], y[1]); o.y = pk2(y[2], y[3]);
                *(LDSP u32x2*)(hl + 32 * ni) = o;
            }
        }
        __syncthreads();
        {
            int tid0 = threadIdx.x; asm volatile("" : "+v"(tid0));
#pragma unroll 1
            for (int id = tid0; id < 64 * 128; id += 512) {
                const int r = id >> 7, c = id & 127; const u32x4 hv = *(const LDSP u32x4*)(lds + r * 2064 + c * 16);
                *(u32x4*)(a.h1b + (size_t)(m0 + r) * 1024 + c * 8) = hv;
                u32x2 q8;
                q8.x = pk4f8(bf2f(hv.x & 0xffff) * F8_SH, bf2f(hv.x >> 16) * F8_SH, bf2f(hv.y & 0xffff) * F8_SH, bf2f(hv.y >> 16) * F8_SH);
                q8.y = pk4f8(bf2f(hv.z & 0xffff) * F8_SH, bf2f(hv.z >> 16) * F8_SH, bf2f(hv.w & 0xffff) * F8_SH, bf2f(hv.w >> 16) * F8_SH);
                __builtin_nontemporal_store(q8, (u32x2*)(a.h1q + (size_t)(m0 + r) * 1024 + c * 8));
            }
        }
        RB_FRESH();
        {
            f32x4 rl[4][2];
            rb_gemm<2>(rl, lds, 2064, a.rsT + (size_t)(32 * w) * 1024, 1024, lane);
#pragma unroll
            for (int m = 0; m < 4; ++m)
#pragma unroll
                for (int ni = 0; ni < 2; ++ni) *(f32x4*)(a.logits + (size_t)(m0 + 16 * m + fr) * 256 + 32 * w + 16 * ni + 4 * fq) = rl[m][ni];
        }
        RB_FRESH();
        u32x2 actv[4][2];
        {
            f32x4 gu[4][4];
            rb_gemm<4>(gu, lds, 2064, a.rsT + (size_t)(256 + 64 * w) * 1024, 1024, lane);
#pragma unroll
            for (int m = 0; m < 4; ++m)
#pragma unroll
                for (int ni = 0; ni < 2; ++ni) {
                    const f32x4 g = gu[m][ni], up = gu[m][ni + 2];
                    actv[m][ni].x = pk2(silu_f(g[0]) * up[0], silu_f(g[1]) * up[1]); actv[m][ni].y = pk2(silu_f(g[2]) * up[2], silu_f(g[3]) * up[3]);
                }
        }
        asm volatile("s_waitcnt vmcnt(0)" ::: "memory");
        if (threadIdx.x < 256) ((LDSP int*)(lds + RB_HIST_OFF))[threadIdx.x] = 0;
        __syncthreads();
#pragma unroll
        for (int m = 0; m < 4; ++m)
#pragma unroll
            for (int ni = 0; ni < 2; ++ni) *(LDSP u32x2*)(lds + (16 * m + fr) * 528 + (32 * w + 16 * ni + 4 * fq) * 2) = actv[m][ni];
        RB_FRESH();
        {
            int e_my; route_tokens8(a.logits, a.router_bias, a.gate, m0 + 8 * w, lane, e_my);
            LDSP int* hist = (LDSP int*)(lds + RB_HIST_OFF); LDSP int* hbase = hist + 256;
            const int lpos = __hip_atomic_fetch_add(hist + e_my, 1, __ATOMIC_RELAXED, __HIP_MEMORY_SCOPE_WORKGROUP);
            __syncthreads();
            const int seg = blockIdx.x & (NSEG - 1);
            if (threadIdx.x < 256) { const int c = hist[threadIdx.x]; if (c > 0) hbase[threadIdx.x] = atomicAdd(&a.cntp[(size_t)(seg * 256 + threadIdx.x) * CNT_STRIDE], c); }
            __syncthreads();
            const int pos = hbase[e_my] + lpos, slot = (m0 + 8 * w) * TOPK + lane;
            a.list[(size_t)(e_my * NSEG + seg) * SEGCAP + pos] = slot;
            a.inv[slot] = (e_my << 16) | (seg << 11) | pos;
        }
        __syncthreads();
        RB_FRESH();
        {
            rb_gemm<4, 8, 0>(acc, lds, 528, a.sdT + (size_t)n0 * 256, 256, lane);
            rb_gemm<4, 8, 4>(acc, lds, 528, a.sdT + (size_t)(n0 + 64) * 256, 256, lane);
            __syncthreads();
            RB_FRESH();
#pragma unroll
            for (int m = 0; m < 4; ++m) {
                const size_t ro = (size_t)(m0 + 16 * m + fr) * 1024 + n0 + 4 * fq;
                LDSP unsigned char* pl = lds + (16 * m + fr) * 2064 + (n0 + 4 * fq) * 2;
#pragma unroll
                for (int ni = 0; ni < 8; ++ni) {
                    const u32x2 hw = *(const u32x2*)(a.h1b + ro + 16 * ni);
                    f32x4 hv; hv[0] = bf2f(hw.x & 0xffff); hv[1] = bf2f(hw.x >> 16); hv[2] = bf2f(hw.y & 0xffff); hv[3] = bf2f(hw.y >> 16);
                    const f32x4 y = hv * ALPHA + acc[m][ni];
                    u32x2 o; o.x = pk2(y[0], y[1]); o.y = pk2(y[2], y[3]);
                    *(LDSP u32x2*)(pl + 32 * ni) = o;
                }
            }
            __syncthreads();
            {
                int tid0 = threadIdx.x; asm volatile("" : "+v"(tid0));
#pragma unroll 1
                for (int id = tid0; id < 64 * 128; id += 512) { const int r = id >> 7, c = id & 127; __builtin_nontemporal_store(*(const LDSP u32x4*)(lds + r * 2064 + c * 16), (u32x4*)(a.pre2b + (size_t)(m0 + r) * 1024 + c * 8)); }
            }
        }
    }
    if (!cvf_) convert_experts(a, lds, 128, 192);
#undef RB_FRESH
}
template <bool RAGGED, class RowPtr>
__device__ __forceinline__ void swiglu_epi_pg(const f32x4 (&acc)[2][2][4][2], int wr, int wc, int fr, int fq, int nvalid, const RowPtr& rowp) {
    constexpr float us = 1.f / (F8_SH * F8_SW);
    asm volatile("" : "+v"(fr));
#pragma unroll
    for (int ai = 0; ai < 2; ++ai)
#pragma unroll
        for (int m = 0; m < 4; ++m) {
            const int r = RAGGED ? 16 * (2 * (4 * ai + m) + wr) + fr : 128 * ai + 64 * wr + 16 * m + fr;
            if (r < nvalid) {
                f32x4 o0, o1;
#pragma unroll
                for (int j = 0; j < 4; ++j) { o0[j] = silu_f(acc[ai][0][m][0][j] * us) * (acc[ai][1][m][0][j] * (us * F8_SA)); o1[j] = silu_f(acc[ai][0][m][1][j] * us) * (acc[ai][1][m][1][j] * (us * F8_SA)); }
                u32x2 w; w.x = pk4f8(o0[0], o0[1], o0[2], o0[3]); w.y = pk4f8(o1[0], o1[1], o1[2], o1[3]);
                *(u32x2*)(rowp(r) + 32 * wc + 8 * fq) = w;
            }
        }
}
__device__ __forceinline__ void phase_moe_up(const Params& a, LDSP unsigned char* lds) {
    LDSP int* ts = (LDSP int*)(lds + LDS_TS); LDSP int* ud = (LDSP int*)(lds + LDS_TS + MOE_UD_OFF);
    moe_tile_table<false>(a.cntp, a.ctab, lds, ts, threadIdx.x);
    int first, last, step; unit_range(2 * ts[256], first, last, step);
    const int nun = moe_build_units(ts, (const LDSP int*)(lds + LDS_CT), first, last, step, 2, ud, threadIdx.x);
    pg::gemm_phase<true, true, true, true>(lds, 512  , pg::sched([&](int i, pg::Unit& u) {
        if (i >= nun) return false;
        const LDSP int* d = ud + i * 5; const int e = d[0], pn = d[1];
        u.A = (const char*)a.h1q; u.B = (const char*)(a.w_gu8 + ((size_t)e * 512 + pn * 256) * 1024);
        u.x0 = pn; u.x1 = d[3]; u.x2 = d[4]; u.x3 = (e << 16) | d[2]; return true;
    }, [&](const pg::Unit& u) {
        const pg::LaneRC l = pg::lane_rc_fresh(); const int e = u.x3 >> 16, row0 = u.x3 & 0xffff, nvalid = u.x1; pg::VA v;
        const int r00 = pg::ragged_row(0, l.R0), r01 = pg::ragged_row(0, l.R1), r10 = pg::ragged_row(1, l.R0), r11 = pg::ragged_row(1, l.R1);
        const LDSP int* spe = (const LDSP int*)(lds + LDS_SP) + e * NSEG;
        const i32x4_t sa = *(const LDSP i32x4_t*)spe, sb = *(const LDSP i32x4_t*)(spe + 4);
        const int* lste = a.list + (size_t)e * NSEG * SEGCAP;
        auto tok_of = [&](int r) -> unsigned {
            if (r >= nvalid) return 0u;
            const int rr = row0 + r;
            int sg = 0, base = 0;
            if (rr >= sa[1]) { sg = 1; base = sa[1]; } if (rr >= sa[2]) { sg = 2; base = sa[2]; } if (rr >= sa[3]) { sg = 3; base = sa[3]; }
            if (rr >= sb[0]) { sg = 4; base = sb[0]; } if (rr >= sb[1]) { sg = 5; base = sb[1]; } if (rr >= sb[2]) { sg = 6; base = sb[2]; } if (rr >= sb[3]) { sg = 7; base = sb[3]; }
            return (unsigned)(lste[sg * SEGCAP + (rr - base)] >> 3);
        };
        v.v00 = tok_of(r00) * 1024u + l.C0 * 2; v.v01 = tok_of(r01) * 1024u + l.C1 * 2;
        v.v10 = tok_of(r10) * 1024u + l.C0 * 2; v.v11 = tok_of(r11) * 1024u + l.C1 * 2;
        return v;
    }), [&](const f32x4 (&acc)[2][2][4][2], const pg::Unit& u, int wr, int wc, int fr, int fq) {
        unsigned char* base = a.act8 + (size_t)u.x2 * 256 + 128 * u.x0;
        swiglu_epi_pg<true>(acc, wr, wc, fr, fq, u.x1, [&](int r) { return base + (size_t)r * 256; });
    });
}
__device__ __forceinline__ void phase_moe_down(const Params& a, LDSP unsigned char* lds) {
    LDSP int* ts = (LDSP int*)(lds + LDS_TS); LDSP int* ud = (LDSP int*)(lds + LDS_TS + MOE_UD_OFF);
    moe_tile_table<true>(a.cntp, a.ctab, lds, ts, threadIdx.x);
    int first, last, step; unit_range(4 * ts[256], first, last, step);
    const int nun = moe_build_units(ts, (const LDSP int*)(lds + LDS_CT), first, last, step, 4, ud, threadIdx.x);
    pg::gemm_phase<false, 2, true, true>(lds, 128  , pg::sched([&](int i, pg::Unit& u) {
        if (i >= nun) return false;
        const LDSP int* d = ud + i * 5; const int e = d[0], pn = d[1];
        u.A = (const char*)(a.act8 + (size_t)d[4] * 256); u.B = (const char*)(a.w_dn8 + ((size_t)e * 1024 + pn * 256) * 256);
        u.x0 = pn; u.x1 = d[3]; u.x2 = d[4]; u.x3 = 0; return true;
    }, [](const pg::Unit&) { const pg::LaneRC l = pg::lane_rc(); pg::VA v;
        v.v00 = pg::ragged_row(0, l.R0) * 256 + l.C0 * 2; v.v01 = pg::ragged_row(0, l.R1) * 256 + l.C1 * 2; v.v10 = pg::ragged_row(1, l.R0) * 256 + l.C0 * 2; v.v11 = pg::ragged_row(1, l.R1) * 256 + l.C1 * 2; return v;
    }), [&](const f32x4 (&acc)[2][2][4][2], const pg::Unit& u, int wr, int wc, int fr, int fq) {
        constexpr float cs = F8_SC / (F8_SA * F8_SW);
        asm volatile("" : "+v"(fr), "+v"(fq));
        const int nvalid = u.x1; unsigned char* base = a.contrib8 + (size_t)u.x2 * 1024 + u.x0 * 256 + 64 * wc + 16 * fq;
#pragma unroll
        for (int ai = 0; ai < 2; ++ai)
#pragma unroll
            for (int m = 0; m < 4; ++m) {
                const int r = 16 * (2 * (4 * ai + m) + wr) + fr;
                if (r < nvalid) {
                    const f32x4 c0 = acc[ai][0][m][0] * cs, c1 = acc[ai][0][m][1] * cs, c2 = acc[ai][1][m][0] * cs, c3 = acc[ai][1][m][1] * cs;
                    u32x4 w; w.x = pk4f8(c0[0], c0[1], c0[2], c0[3]); w.y = pk4f8(c1[0], c1[1], c1[2], c1[3]); w.z = pk4f8(c2[0], c2[1], c2[2], c2[3]); w.w = pk4f8(c3[0], c3[1], c3[2], c3[3]);
                    *(u32x4*)(base + (size_t)r * 1024) = w;
                }
            }
    });
}
__device__ __forceinline__ void phase_final(const Params& p, LDSP unsigned char* lds) {
    LDSP int* ts = (LDSP int*)(lds + LDS_TS);
    moe_tile_table<true>(p.cntp, p.ctab, lds, ts, threadIdx.x);
    FinArgs fa{p.pre2b, p.contrib8, p.gate, p.inv, p.ln2_g, p.ln2_b, p.out};
    const int lane = threadIdx.x & 63, wid = threadIdx.x >> 6;
    final_tokens(fa, ts + 260, (const LDSP int*)(lds + LDS_SP), blockIdx.x * 8 + wid, gridDim.x * 8, lane);
}

__global__ void __launch_bounds__(512, 2) k_mega(Params p) {
    extern __shared__ __attribute__((aligned(16))) unsigned char smem[];
    LDSP unsigned char* lds = (LDSP unsigned char*)smem;
    if (threadIdx.x == 0) *(LDSP u32x4*)(lds + LDS_XB) = (u32x4){0u, 0u, 0u, 0u};
    __syncthreads();
    XcdBarrier bar = xcd_barrier_post(p.bar, (volatile LAS unsigned*)(lds + LDS_XB));
#define PHASE(i, body) if (p.ph_lo <= (i) && (i) < p.ph_hi) { body; if ((i) + 1 < p.ph_hi) xcd_barrier(bar); }
    PHASE(0, phase_prologue(p, lds))
    PHASE(1, phase_proj(p, lds))
    PHASE(2, phase_mixers(p, lds))
    PHASE(5, phase_wout_ln(p, lds))
    PHASE(9, phase_moe_up(p, lds))
    PHASE(10, phase_moe_down(p, lds))
    PHASE(11, phase_final(p, lds))
#undef PHASE
}
}

#ifndef MK_PER_PHASE
#define MK_PER_PHASE 0
#endif
extern "C" void kernel_launch(void* const* d_in, const int* in_sizes, int n_in, void* d_out, int out_size, void* d_ws, size_t ws_size, hipStream_t stream) {
    static int grid = 0;
    if (!grid) {
        int dev = 0, cus = 0;
        if (hipGetDevice(&dev) != hipSuccess || hipDeviceGetAttribute(&cus, hipDeviceAttributeMultiprocessorCount, dev) != hipSuccess || cus < 1) return;
        if (hipFuncSetAttribute((const void*)k_mega, hipFuncAttributeMaxDynamicSharedMemorySize, LDS_TOTAL) != hipSuccess) return;
        grid = cus;
    }
    Params p{};
    const float** inp = (const float**)&p.x;
    for (int i = 0; i < 25; ++i) inp[i] = (const float*)d_in[i];
    p.out = (float*)d_out;
    char* ws = (char*)d_ws; size_t off = 0;
    auto take = [&](size_t bytes) { char* q = ws + off; off += (bytes + 255) & ~(size_t)255; return q; };
    p.bar = (unsigned*)take(XCD_BAR_WORDS * 4);
    const size_t ctl_bytes = off;
    p.cntp = (int*)take((size_t)NSEG * NE * CNT_STRIDE * 4);
    p.list = (int*)take((size_t)NE * NSEG * SEGCAP * 4); p.ctab = (int*)take((size_t)NE * NSEG * 4);
    p.xb = (bf16_t*)take((size_t)NT * 1024 * 2); p.w_inT = (bf16_t*)take((size_t)2048 * 1024 * 2); p.rope = (float*)take(2048 * 8 * 2 * 4);
    p.q = (bf16_t*)take((size_t)NT * 512 * 2); p.k = (bf16_t*)take((size_t)NT * 512 * 2); p.v = (bf16_t*)take((size_t)NT * 512 * 2); p.u = (bf16_t*)take((size_t)NT * 512 * 2);
    p.opart = (bf16_t*)take((size_t)3 * NT * 512 * 2); p.lse = (float*)take((size_t)3 * NT * 8 * 4);
    p.wendT = (bf16_t*)take((size_t)32 * 128 * 256 * 2); p.wcarT = (bf16_t*)take((size_t)32 * 256 * 128 * 2); p.klagT = (bf16_t*)take((size_t)32 * 16 * 256 * 2); p.a16 = (float*)take((size_t)32 * 64 * 2 * 4);
    p.w_gluT = (bf16_t*)take((size_t)512 * 512 * 2); p.yss = (bf16_t*)take((size_t)NT * 512 * 2);
    p.w_outT = (bf16_t*)take((size_t)1024 * 1024 * 2); p.rsT = (bf16_t*)take((size_t)768 * 1024 * 2); p.sdT = (bf16_t*)take((size_t)1024 * 256 * 2);
    p.h1b = (bf16_t*)take((size_t)NT * 1024 * 2); p.logits = (float*)take((size_t)NT * 256 * 4);
    p.pre2b = (bf16_t*)take((size_t)NT * 1024 * 2); p.h1q = (unsigned char*)take((size_t)NT * 1024); p.gate = (float*)take((size_t)NT * 8 * 4); p.inv = (int*)take((size_t)NT * 8 * 4);
    p.w_gu8 = (unsigned char*)take((size_t)256 * 512 * 1024); p.w_dn8 = (unsigned char*)take((size_t)256 * 1024 * 256);
    p.act8 = (unsigned char*)take((size_t)(NT * 8 + 256 * 16 + 512) * 256); p.contrib8 = (unsigned char*)take((size_t)(NT * 8 + 256 * 16 + 512) * 1024);
    if (off > ws_size) return;
    (void)hipMemsetAsync(ws, 0, ctl_bytes, stream);
#if MK_PER_PHASE
    for (int i = 0; i < N_PHASES; ++i) { p.ph_lo = i; p.ph_hi = i + 1; hipLaunchKernelGGL(k_mega, dim3(grid), dim3(512), LDS_TOTAL, stream, p); }
#else
    p.ph_lo = 0; p.ph_hi = N_PHASES;
    hipLaunchKernelGGL(k_mega, dim3(grid), dim3(512), LDS_TOTAL, stream, p);
#ifdef PROBE_PHASE
    (void)hipMemsetAsync(ws, 0, XCD_BAR_WORDS * 4, stream);
    p.ph_lo = PROBE_PHASE; p.ph_hi = PROBE_PHASE + 1;
    hipLaunchKernelGGL(k_mega, dim3(grid), dim3(512), LDS_TOTAL, stream, p);
#endif
#endif
}
```

```cpp
#include <hip/hip_runtime.h>
#include <stdint.h>

namespace {
constexpr int B_ = 8, L_ = 2048, D_ = 1024, NT = B_ * L_;
constexpr int NE = 256, TOPK = 8;
constexpr int NSEG = 8, SEGCAP = 2048, CNT_STRIDE = 64;
constexpr float ALPHA = 1.189207115002721f;

__device__ __forceinline__ float gelu_tanh(float x) {
    const float z2 = 1.5957691216057308f * (x + 0.044715f * x * x * x);
    return x * __builtin_amdgcn_rcpf(1.f + __expf(-z2));
}
__device__ __forceinline__ float wave_sum(float v) {
#define WS_STEP(ctrl, rmask) v += __builtin_bit_cast(float, __builtin_amdgcn_update_dpp(0, __builtin_bit_cast(int, v), ctrl, rmask, 0xf, false))
    WS_STEP(0x111, 0xf); WS_STEP(0x112, 0xf); WS_STEP(0x114, 0xf); WS_STEP(0x118, 0xf); WS_STEP(0x142, 0xa); WS_STEP(0x143, 0xc);
#undef WS_STEP
    return __builtin_bit_cast(float, __builtin_amdgcn_readlane(__builtin_bit_cast(int, v), 63));
}
#define XB_TMO      128
#define XB_XCNT(j)  (256  + 64 * (j))
#define XB_XSUB(j)  (1280 + 64 * (j))
#define XB_XGEN(j)  (2304 + 64 * (j))
#define XB_TOP      3328
#define XB_TOPGEN   3392
#define XCD_BAR_WORDS 3456
#define XB_SPIN_CAP (1u << 18)
#define LAS __attribute__((address_space(3)))

__device__ __forceinline__ unsigned xb_ld(unsigned* p)              { return __hip_atomic_load(p, __ATOMIC_RELAXED, __HIP_MEMORY_SCOPE_AGENT); }
__device__ __forceinline__ unsigned xb_add(unsigned* p, unsigned v) { return __hip_atomic_fetch_add(p, v, __ATOMIC_RELAXED, __HIP_MEMORY_SCOPE_AGENT); }
__device__ __forceinline__ unsigned xb_xcc_id() { return (unsigned)__builtin_amdgcn_s_getreg((3 << 11) | 20) & 0xFu; }
#define XB_SPIN(cond, bar) do { unsigned _sp = 0; while (cond) { __builtin_amdgcn_s_sleep(1); \
    if ((++_sp & 255u) == 0u) { if (xb_ld(&(bar)[XB_TMO])) break; if (_sp > XB_SPIN_CAP) { atomicAdd(&(bar)[XB_TMO], 1u); break; } } } } while (0)

struct XcdBarrier {
    unsigned* bar; unsigned x;
    volatile LAS unsigned* st;
};

__device__ __forceinline__ XcdBarrier xcd_barrier_post(unsigned* bar, volatile LAS unsigned* st) {
    XcdBarrier b; b.bar = bar; b.x = xb_xcc_id(); b.st = st;
    if (threadIdx.x == 0) (void)xb_add(&bar[XB_XCNT(b.x)], 1u);
    return b;
}
__device__ __forceinline__ void xcd_barrier_complete(unsigned* bar, unsigned x, unsigned& nloc, unsigned& nx) {
    const unsigned G = gridDim.x * gridDim.y * gridDim.z;
    unsigned sum, cnt, mine, sp = 0u;
    for (;;) {
        sum = 0u; cnt = 0u; mine = 0u;
#pragma unroll
        for (unsigned j = 0; j < 16; ++j) { const unsigned c = xb_ld(&bar[XB_XCNT(j)]); sum += c; cnt += (c > 0u) ? 1u : 0u; mine = (j == x) ? c : mine; }
        if (sum == G) break;
        __builtin_amdgcn_s_sleep(1);
        if ((++sp & 255u) == 0u) { if (xb_ld(&bar[XB_TMO])) break; if (sp > XB_SPIN_CAP) { atomicAdd(&bar[XB_TMO], 1u); break; } }
    }
    nloc = mine > 0u ? mine : 1u; nx = cnt > 0u ? cnt : 1u;
}

__device__ __forceinline__ void xcd_barrier(const XcdBarrier& b) {
    asm volatile("s_waitcnt vmcnt(0)" ::: "memory");
    __syncthreads();
    if (threadIdx.x == 0) {
        unsigned* bar = b.bar;
        __builtin_amdgcn_s_waitcnt(0);
        unsigned nloc = b.st[0], nx = b.st[1];
        if (nloc == 0u) { xcd_barrier_complete(bar, b.x, nloc, nx); b.st[0] = nloc; b.st[1] = nx; }
        const unsigned old = xb_add(&bar[XB_XSUB(b.x)], 1u);
        const unsigned gen = old / nloc;
        if (old + 1u == (gen + 1u) * nloc) {
            __builtin_amdgcn_fence(__ATOMIC_RELEASE, "agent");
            asm volatile("s_waitcnt vmcnt(0)" ::: "memory");
            const unsigned og = xb_add(&bar[XB_TOP], 1u);
            const unsigned tg = og / nx;
            if (og + 1u == (tg + 1u) * nx) xb_add(&bar[XB_TOPGEN], 1u);
            else XB_SPIN(xb_ld(&bar[XB_TOPGEN]) == tg, bar);
            __builtin_amdgcn_fence(__ATOMIC_ACQUIRE, "agent");
            xb_add(&bar[XB_XGEN(b.x)], 1u);
            asm volatile("s_waitcnt vmcnt(0)" ::: "memory");
        } else {
            XB_SPIN(xb_ld(&bar[XB_XGEN(b.x)]) == gen, bar);
            __builtin_amdgcn_fence(__ATOMIC_ACQUIRE, "agent");
            asm volatile("s_waitcnt vmcnt(0)" ::: "memory");
        }
    }
    __syncthreads();
}


typedef unsigned short bf16_t;
typedef short bf16x8 __attribute__((ext_vector_type(8)));
typedef float f32x4 __attribute__((ext_vector_type(4)));
typedef unsigned u32x2 __attribute__((ext_vector_type(2)));
typedef unsigned u32x4 __attribute__((ext_vector_type(4)));
#define LDSP __attribute__((address_space(3)))
typedef short s16x4 __attribute__((ext_vector_type(4)));
__device__ __forceinline__ s16x4 vtr(const LDSP unsigned char* p) { return __builtin_bit_cast(s16x4, __builtin_amdgcn_ds_read_tr16_b64_v4i16((LDSP s16x4*)p)); }

__device__ __forceinline__ unsigned f2bf(float f) { unsigned u = __builtin_bit_cast(unsigned, f); return (u + 0x7fffu + ((u >> 16) & 1u)) >> 16; }
typedef float f32x2_t __attribute__((ext_vector_type(2))); typedef __bf16 bf16x2_t __attribute__((ext_vector_type(2)));
__device__ __forceinline__ unsigned pk2(float lo, float hi) { f32x2_t v = {lo, hi}; bf16x2_t b = __builtin_convertvector(v, bf16x2_t); return __builtin_bit_cast(unsigned, b); }
__device__ __forceinline__ float bf2f(unsigned short b) { return __builtin_bit_cast(float, (unsigned)b << 16); }
typedef int i32x4_t __attribute__((ext_vector_type(4))); typedef int i32x8_t __attribute__((ext_vector_type(8)));
constexpr float F8_SH = 4.f, F8_SW = 64.f, F8_SA = 2.f, F8_SC = 128.f;
__device__ __forceinline__ float f8clamp(float x) { return __builtin_amdgcn_fmed3f(x, -448.f, 448.f); }
__device__ __forceinline__ unsigned pk4f8(float a, float b, float c, float d) {
    unsigned w = 0;
    w = __builtin_amdgcn_cvt_pk_fp8_f32(f8clamp(a), f8clamp(b), w, false);
    w = __builtin_amdgcn_cvt_pk_fp8_f32(f8clamp(c), f8clamp(d), w, true);
    return w;
}
__device__ __forceinline__ f32x2_t f8lo(unsigned w) { return __builtin_amdgcn_cvt_pk_f32_fp8(w, false); }
__device__ __forceinline__ f32x2_t f8hi(unsigned w) { return __builtin_amdgcn_cvt_pk_f32_fp8(w, true); }
__device__ __forceinline__ void mfma_f8(f32x4& c, i32x8_t a, i32x8_t b) { asm volatile("v_mfma_f32_16x16x128_f8f6f4 %0, %1, %2, %0" : "+v"(c) : "v"(a), "v"(b)); }
__device__ __forceinline__ i32x8_t cat8(bf16x8 lo, bf16x8 hi) { return __builtin_shufflevector(__builtin_bit_cast(i32x4_t, lo), __builtin_bit_cast(i32x4_t, hi), 0, 1, 2, 3, 4, 5, 6, 7); }

struct RowId { __device__ __forceinline__ int operator()(int n) const { return n; } };
struct RowGU64 { __device__ __forceinline__ int operator()(int j) const { const int up = j >> 8, jj = j & 255; return (jj >> 5) * 64 + up * 32 + (jj & 31); } };
struct RowGU { __device__ __forceinline__ int operator()(int j) const { const int up = j >> 8, jj = j & 255; return (jj >> 7) * 256 + up * 128 + (jj & 127); } };
constexpr float QSCALE = 0.125f * 1.4426950408889634f;
struct ARowDense { const unsigned char* base; size_t ld; __device__ __forceinline__ const unsigned char* operator()(int r) const { return base + (size_t)r * ld; } };
typedef float f32x16 __attribute__((ext_vector_type(16)));
struct AttArgs { const bf16_t* q; const bf16_t* k; const bf16_t* v; bf16_t* opart; float* lse; };

constexpr int AW_UNITS = 3 * 64 * 8, AW_KP = 144, AW_VP = 192, AW_KBYTES = 384 * AW_KP;
struct AwPre { u32x4 k[6], v[6]; bf16x8 q[4]; };
__device__ __forceinline__ int aw_key_token(int c, int j, int kk) {
    if (c == 2) { const int rr = (kk >> 7) & 1, ks = kk & 127; return ks * 16 + 2 * j + rr; }
    const int d = c ? 4 : 1, r = c ? (j >> 1) : 0, A = c ? (j & 1) : j;
    int ks = 256 * A - 128 + kk; ks = ks < 0 ? 0 : ks;
    return ks * d + r;
}
__device__ __forceinline__ void aw_wave_coords(int c, int j, int w, int l31, int& d, int& r, int& sq, int& k00, int& lrow00) {
    if (c == 2) { const int rr = w >> 2, a = w & 3; d = 16; r = 2 * j + rr; sq = 32 * a + l31; k00 = 32 * a - 128; lrow00 = rr * 128 + k00; }
    else { d = c ? 4 : 1; r = c ? (j >> 1) : 0; const int A = c ? (j & 1) : j; sq = 256 * A + 32 * w + l31; k00 = 256 * A + 32 * w - 128; lrow00 = 32 * w; }
}
__device__ __forceinline__ void aw_prefetch(const AttArgs& A, int U, AwPre& P, int tid) {
    const int c = U >> 9, rem = U & 511, bh = rem >> 3, j = rem & 7;
    const bf16_t* Kb = A.k + (size_t)bh * 2048 * 64; const bf16_t* Vb = A.v + (size_t)bh * 2048 * 64;
    const int ch = tid & 7, row0 = tid >> 3;
#pragma unroll
    for (int i = 0; i < 6; ++i) {
        const size_t off = (size_t)aw_key_token(c, j, row0 + 64 * i) * 64 + ch * 8;
        P.k[i] = *(const u32x4*)(Kb + off); P.v[i] = *(const u32x4*)(Vb + off);
    }
    const int lane = tid & 63, w = tid >> 6, l31 = lane & 31, h2 = lane >> 5;
    int d, r, sq, k00, lrow00; aw_wave_coords(c, j, w, l31, d, r, sq, k00, lrow00);
    const bf16_t* qp = A.q + ((size_t)bh * 2048 + (size_t)sq * d + r) * 64 + 8 * h2;
#pragma unroll
    for (int s_ = 0; s_ < 4; ++s_) P.q[s_] = *(const bf16x8*)(qp + 16 * s_);
}
__device__ __forceinline__ void aw_stage(const AwPre& P, LDSP unsigned char* lds, int tid) {
    const int ch = tid & 7, row0 = tid >> 3;
#pragma unroll
    for (int i = 0; i < 6; ++i) {
        *(LDSP u32x4*)(lds + (row0 + 64 * i) * AW_KP + ch * 16) = P.k[i];
        *(LDSP u32x4*)(lds + AW_KBYTES + (row0 + 64 * i) * AW_VP + ch * 16) = P.v[i];
    }
}
__device__ __forceinline__ void aw_compute(const AttArgs& A, int U, const bf16x8 (&qf)[4], const LDSP unsigned char* lds, int tid) {
    const int c = U >> 9, rem = U & 511, bh = rem >> 3, j = rem & 7;
    const int lane = tid & 63, w = __builtin_amdgcn_readfirstlane(tid >> 6), l31 = lane & 31, h2 = lane >> 5;
    int d, r, sq, k00, lrow00; aw_wave_coords(c, j, w, l31, d, r, sq, k00, lrow00);
    const int tq = sq * d + r;
    f32x16 S[5];
#pragma unroll
    for (int kt = 0; kt < 5; ++kt) {
        const int k0 = k00 + 32 * kt;
        int lrow = lrow00 + 32 * kt; lrow = lrow < 0 ? 0 : lrow;
        const LDSP unsigned char* kp = lds + (lrow + l31) * AW_KP + 16 * h2;
        f32x16 acc;
#pragma unroll
        for (int i = 0; i < 16; ++i) acc[i] = 0.f;
#pragma unroll
        for (int s_ = 0; s_ < 4; ++s_) acc = __builtin_amdgcn_mfma_f32_32x32x16_bf16(*(const LDSP bf16x8*)(kp + 32 * s_), qf[s_], acc, 0, 0, 0);
        if (kt == 0 || kt == 4) {
#pragma unroll
            for (int i = 0; i < 16; ++i) {
                const int keyrow = (i & 3) + 8 * (i >> 2) + 4 * h2;
                const int dist = sq - (k0 + keyrow);
                if (dist < 0 || dist > 128) acc[i] = -INFINITY;
            }
        }
        if (k0 < 0) {
#pragma unroll
            for (int i = 0; i < 16; ++i) acc[i] = -INFINITY;
        }
        S[kt] = acc;
    }
    float m = -INFINITY;
#pragma unroll
    for (int kt = 0; kt < 5; ++kt)
#pragma unroll
        for (int i = 0; i < 16; ++i) m = fmaxf(m, S[kt][i]);
    m = fmaxf(m, __shfl_xor(m, 32));
    float l = 0.f;
#pragma unroll
    for (int kt = 0; kt < 5; ++kt)
#pragma unroll
        for (int i = 0; i < 16; ++i) { const float pe = __builtin_amdgcn_exp2f(S[kt][i] - m);        S[kt][i] = pe; l += pe; }
    l += __shfl_xor(l, 32);
    f32x16 O[2];
#pragma unroll
    for (int dt = 0; dt < 2; ++dt)
#pragma unroll
        for (int i = 0; i < 16; ++i) O[dt][i] = 0.f;
    const int g = lane >> 4, li = lane & 15;
    const int vro = (4 * (g >> 1) + (li >> 2)) * AW_VP + (16 * (g & 1) + 4 * (li & 3)) * 2;
#pragma unroll
    for (int kt = 0; kt < 5; ++kt) {
        int lrow = lrow00 + 32 * kt; lrow = lrow < 0 ? 0 : lrow;
        const LDSP unsigned char* vrd = lds + AW_KBYTES + lrow * AW_VP + vro;
#pragma unroll
        for (int sp = 0; sp < 2; ++sp) {
            bf16x8 pf;
            {
                u32x4 w4;
                w4.x = pk2(S[kt][8 * sp + 0], S[kt][8 * sp + 1]); w4.y = pk2(S[kt][8 * sp + 2], S[kt][8 * sp + 3]);
                w4.z = pk2(S[kt][8 * sp + 4], S[kt][8 * sp + 5]); w4.w = pk2(S[kt][8 * sp + 6], S[kt][8 * sp + 7]);
                pf = __builtin_bit_cast(bf16x8, w4);
            }
#pragma unroll
            for (int dt = 0; dt < 2; ++dt) {
                const s16x4 lo = vtr(vrd + (16 * sp) * AW_VP + dt * 64);
                const s16x4 hi = vtr(vrd + (16 * sp + 8) * AW_VP + dt * 64);
                const bf16x8 vf = (bf16x8){lo[0], lo[1], lo[2], lo[3], hi[0], hi[1], hi[2], hi[3]};
                O[dt] = __builtin_amdgcn_mfma_f32_32x32x16_bf16(vf, pf, O[dt], 0, 0, 0);
            }
        }
    }
    const float il = __builtin_amdgcn_rcpf(l);
    const int b = bh >> 3, h = bh & 7;
    const size_t tok = (size_t)b * 2048 + tq;
    bf16_t* op = A.opart + ((size_t)c * NT + tok) * 512 + h * 64 + 4 * h2;
#pragma unroll
    for (int dt = 0; dt < 2; ++dt)
#pragma unroll
        for (int g4 = 0; g4 < 4; ++g4) {
            u32x2 w2; w2.x = pk2(O[dt][4 * g4 + 0] * il, O[dt][4 * g4 + 1] * il); w2.y = pk2(O[dt][4 * g4 + 2] * il, O[dt][4 * g4 + 3] * il);
            *(u32x2*)(op + 32 * dt + 8 * g4) = w2;
        }
    if (h2 == 0) A.lse[((size_t)c * NT + tok) * 8 + h] = m + log2f(l);
}
struct SsmTabArgs { const float* lam_re; const float* lam_im; const float* log_step; const float* b_re; const float* b_im; const float* c_re; const float* c_im;
                    bf16_t* wendT; bf16_t* wcarT; bf16_t* klagT; float* a16; };
__device__ __forceinline__ void ssm_apow(const SsmTabArgs& A, int g, int p, float k, float& pr, float& pi) {
    const float lr = A.lam_re[g * 64 + p], li = A.lam_im[g * 64 + p], step = __expf(A.log_step[g]);
    const float e = __expf(k * lr * step); pr = e * __cosf(k * li * step); pi = e * __sinf(k * li * step);
}
__device__ __forceinline__ void ssm_coef(const SsmTabArgs& A, int g, int p, float& cr, float& ci) {
    const float lr = A.lam_re[g * 64 + p], li = A.lam_im[g * 64 + p];
    float ar, ai; ssm_apow(A, g, p, 1.f, ar, ai);
    const float nr = ar - 1.f, ni = ai, den = lr * lr + li * li;
    cr = (nr * lr + ni * li) / den; ci = (ni * lr - nr * li) / den;
}
__device__ __forceinline__ size_t ft_off(int n, int k, int K) { return ((size_t)((n >> 4) * (K >> 5) + (k >> 5)) << 9) + (((k >> 3) & 3) << 7) + ((n & 15) << 3) + (k & 7); }
__device__ __forceinline__ void ssm_tab_item(const SsmTabArgs& A, int it) {
    if (it < 32768) {
        const int s = it & 15, p = (it >> 4) & 63, g = it >> 10;
        float pr, pi, cr, ci; ssm_apow(A, g, p, (float)(15 - s), pr, pi); ssm_coef(A, g, p, cr, ci);
        const float mr = pr * cr - pi * ci, mi = pr * ci + pi * cr;
        bf16_t* wb = A.wendT + (size_t)g * 128 * 256;
#pragma unroll
        for (int c = 0; c < 16; ++c) {
            const float br = A.b_re[((size_t)g * 64 + p) * 16 + c], bi = A.b_im[((size_t)g * 64 + p) * 16 + c];
            wb[ft_off(p, s * 16 + c, 256)] = (bf16_t)f2bf(mr * br - mi * bi); wb[ft_off(64 + p, s * 16 + c, 256)] = (bf16_t)f2bf(mr * bi + mi * br);
        }
    } else if (it < 65536) {
        const int j = it - 32768; const int t = j & 15, p = (j >> 4) & 63, g = j >> 10;
        float pr, pi; ssm_apow(A, g, p, (float)(t + 1), pr, pi);
#pragma unroll
        for (int co = 0; co < 16; ++co) {
            const float cr = A.c_re[((size_t)g * 16 + co) * 64 + p], ci = A.c_im[((size_t)g * 16 + co) * 64 + p];
            bf16_t* wb = A.wcarT + (size_t)g * 256 * 128;
            wb[ft_off(t * 16 + co, p, 128)] = (bf16_t)f2bf(cr * pr - ci * pi); wb[ft_off(t * 16 + co, 64 + p, 128)] = (bf16_t)f2bf(-(cr * pi + ci * pr));
        }
    } else {
        const int j = it - 65536; const int p = j & 63, g = j >> 6;
        float pr, pi; ssm_apow(A, g, p, 16.f, pr, pi);
        A.a16[(size_t)j * 2] = pr; A.a16[(size_t)j * 2 + 1] = pi;
    }
}
constexpr int SSM_TAB_ITEMS = 65536 + 2048;
__device__ __forceinline__ void ssm_klag_item(const SsmTabArgs& A, int it, LDSP float* scr, int tid) {
    const int g = it >> 4, lag = it & 15;
    LDSP float* Mr = scr; LDSP float* Mi = scr + 1024; LDSP float* Cr = scr + 2048; LDSP float* Ci = scr + 3072;
    __syncthreads();
    if (tid < 64) {
        const int p = tid; float pr, pi, cr, ci; ssm_apow(A, g, p, (float)lag, pr, pi); ssm_coef(A, g, p, cr, ci);
        const float mr = pr * cr - pi * ci, mi = pr * ci + pi * cr;
#pragma unroll
        for (int c = 0; c < 16; ++c) {
            const float br = A.b_re[((size_t)g * 64 + p) * 16 + c], bi = A.b_im[((size_t)g * 64 + p) * 16 + c];
            Mr[p * 16 + c] = mr * br - mi * bi; Mi[p * 16 + c] = mr * bi + mi * br;
            Cr[p * 16 + c] = A.c_re[((size_t)g * 16 + c) * 64 + p]; Ci[p * 16 + c] = A.c_im[((size_t)g * 16 + c) * 64 + p];
        }
    }
    __syncthreads();
    if (tid < 256) {
        const int co = tid >> 4, ci_ = tid & 15; float acc = 0.f;
        for (int p = 0; p < 64; ++p) acc += Cr[p * 16 + co] * Mr[p * 16 + ci_] - Ci[p * 16 + co] * Mi[p * 16 + ci_];
        A.klagT[(((size_t)g * 16 + lag) * 16 + co) * 16 + ci_] = (bf16_t)f2bf(acc);
    }
}

struct SsmArgs { const bf16_t* u; const bf16_t* wendT; const bf16_t* wcarT; const bf16_t* klagT; const float* a16; const float* d_skip; bf16_t* yss; };
__device__ __forceinline__ void ssm_stage_u(LDSP unsigned char* lds, const bf16_t* ubase  , int hh, int tid) {
#pragma unroll
    for (int i = 0; i < 4; ++i) {
        const int id = tid + 512 * i, row = id >> 5, ch = id & 31;
        const u32x4 w = *(const u32x4*)(ubase + (size_t)(64 * hh + row) * 256 + ch * 8);
        *(LDSP u32x4*)(lds + (ch >> 3) * 8192 + row * 128 + (((ch & 7) ^ (row & 7)) * 16)) = w;
    }
}
__device__ __forceinline__ void ssm_unit(const SsmArgs& A, int bg, LDSP unsigned char* lds) {
    const int tid = threadIdx.x, lane = tid & 63, w = __builtin_amdgcn_readfirstlane(tid >> 6), fr = lane & 15, fq = lane >> 4;
    const int g = bg & 31, b = bg >> 5;
    const bf16_t* ubase = A.u + (size_t)bg * 2048 * 16;
    LDSP unsigned char* Ebuf = lds + 32768; LDSP unsigned char* Xbuf = lds + 98304;
    const bf16_t* wend = A.wendT + (size_t)g * 128 * 256;
    const bf16_t* wcar = A.wcarT + (size_t)g * 256 * 128;
    const bf16_t* klag = A.klagT + (size_t)g * 16 * 256;
    for (int hh = 0; hh < 2; ++hh) {
        __syncthreads();
        ssm_stage_u(lds, ubase, hh, tid);
        __syncthreads();
        f32x4 acc[4];
#pragma unroll
        for (int mi = 0; mi < 4; ++mi) acc[mi] = (f32x4){0.f, 0.f, 0.f, 0.f};
#pragma unroll
        for (int kk = 0; kk < 8; ++kk) {
            const bf16x8 wf = *(const bf16x8*)(wend + ((size_t)(w * 8 + kk) << 9) + lane * 8);
#pragma unroll
            for (int mi = 0; mi < 4; ++mi) {
                const bf16x8 af = *(const LDSP bf16x8*)(lds + (kk >> 1) * 8192 + (16 * mi + fr) * 128 + (((((kk & 1) * 4) + fq) ^ (fr & 7)) * 16));
                acc[mi] = __builtin_amdgcn_mfma_f32_16x16x32_bf16(wf, af, acc[mi], 0, 0, 0);
            }
        }
#pragma unroll
        for (int mi = 0; mi < 4; ++mi) *(LDSP f32x4*)(Ebuf + ((64 * hh + 16 * mi + fr) * 128 + 16 * w + 4 * fq) * 4) = acc[mi];
    }
    __syncthreads();
    {
        const float ar = A.a16[((size_t)g * 64 + lane) * 2], ai = A.a16[((size_t)g * 64 + lane) * 2 + 1];
        LDSP float* Tb = (LDSP float*)(lds + 131072);
        float Lr[16], Li[16];
        float cr = 0.f, ci = 0.f;
#pragma unroll
        for (int j = 0; j < 16; ++j) {
            const int c = 16 * w + j;
            const float er = *(const LDSP float*)(Ebuf + (c * 128 + lane) * 4), ei = *(const LDSP float*)(Ebuf + (c * 128 + 64 + lane) * 4);
            Lr[j] = cr; Li[j] = ci;
            const float nr = ar * cr - ai * ci + er, ni = ar * ci + ai * cr + ei;
            cr = nr; ci = ni;
        }
        Tb[w * 128 + lane] = cr; Tb[w * 128 + 64 + lane] = ci;
        float pr = ar, pi = ai;
#pragma unroll
        for (int q = 0; q < 4; ++q) { const float tr = pr * pr - pi * pi, ti = 2.f * pr * pi; pr = tr; pi = ti; }
        __syncthreads();
        float gr = 0.f, gi = 0.f;
        for (int v = 0; v < w; ++v) {
            const float tr = Tb[v * 128 + lane], ti = Tb[v * 128 + 64 + lane];
            const float nr = pr * gr - pi * gi + tr, ni = pr * gi + pi * gr + ti;
            gr = nr; gi = ni;
        }
        const int xo = (lane >> 3), xb = (lane & 7) * 2;
        float qr = 1.f, qi = 0.f;
#pragma unroll
        for (int j = 0; j < 16; ++j) {
            const int c = 16 * w + j;
            const float xr = Lr[j] + qr * gr - qi * gi, xi = Li[j] + qr * gi + qi * gr;
            const int off = c * 128 + ((xo ^ (c & 7)) * 16) + xb;
            *(LDSP bf16_t*)(Xbuf + off) = (bf16_t)f2bf(xr);
            *(LDSP bf16_t*)(Xbuf + 16384 + off) = (bf16_t)f2bf(xi);
            const float tr = qr * ar - qi * ai, ti = qr * ai + qi * ar; qr = tr; qi = ti;
        }
    }
    __syncthreads();
    for (int hx = 0; hx < 2; ++hx) {
        const int hh = 1 - hx;
        if (hx == 1) { __syncthreads(); ssm_stage_u(lds, ubase, hh, tid); __syncthreads(); }
        f32x4 acc[4][2];
#pragma unroll
        for (int mi = 0; mi < 4; ++mi) { acc[mi][0] = (f32x4){0.f, 0.f, 0.f, 0.f}; acc[mi][1] = (f32x4){0.f, 0.f, 0.f, 0.f}; }
#pragma unroll
        for (int j = 0; j < 2; ++j) {
            const int t = j ? (15 - w) : w;
#pragma unroll
            for (int kk = 0; kk < 8; ++kk) {
                if (2 * kk <= t) {
                    const int s = 2 * kk + (fq >> 1);
                    bf16x8 wf = (bf16x8){0, 0, 0, 0, 0, 0, 0, 0};
                    if (s <= t) wf = *(const bf16x8*)(klag + ((size_t)(t - s) * 16 + fr) * 16 + 8 * (fq & 1));
#pragma unroll
                    for (int mi = 0; mi < 4; ++mi) {
                        const bf16x8 af = *(const LDSP bf16x8*)(lds + (kk >> 1) * 8192 + (16 * mi + fr) * 128 + (((((kk & 1) * 4) + fq) ^ (fr & 7)) * 16));
                        acc[mi][j] = __builtin_amdgcn_mfma_f32_16x16x32_bf16(wf, af, acc[mi][j], 0, 0, 0);
                    }
                }
            }
#pragma unroll
            for (int k2 = 0; k2 < 4; ++k2) {
                const bf16x8 wf = *(const bf16x8*)(wcar + ((size_t)(t * 4 + k2) << 9) + lane * 8);
#pragma unroll
                for (int mi = 0; mi < 4; ++mi) {
                    const int row = 64 * hh + 16 * mi + fr;
                    const bf16x8 xf = *(const LDSP bf16x8*)(Xbuf + (k2 >> 1) * 16384 + row * 128 + (((((k2 & 1) * 4) + fq) ^ (fr & 7)) * 16));
                    acc[mi][j] = __builtin_amdgcn_mfma_f32_16x16x32_bf16(wf, xf, acc[mi][j], 0, 0, 0);
                }
            }
        }
        const float4 dk = *(const float4*)(A.d_skip + g * 16 + 4 * fq);
#pragma unroll
        for (int j = 0; j < 2; ++j) {
            const int t = j ? (15 - w) : w;
#pragma unroll
            for (int mi = 0; mi < 4; ++mi) {
                const int tt = (64 * hh + 16 * mi + fr) * 16 + t;
                const u32x2 uw = *(const u32x2*)(ubase + (size_t)tt * 16 + 4 * fq);
                const f32x4 a = acc[mi][j];
                const float y0 = gelu_tanh(a[0] + dk.x * bf2f(uw.x & 0xffff)), y1 = gelu_tanh(a[1] + dk.y * bf2f(uw.x >> 16));
                const float y2 = gelu_tanh(a[2] + dk.z * bf2f(uw.y & 0xffff)), y3 = gelu_tanh(a[3] + dk.w * bf2f(uw.y >> 16));
                u32x2 o; o.x = pk2(y0, y1); o.y = pk2(y2, y3);
                *(u32x2*)(A.yss + ((size_t)b * 2048 + tt) * 512 + g * 16 + 4 * fq) = o;
            }
        }
    }
}
__device__ __forceinline__ float silu_f(float g) { return g * __builtin_amdgcn_rcpf(1.f + __expf(-g)); }
constexpr int ME_LDS = 147456;
namespace pg {
constexpr int BM = 256, BK = 64, HALF = 128, HTB = HALF * BK * 2, STAGE_BYTES = 8 * HTB;
constexpr int VA_SLOT_OFF = 151552;
__device__ __forceinline__ int lds_byte(int r, int c) { const int st = (r >> 4) * 2 + (c >> 5), rr = r & 15, cc = c & 31, ob = rr * 64 + cc * 2; return st * 1024 + (ob ^ (((ob >> 9) & 1) << 5)); }
__device__ __forceinline__ void stage_rc(int b, int& R, int& C) { const int st = b / 1024, sb = b % 1024, swz = sb ^ (((sb >> 9) & 1) << 5); R = (st >> 1) * 16 + swz / 64; C = (st & 1) * 32 + (swz % 64) / 2; }
struct Unit { const char* A; const char* B; int x0, x1, x2, x3; };
struct LaneRC { int R0, C0, R1, C1; };
__device__ __forceinline__ LaneRC lane_rc() { LaneRC l; stage_rc(threadIdx.x * 16, l.R0, l.C0); stage_rc(threadIdx.x * 16 + 8192, l.R1, l.C1); return l; }
__device__ __forceinline__ LaneRC lane_rc_fresh() { int t = threadIdx.x; asm volatile("" : "+v"(t)); LaneRC l; stage_rc(t * 16, l.R0, l.C0); stage_rc(t * 16 + 8192, l.R1, l.C1); return l; }
struct VA { unsigned v00, v01, v10, v11; };
__device__ __forceinline__ VA dense_va(unsigned lda  ) {
    const LaneRC l = lane_rc(); VA v;
    v.v00 = l.R0 * lda + l.C0 * 2; v.v01 = l.R1 * lda + l.C1 * 2; v.v10 = (128 + l.R0) * lda + l.C0 * 2; v.v11 = (128 + l.R1) * lda + l.C1 * 2; return v;
}
__device__ __forceinline__ int perm32(int rho) { const int n = rho >> 4, i = rho & 15; return 8 * (i >> 2) + 4 * n + (i & 3); }
__device__ __forceinline__ int ragged_row(int h, int R) { return 16 * (2 * (4 * h + ((R >> 4) & 3)) + (R >> 6)) + (R & 15); }
template <bool GATHER, int PERM, bool RAGGED, bool F8, class Sched, class Epi>
__device__ __forceinline__ void gemm_phase(LDSP unsigned char* lds, const int K, const Sched& S, const Epi& E) {
    const int tid = threadIdx.x, wid = __builtin_amdgcn_readfirstlane(tid >> 6), lane = tid & 63, wr = wid >> 2, wc = wid & 3, fr = lane & 15, fq = lane >> 4;
    const int nt = K / BK;
    unsigned voffB[2];
    { int R, C; stage_rc(tid * 16, R, C); if (PERM == 1) R = (R & ~31) + perm32(R & 31); if (PERM == 2) R = 64 * (R >> 5) + 16 * ((R >> 2) & 3) + 4 * ((R >> 4) & 1) + (R & 3); voffB[0] = (unsigned)(R * K + C) * 2u;
      stage_rc(tid * 16 + 8192, R, C); if (PERM == 1) R = (R & ~31) + perm32(R & 31); if (PERM == 2) R = 64 * (R >> 5) + 16 * ((R >> 2) & 3) + 4 * ((R >> 4) & 1) + (R & 3); voffB[1] = (unsigned)(R * K + C) * 2u; }
    const size_t kstep = (size_t)(BK * 2), hstepB = (size_t)(PERM == 2 ? 8 : HALF) * K * 2;
    const unsigned ldsw = (unsigned)wid * 1024u;
    const int aoff = lds_byte(wr * 64 + fr, fq * 8), boff = lds_byte(wc * 32 + fr, fq * 8);
#define PG_SA(b, h) (((b) * 2 + (h)) * HTB)
#define PG_SB(b, h) ((4 + (b) * 2 + (h)) * HTB)
#define PG_STAGE(bufoff, gbase, v0, v1) do { \
        __builtin_amdgcn_global_load_lds((const unsigned*)((const char*)(gbase) + (v0)), (LDSP unsigned*)(lds + (bufoff) + ldsw), 16, 0, 0); \
        __builtin_amdgcn_global_load_lds((const unsigned*)((const char*)(gbase) + (v1)), (LDSP unsigned*)(lds + (bufoff) + ldsw + 8192), 16, 0, 0); } while (0)
#define PG_LDA(dst, b, h) do { _Pragma("unroll") for (int m = 0; m < 4; ++m) _Pragma("unroll") for (int k = 0; k < 2; ++k) dst[m][k] = *(const LDSP bf16x8*)(lds + PG_SA(b, h) + aoff + m * 2048 + k * 1024); } while (0)
#define PG_LDB(dst, b, h) do { _Pragma("unroll") for (int n = 0; n < 2; ++n) _Pragma("unroll") for (int k = 0; k < 2; ++k) dst[n][k] = *(const LDSP bf16x8*)(lds + PG_SB(b, h) + boff + n * 2048 + k * 1024); } while (0)
#define PG_MMA(ai, bj, At, Bt, ML) do { __builtin_amdgcn_s_setprio(1); _Pragma("unroll") for (int m = 0; m < (ML); ++m) { _Pragma("unroll") for (int n = 0; n < 2; ++n) { \
        if constexpr (F8) mfma_f8(acc[ai][bj][m][n], cat8(Bt[n][0], Bt[n][1]), cat8(At[m][0], At[m][1])); \
        else { _Pragma("unroll") for (int k = 0; k < 2; ++k) acc[ai][bj][m][n] = __builtin_amdgcn_mfma_f32_16x16x32_bf16(Bt[n][k], At[m][k], acc[ai][bj][m][n], 0, 0, 0); } } } __builtin_amdgcn_s_setprio(0); } while (0)
#define PG_WAIT_V(n) asm volatile("s_waitcnt vmcnt(" #n ")" ::: "memory")
#define PG_WAIT_L(n) asm volatile("s_waitcnt lgkmcnt(" #n ")" ::: "memory")
#define PG_BAR __builtin_amdgcn_s_barrier()
#define PG_SCHED __builtin_amdgcn_sched_barrier(0)
    Unit cur, nxt; int ui = 0;
    if (!S.next(0, cur)) return;
    f32x4 acc[2][2][4][2];
#pragma unroll
    for (int a = 0; a < 2; ++a)
#pragma unroll
        for (int b = 0; b < 2; ++b)
#pragma unroll
            for (int m = 0; m < 4; ++m)
#pragma unroll
                for (int n = 0; n < 2; ++n) acc[a][b][m][n] = (f32x4){0.f, 0.f, 0.f, 0.f};
    bf16x8 At[4][2], B0[2][2], B1[2][2];
    const char* cA = cur.A; const char* cB = cur.B;
    int nvc = RAGGED ? cur.x1 : 256;
    VA cva = S.va(cur);
    PG_STAGE(PG_SB(0, 0), cB, voffB[0], voffB[1]); PG_STAGE(PG_SB(0, 1), cB + hstepB, voffB[0], voffB[1]);
    PG_STAGE(PG_SA(0, 0), cA, cva.v00, cva.v01); PG_STAGE(PG_SA(0, 1), cA, cva.v10, cva.v11);
    if (wr == 1) PG_BAR;
    PG_WAIT_V(2); PG_BAR;
    PG_STAGE(PG_SB(1, 0), cB + kstep, voffB[0], voffB[1]); PG_STAGE(PG_SA(1, 0), cA + kstep, cva.v00, cva.v01); PG_STAGE(PG_SB(1, 1), cB + hstepB + kstep, voffB[0], voffB[1]);
    PG_WAIT_V(6); PG_BAR;
    for (;;) {
        const bool has_next = S.next(ui + 1, nxt);
        const char* nA = has_next ? nxt.A : cA; const char* nB = has_next ? nxt.B : cB;
        if constexpr (GATHER) {
            VA nva_ = cva; if (has_next) nva_ = S.va(nxt);
            *(LDSP u32x4*)(lds + VA_SLOT_OFF + tid * 16) = (u32x4){nva_.v00, nva_.v01, nva_.v10, nva_.v11};
        }
#define PG_BODY(M1) do { \
              \
            PG_LDB(B0, 0, 0); PG_LDB(B1, 0, 1); PG_SCHED; PG_LDA(At, 0, 0); PG_STAGE(PG_SA(1, 1), a1, cva.v10, cva.v11); \
            PG_WAIT_V(8); PG_WAIT_L(0); PG_BAR; PG_MMA(0, 0, At, B0, 4); PG_MMA(0, 1, At, B1, 4); PG_BAR; PG_SCHED; \
            PG_LDA(At, 0, 1); PG_STAGE(PG_SB(0, 0), b2, voffB[0], voffB[1]); PG_STAGE(PG_SB(0, 1), b2 + hstepB, voffB[0], voffB[1]); PG_STAGE(PG_SA(0, 0), a2, v00, v01); \
            PG_WAIT_V(8); PG_WAIT_L(0); PG_BAR; PG_MMA(1, 0, At, B0, M1); PG_MMA(1, 1, At, B1, M1); PG_BAR; PG_SCHED; \
              \
            PG_LDB(B0, 1, 0); PG_LDB(B1, 1, 1); PG_SCHED; PG_LDA(At, 1, 0); PG_STAGE(PG_SA(0, 1), a2, v10, v11); \
            PG_WAIT_V(8); PG_WAIT_L(0); PG_BAR; PG_MMA(0, 0, At, B0, 4); PG_MMA(0, 1, At, B1, 4); PG_BAR; PG_SCHED; \
            PG_LDA(At, 1, 1); PG_STAGE(PG_SB(1, 0), b3, voffB[0], voffB[1]); PG_STAGE(PG_SB(1, 1), b3 + hstepB, voffB[0], voffB[1]); PG_STAGE(PG_SA(1, 0), a3, v00, v01); \
            PG_WAIT_V(8); PG_WAIT_L(0); PG_BAR; PG_MMA(1, 0, At, B0, M1); PG_MMA(1, 1, At, B1, M1); PG_BAR; PG_SCHED; } while (0)
#define PG_TLOOP(M1) do { _Pragma("unroll 1") for (int t = 0; t < nt; t += 2) { \
            const bool last = (t == nt - 2); \
            const char* a1 = cA + (size_t)(t + 1) * kstep; \
            const char* a2 = last ? nA : cA + (size_t)(t + 2) * kstep; const char* b2 = last ? nB : cB + (size_t)(t + 2) * kstep; \
            const char* a3 = a2 + kstep; const char* b3 = b2 + kstep; \
            unsigned v00 = cva.v00, v01 = cva.v01, v10 = cva.v10, v11 = cva.v11; \
            asm volatile("" : "+v"(voffB[0]), "+v"(voffB[1]));        \
            if constexpr (GATHER) { if (last) { const u32x4 q_ = *(const LDSP u32x4*)(lds + VA_SLOT_OFF + tid * 16); v00 = q_.x; v01 = q_.y; v10 = q_.z; v11 = q_.w; } } \
            PG_BODY(M1); } } while (0)
        if constexpr (RAGGED) {
            if (nvc > 192) PG_TLOOP(4); else if (nvc > 128) PG_TLOOP(2); else PG_TLOOP(0);
        } else PG_TLOOP(4);
#undef PG_TLOOP
#undef PG_BODY
        if (wr == 0) PG_BAR;
        if constexpr (F8) asm volatile("s_nop 15\n\ts_nop 15" ::: "memory");
        E(acc, cur, wr, wc, fr, fq);
        if (!has_next) break;
#pragma unroll
        for (int a = 0; a < 2; ++a)
#pragma unroll
            for (int b = 0; b < 2; ++b)
#pragma unroll
                for (int m = 0; m < 4; ++m)
#pragma unroll
                    for (int n = 0; n < 2; ++n) acc[a][b][m][n] = (f32x4){0.f, 0.f, 0.f, 0.f};
        cur = nxt; cA = nA; cB = nB; ++ui; if (RAGGED) nvc = cur.x1;
        if constexpr (GATHER) { const u32x4 q_ = *(const LDSP u32x4*)(lds + VA_SLOT_OFF + tid * 16); cva.v00 = q_.x; cva.v01 = q_.y; cva.v10 = q_.z; cva.v11 = q_.w; }
        if (wr == 1) PG_BAR;
    }
    PG_WAIT_V(0);
    PG_BAR;
#undef PG_SA
#undef PG_SB
#undef PG_STAGE
#undef PG_LDA
#undef PG_LDB
#undef PG_MMA
#undef PG_WAIT_V
#undef PG_WAIT_L
#undef PG_BAR
#undef PG_SCHED
}
template <class F, class V> struct SchedF { F f; V v; __device__ __forceinline__ bool next(int i, Unit& u) const { return f(i, u); } __device__ __forceinline__ VA va(const Unit& u) const { return v(u); } };
template <class F, class V> __device__ __forceinline__ SchedF<F, V> sched(F f, V v) { return SchedF<F, V>{f, v}; }
template <class F> struct EpiFrag {
    F f;
    __device__ __forceinline__ void operator()(const f32x4 (&acc)[2][2][4][2], const Unit& u, int wr, int wc, int fr, int fq) const {
#pragma unroll
        for (int ai = 0; ai < 2; ++ai)
#pragma unroll
            for (int m = 0; m < 4; ++m) {
                int rr_ = 128 * ai + 64 * wr + 16 * m + fr;
                asm volatile("" : "+v"(rr_));
#pragma unroll
                for (int bj = 0; bj < 2; ++bj)
#pragma unroll
                    for (int n = 0; n < 2; ++n) f(u, rr_, 128 * bj + 32 * wc + 16 * n + 4 * fq, acc[ai][bj][m][n]);
                asm volatile("" ::: "memory");
            }
    }
};
template <class F> __device__ __forceinline__ EpiFrag<F> epi_frag(F f) { return EpiFrag<F>{f}; }
template <class F> struct EpiRow8 {
    F f;
    __device__ __forceinline__ void operator()(const f32x4 (&acc)[2][2][4][2], const Unit& u, int wr, int wc, int fr, int fq) const {
#pragma unroll
        for (int ai = 0; ai < 2; ++ai)
#pragma unroll
            for (int m = 0; m < 4; ++m) {
                int rr_ = 128 * ai + 64 * wr + 16 * m + fr;
                asm volatile("" : "+v"(rr_));
#pragma unroll
                for (int bj = 0; bj < 2; ++bj) f(u, rr_, 128 * bj + 32 * wc + 8 * fq, acc[ai][bj][m][0], acc[ai][bj][m][1]);
                asm volatile("" ::: "memory");
            }
    }
};
template <class F> __device__ __forceinline__ EpiRow8<F> epi_row8(F f) { return EpiRow8<F>{f}; }
__device__ __forceinline__ u32x4 pack8(f32x4 a, f32x4 b) { u32x4 w; w.x = pk2(a[0], a[1]); w.y = pk2(a[2], a[3]); w.z = pk2(b[0], b[1]); w.w = pk2(b[2], b[3]); return w; }
__device__ __forceinline__ bool static_tile(int i, int nM, int nN, int& pm, int& pn) {
    const int nwg = nM * nN; const long L = (long)i * gridDim.x + blockIdx.x; if (L >= nwg) return false;
    int wgid = (int)L; { const int q = nwg / 8, r = nwg % 8, xcd = wgid % 8, off = wgid / 8; wgid = (xcd < r ? xcd * (q + 1) : r * (q + 1) + (xcd - r) * q) + off; }
    const int nig = 8 * nN, gid = wgid / nig, fm = gid * 8, gsz = (nM - fm) < 8 ? (nM - fm) : 8;
    pm = fm + ((wgid % nig) % gsz); pn = (wgid % nig) / gsz; return true;
}
}

__device__ __forceinline__ int moe_ntiles(int c) { return (c + 255) >> 8; }
__device__ __forceinline__ void moe_tile_rows(int c, int j, int& row0, int& nvalid) {
    const int nte = (c + 255) >> 8, rpt = nte ? (((c + nte - 1) / nte + 15) & ~15) : 0;
    row0 = j * rpt; nvalid = min(c - row0, rpt);
}
constexpr int LDS_SP = 131072, LDS_CT = LDS_SP + 256 * NSEG * 4, LDS_WT = LDS_CT + 1024;
template <bool COMPACT>
__device__ __forceinline__ void moe_tile_table(const int* cntp, int* ctab, LDSP unsigned char* lds, LDSP int* ts, int tid) {
    LDSP int* sp = (LDSP int*)(lds + LDS_SP); LDSP int* ct = (LDSP int*)(lds + LDS_CT); LDSP int* wt = (LDSP int*)(lds + LDS_WT);
    const int lane = tid & 63, wid = tid >> 6;
    __syncthreads();
    int c = 0;
    if (tid < 256) {
        int v[NSEG];
        if constexpr (COMPACT) {
            const i32x4_t a0 = *(const i32x4_t*)(ctab + tid * NSEG), a1 = *(const i32x4_t*)(ctab + tid * NSEG + 4);
            v[0] = a0[0]; v[1] = a0[1]; v[2] = a0[2]; v[3] = a0[3]; v[4] = a1[0]; v[5] = a1[1]; v[6] = a1[2]; v[7] = a1[3];
        } else {
#pragma unroll
            for (int sg = 0; sg < NSEG; ++sg) v[sg] = __hip_atomic_load(cntp + (size_t)(sg * 256 + tid) * CNT_STRIDE, __ATOMIC_RELAXED, __HIP_MEMORY_SCOPE_AGENT);
            *(i32x4_t*)(ctab + tid * NSEG) = (i32x4_t){v[0], v[1], v[2], v[3]}; *(i32x4_t*)(ctab + tid * NSEG + 4) = (i32x4_t){v[4], v[5], v[6], v[7]};
        }
#pragma unroll
        for (int sg = 0; sg < NSEG; ++sg) { sp[tid * NSEG + sg] = c; c += v[sg]; }
        ct[tid] = c;
    }
    const int own_t = (c + 255) >> 8, own_a = (c + 15) & ~15;
    int st = own_t, sa = own_a;
#define TT_STEP(ctrl, rmask) do { st += __builtin_amdgcn_update_dpp(0, st, ctrl, rmask, 0xf, false); sa += __builtin_amdgcn_update_dpp(0, sa, ctrl, rmask, 0xf, false); } while (0)
    TT_STEP(0x111, 0xf); TT_STEP(0x112, 0xf); TT_STEP(0x114, 0xf); TT_STEP(0x118, 0xf); TT_STEP(0x142, 0xa); TT_STEP(0x143, 0xc);
#undef TT_STEP
    if (lane == 63 && wid < 4) { wt[wid * 2] = st; wt[wid * 2 + 1] = sa; }
    __syncthreads();
    if (tid < 256) {
        for (int w2 = 0; w2 < wid; ++w2) { st += wt[w2 * 2]; sa += wt[w2 * 2 + 1]; }
        ts[tid] = st - own_t; ts[260 + tid] = sa - own_a;
        if (tid == 255) ts[256] = st;
    }
    __syncthreads();
}
__device__ __forceinline__ int moe_find_expert(const LDSP int* ts, int tile) {
    int lo = 0, hi = 256;
    while (hi - lo > 1) { const int mid = (lo + hi) >> 1; if (ts[mid] <= tile) lo = mid; else hi = mid; }
    return lo;
}
struct MoeUnit { int e, pn, row0, nvalid, arow0; };
constexpr int MOE_UD_OFF = 2176, MOE_UD_MAX = 56;
__device__ __forceinline__ MoeUnit moe_unit(const LDSP int* ts, const LDSP int* ct, int o, int npn) {
    MoeUnit u; u.e = moe_find_expert(ts, o / npn);
    const int nte = ts[u.e + 1] - ts[u.e], local = o - npn * ts[u.e];
    u.pn = local / nte; const int j = local - u.pn * nte;
    const int c = ct[u.e];
    moe_tile_rows(c, j, u.row0, u.nvalid); u.arow0 = ts[260 + u.e] + u.row0;
    return u;
}
__device__ __forceinline__ int moe_build_units(const LDSP int* ts, const LDSP int* cnt, int first, int last, int step, int npn, LDSP int* ud, int tid) {
    const int n = first < last ? (last - first + step - 1) / step : 0;
    if (tid < n && tid < MOE_UD_MAX) { const MoeUnit mu = moe_unit(ts, cnt, first + tid * step, npn); LDSP int* d = ud + tid * 5; d[0] = mu.e; d[1] = mu.pn; d[2] = mu.row0; d[3] = mu.nvalid > 0 ? mu.nvalid : 0; d[4] = mu.arow0; }
    __syncthreads();
    return n < MOE_UD_MAX ? n : MOE_UD_MAX;
}
__device__ __forceinline__ void unit_range(int U, int& first, int& last, int& step) {
    const int G = gridDim.x;
    if (G & 7) { first = blockIdx.x; last = U; step = G; return; }
    const int x = blockIdx.x & 7, r = blockIdx.x >> 3;
    first = (int)(((long)x * U) >> 3) + r; last = (int)(((long)(x + 1) * U) >> 3); step = G >> 3;
}
struct FinArgs { const bf16_t* pre2b; const unsigned char* contrib8; const float* gate; const int* inv; const float* g; const float* b; float* out; };
struct FinRows { u32x2 c0[8], c1[8]; u32x4 p0, p1; };
__device__ __forceinline__ void fin_index(const FinArgs& A, const LDSP int* ab, const LDSP int* sp, int tok, int lane, int& rowk, float& gk) {
    const int l8 = lane & 7;
    const int w = A.inv[(size_t)tok * 8 + l8]; rowk = ab[w >> 16] + sp[(w >> 16) * NSEG + ((w >> 11) & (NSEG - 1))] + (w & 2047); gk = A.gate[(size_t)tok * 8 + l8] * (1.f / F8_SC);
}
__device__ __forceinline__ void fin_rows(const FinArgs& A, int rowk, int tok, int lane, FinRows& R) {
#pragma unroll
    for (int k = 0; k < 8; ++k) {
        const int row = __builtin_amdgcn_readlane(rowk, k);
        const unsigned char* cp = A.contrib8 + (size_t)row * 1024 + lane * 8;
        R.c0[k] = *(const u32x2*)cp; R.c1[k] = *(const u32x2*)(cp + 512);
    }
    const bf16_t* pp = A.pre2b + (size_t)tok * 1024 + lane * 8;
    R.p0 = *(const u32x4*)pp; R.p1 = *(const u32x4*)(pp + 512);
}
__device__ __forceinline__ void fin_finish(const FinArgs& A, const FinRows& R, float gk, int tok, int lane) {
    const u32x4 p0 = R.p0, p1 = R.p1;
    f32x4 v[4];
    v[0] = (f32x4){bf2f(p0.x & 0xffff), bf2f(p0.x >> 16), bf2f(p0.y & 0xffff), bf2f(p0.y >> 16)}; v[1] = (f32x4){bf2f(p0.z & 0xffff), bf2f(p0.z >> 16), bf2f(p0.w & 0xffff), bf2f(p0.w >> 16)};
    v[2] = (f32x4){bf2f(p1.x & 0xffff), bf2f(p1.x >> 16), bf2f(p1.y & 0xffff), bf2f(p1.y >> 16)}; v[3] = (f32x4){bf2f(p1.z & 0xffff), bf2f(p1.z >> 16), bf2f(p1.w & 0xffff), bf2f(p1.w >> 16)};
#pragma unroll
    for (int k = 0; k < 8; ++k) {
        const float gt = __builtin_bit_cast(float, __builtin_amdgcn_readlane(__builtin_bit_cast(int, gk), k));
        const unsigned w4[4] = {R.c0[k].x, R.c0[k].y, R.c1[k].x, R.c1[k].y};
#pragma unroll
        for (int i = 0; i < 4; ++i) {
            const f32x2_t lo = f8lo(w4[i]), hi = f8hi(w4[i]);
            v[i][0] += gt * lo[0]; v[i][1] += gt * lo[1]; v[i][2] += gt * hi[0]; v[i][3] += gt * hi[1];
        }
    }
    float s_ = 0.f;
#pragma unroll
    for (int i = 0; i < 4; ++i) s_ += (v[i][0] + v[i][1]) + (v[i][2] + v[i][3]);
    const float mu = wave_sum(s_) * (1.f / 1024.f);
    float q = 0.f;
#pragma unroll
    for (int i = 0; i < 4; ++i) { const f32x4 d = v[i] - mu; q += (d[0] * d[0] + d[1] * d[1]) + (d[2] * d[2] + d[3] * d[3]); }
    const float rstd = rsqrtf(wave_sum(q) * (1.f / 1024.f) + 1e-5f);
    const int co[4] = {lane * 8, lane * 8 + 4, 512 + lane * 8, 516 + lane * 8};
#pragma unroll
    for (int i = 0; i < 4; ++i) {
        const f32x4 gg = *(const f32x4*)(A.g + co[i]), bb = *(const f32x4*)(A.b + co[i]);
        *(f32x4*)(A.out + (size_t)tok * 1024 + co[i]) = (v[i] - mu) * rstd * gg + bb;
    }
}
__device__ __forceinline__ void final_tokens(const FinArgs& A, const LDSP int* ab, const LDSP int* sp, int t0, int S, int lane) {
    if (t0 >= NT) return;
    int tok = t0, rk0, rk1; float g0, g1;
    fin_index(A, ab, sp, tok, lane, rk0, g0);
    FinRows R0; fin_rows(A, rk0, tok, lane, R0);
    int tok1 = tok + S, tk1 = tok1 < NT ? tok1 : tok;
    fin_index(A, ab, sp, tk1, lane, rk1, g1);
#pragma unroll 1
    for (;;) {
        FinRows R1; fin_rows(A, rk1, tk1, lane, R1);
        const int tok2 = tok1 + S, tk2 = tok2 < NT ? tok2 : tk1;
        int rk2; float g2; fin_index(A, ab, sp, tk2, lane, rk2, g2);
        fin_finish(A, R0, g0, tok, lane);
        if (tok1 >= NT) break;
        R0 = R1; g0 = g1; tok = tok1; tok1 = tok2; tk1 = tk2; rk1 = rk2; g1 = g2;
    }
}
__device__ __forceinline__ void route_tokens8(const LDSP unsigned char* ltile  , const float* rbias, float* gate, int tok0, int lane, int& e_out) {
    const float4 rb = *(const float4*)(rbias + lane * 4);
    float4 lgs[8];
#pragma unroll
    for (int t = 0; t < 8; ++t) { const f32x4 q_ = *(const LDSP f32x4*)(ltile + t * 1040 + lane * 16); lgs[t] = make_float4(q_[0], q_[1], q_[2], q_[3]); }
    int e_all = 0; float g_all = 0.f;
#pragma unroll
    for (int t = 0; t < 8; ++t) {
        const float4 lg = lgs[t];
        float sc[4], ch[4];
        sc[0] = __builtin_amdgcn_rcpf(1.f + __expf(-lg.x)); sc[1] = __builtin_amdgcn_rcpf(1.f + __expf(-lg.y)); sc[2] = __builtin_amdgcn_rcpf(1.f + __expf(-lg.z)); sc[3] = __builtin_amdgcn_rcpf(1.f + __expf(-lg.w));
        ch[0] = sc[0] + rb.x; ch[1] = sc[1] + rb.y; ch[2] = sc[2] + rb.z; ch[3] = sc[3] + rb.w;
        float t1 = -INFINITY, t2 = -INFINITY;
#pragma unroll
        for (int i = 0; i < 4; ++i) { const float v = ch[i]; if (v > t1) { t2 = t1; t1 = v; } else if (v > t2) t2 = v; }
#define RT_MERGE(ctrl) do { const float o1 = __builtin_bit_cast(float, __builtin_amdgcn_update_dpp(0, __builtin_bit_cast(int, t1), ctrl, 0xf, 0xf, false)), \
                o2 = __builtin_bit_cast(float, __builtin_amdgcn_update_dpp(0, __builtin_bit_cast(int, t2), ctrl, 0xf, 0xf, false)); \
            const float n1 = fmaxf(t1, o1), n2 = fmaxf(fminf(t1, o1), fmaxf(t2, o2)); t1 = n1; t2 = n2; } while (0)
        RT_MERGE(0xB1);
        RT_MERGE(0x4E);
        RT_MERGE(0x141);
#undef RT_MERGE
        const float gs = t1 + t2;
        const int mygrp = lane >> 3;
        int rank = 0;
#pragma unroll
        for (int g2 = 0; g2 < 8; ++g2) { const float og = __builtin_bit_cast(float, __builtin_amdgcn_readlane(__builtin_bit_cast(int, gs), g2 * 8)); if (og > gs || (og == gs && g2 < mygrp)) ++rank; }
        const bool gsel = rank < 4;
        unsigned key[4];
#pragma unroll
        for (int i = 0; i < 4; ++i) {
            unsigned u = __builtin_bit_cast(unsigned, ch[i]); u = (u & 0x80000000u) ? ~u : (u | 0x80000000u);
            key[i] = gsel ? ((u & ~0xFFu) | (unsigned)(255 - (lane * 4 + i))) : 0u;
        }
        float gsum = 0.f; float myg = 0.f; int mye = -1;
#pragma unroll 1
        for (int k = 0; k < TOPK; ++k) {
            int bk_ = (int)max(max(key[0], key[1]), max(key[2], key[3]));
            bk_ = (int)max((unsigned)bk_, (unsigned)__builtin_amdgcn_update_dpp(0, bk_, 0x111, 0xf, 0xf, false));
            bk_ = (int)max((unsigned)bk_, (unsigned)__builtin_amdgcn_update_dpp(0, bk_, 0x112, 0xf, 0xf, false));
            bk_ = (int)max((unsigned)bk_, (unsigned)__builtin_amdgcn_update_dpp(0, bk_, 0x114, 0xf, 0xf, false));
            bk_ = (int)max((unsigned)bk_, (unsigned)__builtin_amdgcn_update_dpp(0, bk_, 0x118, 0xf, 0xf, false));
            bk_ = (int)max((unsigned)bk_, (unsigned)__builtin_amdgcn_update_dpp(0, bk_, 0x142, 0xa, 0xf, false));
            bk_ = (int)max((unsigned)bk_, (unsigned)__builtin_amdgcn_update_dpp(0, bk_, 0x143, 0xc, 0xf, false));
            const unsigned bk = (unsigned)__builtin_amdgcn_readlane(bk_, 63);
            const int be = 255 - (int)(bk & 255u);
            const int ol = be >> 2, oi = be & 3;
            float sv = 0.f;
            if (lane == ol) {
#pragma unroll
                for (int i = 0; i < 4; ++i) if (i == oi) { sv = sc[i]; key[i] = 0u; }
            }
            sv = __builtin_bit_cast(float, __builtin_amdgcn_readlane(__builtin_bit_cast(int, sv), ol));
            gsum += sv;
            if (lane == k) { myg = sv; mye = be; }
        }
        const float gv = 2.5f * myg * __builtin_amdgcn_rcpf(gsum + 1e-20f);
        const int eo = __shfl(mye, lane & 7); const float go = __shfl(gv, lane & 7);
        if ((lane >> 3) == t) { e_all = eo; g_all = go; }
    }
    gate[(size_t)tok0 * TOPK + lane] = g_all;
    e_out = e_all;
}


struct Params {
    const float* x; const float* w_in; const float* att_norm_g; const float* lam_re; const float* lam_im; const float* log_step;
    const float* b_re; const float* b_im; const float* c_re; const float* c_im; const float* d_skip; const float* w_glu; const float* b_glu;
    const float* ssm_norm_g; const float* w_out; const float* ln1_g; const float* ln1_b; const float* router_w; const float* router_bias;
    const float* w_gu; const float* w_down; const float* shared_w_gu; const float* shared_w_down; const float* ln2_g; const float* ln2_b;
    float* out;
    unsigned* bar; int* cntp; int* list; int* ctab;
    bf16_t* xb; bf16_t* w_inT; float* rope; bf16_t* q; bf16_t* k; bf16_t* v; bf16_t* u;
    bf16_t* opart; float* lse; bf16_t* wendT; bf16_t* wcarT; bf16_t* klagT; float* a16; bf16_t* w_gluT; bf16_t* yss; void* rsv0; void* rsv1;
    bf16_t* w_outT; bf16_t* rsT; bf16_t* sdT; unsigned char* h1q; bf16_t* h1b; float* logits; void* rsv2; bf16_t* pre2b; float* gate; int* inv;
    unsigned char* w_gu8; unsigned char* w_dn8; unsigned char* act8; unsigned char* contrib8;
    int ph_lo, ph_hi;
};
constexpr int LDS_TS = ME_LDS;
constexpr int LDS_XB = ME_LDS + 4096 + 8192;
constexpr int LDS_TOTAL = ME_LDS + 4096 + 8192 + 64;
static_assert(pg::VA_SLOT_OFF == ME_LDS + 4096 && LDS_TOTAL <= 163840, "LDS map");
constexpr int N_PHASES = 12;

template <class RM>
__device__ __forceinline__ void transpose_range(const float* W, int K, int N, unsigned char* Wt, int t0, int t1, LDSP unsigned char* lds) {
    const int tid = threadIdx.x, lane = tid & 63, wid = __builtin_amdgcn_readfirstlane(tid >> 6);
    LDSP float* scr = (LDSP float*)(lds + wid * 18432);
    const int tn = N >> 5; const RM rm = RM();
    const int lr = lane >> 3, lc = (lane & 7) * 4;
    const int rc = lane & 7, rn = lane >> 3;
#define TR_LOAD(V, t_) do { const int k0_ = ((t_) / tn) * 128, n0_ = ((t_) % tn) * 32; const float* sp_ = W + (size_t)(k0_ + lr) * N + n0_ + lc; \
        _Pragma("unroll") for (int i = 0; i < 16; ++i) V[i] = __builtin_nontemporal_load((const f32x4*)(sp_ + (size_t)(8 * i) * N)); } while (0)
#define TR_PROC(V, t_) do { const int k0_ = ((t_) / tn) * 128, n0_ = ((t_) % tn) * 32; \
        _Pragma("unroll") for (int i = 0; i < 16; ++i) { const int k = 8 * i + lr; *(LDSP f32x4*)(scr + k * 36 + (lc ^ (4 * ((k >> 4) & 7)))) = V[i]; } \
        _Pragma("unroll") for (int j = 0; j < 4; ++j) { \
            const int n = rn + 8 * j; \
            const LDSP float* pa = scr + (16 * rc) * 36 + (n ^ (4 * rc)); \
            u32x4 w; \
            w.x = pk4f8(pa[0] * F8_SW, pa[36] * F8_SW, pa[2 * 36] * F8_SW, pa[3 * 36] * F8_SW); w.y = pk4f8(pa[4 * 36] * F8_SW, pa[5 * 36] * F8_SW, pa[6 * 36] * F8_SW, pa[7 * 36] * F8_SW); \
            w.z = pk4f8(pa[8 * 36] * F8_SW, pa[9 * 36] * F8_SW, pa[10 * 36] * F8_SW, pa[11 * 36] * F8_SW); w.w = pk4f8(pa[12 * 36] * F8_SW, pa[13 * 36] * F8_SW, pa[14 * 36] * F8_SW, pa[15 * 36] * F8_SW); \
            __builtin_nontemporal_store(w, (u32x4*)(Wt + (size_t)rm(n0_ + n) * K + k0_ + 16 * rc)); } } while (0)
    int t = t0 + wid;
    if (t >= t1) return;
    f32x4 va[16], vb[16];
    TR_LOAD(va, t);
#pragma unroll 1
    for (; t < t1; t += 16) {
        const int t2 = t + 8, t3 = t + 16;
        { const int tl = t2 < t1 ? t2 : t; TR_LOAD(vb, tl); }
        TR_PROC(va, t);
        if (t2 < t1) {
            { const int tl = t3 < t1 ? t3 : t2; TR_LOAD(va, tl); }
            TR_PROC(vb, t2);
        }
    }
#undef TR_LOAD
#undef TR_PROC
}
__device__ __forceinline__ void convert_experts(const Params& p, LDSP unsigned char* lds, int t0, int t1) {
    __syncthreads();
    for (int e = blockIdx.x; e < NE; e += gridDim.x) {
        if (t0 < 128) transpose_range<RowGU>(p.w_gu + (size_t)e * 1024 * 512, 1024, 512, p.w_gu8 + (size_t)e * 512 * 1024, t0, t1 < 128 ? t1 : 128, lds);
        if (t1 > 128) transpose_range<RowId>(p.w_down + (size_t)e * 256 * 1024, 256, 1024, p.w_dn8 + (size_t)e * 1024 * 256, (t0 > 128 ? t0 : 128) - 128, t1 - 128, lds);
    }
    __syncthreads();
}
__device__ __forceinline__ bool convert_first() { return ((blockIdx.x >> 3) & 1) == 0; }
template <class RM, bool FT>
__device__ __forceinline__ void transpose_tile_w(const float* W, int K, int N, bf16_t* Wt, int t, LDSP float* scr, int lane) {
    const int tn = N >> 6; const RM rm = RM();
    const int lr = lane >> 4, lc = (lane & 15) * 4;
    const int rc = lane & 7, rn = lane >> 3;
    const int k0 = (t / tn) * 64, n0 = (t % tn) * 64;
    const float* sp = W + (size_t)(k0 + lr) * N + n0 + lc;
    f32x4 v[16];
#pragma unroll
    for (int i = 0; i < 16; ++i) v[i] = *(const f32x4*)(sp + (size_t)(4 * i) * N);
#pragma unroll
    for (int i = 0; i < 16; ++i) { const int k = 4 * i + lr; *(LDSP f32x4*)(scr + k * 68 + (lc ^ (4 * ((k >> 3) & 7)))) = v[i]; }
#pragma unroll
    for (int j = 0; j < 8; ++j) {
        const int n = rn + 8 * j;
        const LDSP float* q = scr + (8 * rc) * 68 + (n ^ (4 * rc));
        u32x4 w;
        w.x = pk2(q[0], q[68]); w.y = pk2(q[2 * 68], q[3 * 68]); w.z = pk2(q[4 * 68], q[5 * 68]); w.w = pk2(q[6 * 68], q[7 * 68]);
        const int nn = rm(n0 + n);
        *(u32x4*)(Wt + (FT ? ft_off(nn, k0 + 8 * rc, K) : (size_t)nn * K + k0 + 8 * rc)) = w;
    }
}
__device__ __forceinline__ void phase_prologue(const Params& p, LDSP unsigned char* lds) {
    const int tid = threadIdx.x;
    {
        const int lane = tid & 63, wid = __builtin_amdgcn_readfirstlane(tid >> 6);
        LDSP float* scr = (LDSP float*)(lds + wid * 17408);
        for (int g = blockIdx.x * 8 + wid; g < 1088; g += gridDim.x * 8) {
            if (g < 512) transpose_tile_w<RowId, false>(p.w_in, 1024, 2048, p.w_inT, g, scr, lane);
            else if (g < 768) transpose_tile_w<RowId, true>(p.w_out, 1024, 1024, p.w_outT, g - 512, scr, lane);
            else if (g < 896) transpose_tile_w<RowGU64, true>(p.shared_w_gu, 1024, 512, p.rsT + (size_t)256 * 1024, g - 768, scr, lane);
            else if (g < 960) transpose_tile_w<RowId, true>(p.w_glu, 512, 512, p.w_gluT, g - 896, scr, lane);
            else if (g < 1024) transpose_tile_w<RowId, true>(p.router_w, 1024, 256, p.rsT, g - 960, scr, lane);
            else transpose_tile_w<RowId, true>(p.shared_w_down, 256, 1024, p.sdT, g - 1024, scr, lane);
        }
    }
    for (size_t i = ((size_t)blockIdx.x * 512 + tid) * 8; i < (size_t)NT * D_; i += (size_t)gridDim.x * 512 * 8) {
        const float4 v0 = *(const float4*)(p.x + i), v1 = *(const float4*)(p.x + i + 4);
        u32x4 w; w.x = pk2(v0.x, v0.y); w.y = pk2(v0.z, v0.w); w.z = pk2(v1.x, v1.y); w.w = pk2(v1.z, v1.w);
        *(u32x4*)(p.xb + i) = w;
    }
    for (int i = blockIdx.x * 512 + tid; i < 2048 * 8; i += gridDim.x * 512) {
        const int pos = i >> 3, f = i & 7;
        const float inv = __builtin_amdgcn_exp2f(-(float)f * (18.931568569324174f / 8.0f));
        const float ang = (float)pos * inv;
        p.rope[2 * i] = __cosf(ang); p.rope[2 * i + 1] = __sinf(ang);
    }
    for (int i = blockIdx.x * 512 + tid; i < NSEG * NE; i += gridDim.x * 512) p.cntp[(size_t)i * CNT_STRIDE] = 0;
    SsmTabArgs sa{p.lam_re, p.lam_im, p.log_step, p.b_re, p.b_im, p.c_re, p.c_im, p.wendT, p.wcarT, p.klagT, p.a16};
    for (int it = blockIdx.x * 512 + tid; it < SSM_TAB_ITEMS; it += gridDim.x * 512) ssm_tab_item(sa, it);
    __syncthreads();
    for (int it = blockIdx.x * 2; it < 512; it += gridDim.x * 2) ssm_klag_item(sa, it + (tid >> 8), (LDSP float*)(lds + (tid >> 8) * 16384), tid & 255);
    __syncthreads();
}
__device__ __forceinline__ void phase_proj(const Params& a, LDSP unsigned char* lds) {
    const bool cvf_ = convert_first();
    if (cvf_) convert_experts(a, lds, 0, 48);
    pg::gemm_phase<false, true, false, false>(lds, 1024, pg::sched([&](int i, pg::Unit& u) {
        int pm, pn; if (!pg::static_tile(i, 64, 8, pm, pn)) return false;
        u.A = (const char*)(a.xb + (size_t)pm * 256 * 1024); u.B = (const char*)(a.w_inT + (size_t)pn * 256 * 1024); u.x0 = pm; u.x1 = pn; u.x2 = 0; u.x3 = 0; return true;
    }, [](const pg::Unit&) { return pg::dense_va(2048); }), pg::epi_row8([&](const pg::Unit& u, int r, int c, f32x4 v0, f32x4 v1) {
        const int m = u.x0 * 256 + r, sec = u.x1 >> 1, cs = (u.x1 & 1) * 256 + c;
        const int b = m >> 11, t = m & 2047, sh = sec < 3 ? 6 : 4;
        bf16_t* dstb = sec == 0 ? a.q : (sec == 1 ? a.k : (sec == 2 ? a.v : a.u));
        if (sec == 0) { v0 = v0 * QSCALE; v1 = v1 * QSCALE; }
        if (sec < 2 && (c & 32) == 0) {
            f32x4 o0, o1;
#pragma unroll
            for (int j = 0; j < 4; ++j) { o0[j] = __shfl_xor(v0[j], 16); o1[j] = __shfl_xor(v1[j], 16); }
            if ((c & 16) == 0) {
                const float* rt = a.rope + (size_t)t * 16;
                const f32x4 c0 = *(const f32x4*)rt, c1 = *(const f32x4*)(rt + 4), c2 = *(const f32x4*)(rt + 8), c3 = *(const f32x4*)(rt + 12);
                const f32x4 cs0 = {c0[0], c0[2], c1[0], c1[2]}, cs1 = {c2[0], c2[2], c3[0], c3[2]}, sn0 = {c0[1], c0[3], c1[1], c1[3]}, sn1 = {c2[1], c2[3], c3[1], c3[3]};
                if ((c & 8) == 0) { v0 = v0 * cs0 - o0 * sn0; v1 = v1 * cs1 - o1 * sn1; }
                else { v0 = v0 * cs0 + o0 * sn0; v1 = v1 * cs1 + o1 * sn1; }
            }
        }
        const int grp = cs >> sh, within = cs & ((1 << sh) - 1);
        *(u32x4*)(dstb + ((((size_t)((b << (9 - sh)) + grp) << 11) + t) << sh) + within) = pg::pack8(v0, v1);
    }));
    if (!cvf_) convert_experts(a, lds, 0, 48);
}
__device__ __forceinline__ void phase_mixers(const Params& p, LDSP unsigned char* lds) {
    const bool cvf_ = convert_first();
    if (cvf_) convert_experts(p, lds, 48, 128);
    SsmArgs sa{p.u, p.wendT, p.wcarT, p.klagT, p.a16, p.d_skip, p.yss};
    for (int bg = blockIdx.x; bg < 256; bg += gridDim.x) ssm_unit(sa, bg, lds);
    __syncthreads();
    AttArgs aa{p.q, p.k, p.v, p.opart, p.lse};
    {
        const int tid = threadIdx.x;
        int U = blockIdx.x;
        AwPre P;
        if (U < AW_UNITS) aw_prefetch(aa, U, P, tid);
        while (U < AW_UNITS) {
            __syncthreads();
            aw_stage(P, lds, tid);
            bf16x8 qf[4];
#pragma unroll
            for (int s_ = 0; s_ < 4; ++s_) qf[s_] = P.q[s_];
            __syncthreads();
            const int Un = U + gridDim.x;
            aw_prefetch(aa, Un < AW_UNITS ? Un : U, P, tid);
            aw_compute(aa, U, qf, lds, tid);
            U = Un;
        }
        __syncthreads();
    }
    if (!cvf_) convert_experts(p, lds, 48, 128);
}
template <int NF, int NW = NF, int OFF = 0, bool INIT = true>
__device__ __forceinline__ void rb_gemm(f32x4 (&acc)[4][NW], const LDSP unsigned char* Alds, int apitch, const bf16_t* Bt, int K, int lane) {
    const int fr = lane & 15, fq = lane >> 4;
    const int nks = K >> 5;
    const char* bb = (const char*)Bt;
    unsigned bo = lane * 16;
    const unsigned nstride = (unsigned)nks * 1024u;
    const LDSP unsigned char* ap = Alds + fr * apitch + fq * 16;
    if constexpr (INIT) {
#pragma unroll
        for (int m = 0; m < 4; ++m)
#pragma unroll
            for (int ni = 0; ni < NF; ++ni) acc[m][OFF + ni] = (f32x4){0.f, 0.f, 0.f, 0.f};
    }
    bf16x8 b0[NF], b1[NF], b2[NF], b3[NF];
#define RB_LOADB(B_, step_) do { _Pragma("unroll") for (int ni = 0; ni < NF; ++ni) B_[ni] = *(const bf16x8*)(bb + (bo + (unsigned)(step_) * 1024u + ni * ns)); } while (0)
#define RB_MMA(B_, step_) do { bf16x8 af_[4]; _Pragma("unroll") for (int m = 0; m < 4; ++m) af_[m] = *(const LDSP bf16x8*)(ap + m * 16 * apitch + (step_) * 64); \
        _Pragma("unroll") for (int m = 0; m < 4; ++m) _Pragma("unroll") for (int ni = 0; ni < NF; ++ni) acc[m][OFF + ni] = __builtin_amdgcn_mfma_f32_16x16x32_bf16(B_[ni], af_[m], acc[m][OFF + ni], 0, 0, 0); } while (0)
    { unsigned ns = nstride; asm volatile("" : "+s"(ns), "+v"(bo)); RB_LOADB(b0, 0); RB_LOADB(b1, 1); RB_LOADB(b2, 2); }
#pragma unroll 1
    for (int ks = 0; ks < nks; ks += 4) {
        unsigned ns = nstride; asm volatile("" : "+s"(ns));
        RB_LOADB(b3, 3);
        RB_MMA(b0, 0);
        if (ks + 4 < nks) RB_LOADB(b0, 4);
        RB_MMA(b1, 1);
        if (ks + 4 < nks) RB_LOADB(b1, 5);
        RB_MMA(b2, 2);
        if (ks + 4 < nks) RB_LOADB(b2, 6);
        RB_MMA(b3, 3);
        bo += 4096u; ap += 256;
    }
#undef RB_LOADB
#undef RB_MMA
}
__device__ __forceinline__ void rb_stage_rows(LDSP unsigned char* dst, int lpitch, const bf16_t* src, size_t gpitch, int ncols) {
    const int cpr = ncols >> 3;
    int tid0 = threadIdx.x; asm volatile("" : "+v"(tid0));
    for (int id = tid0; id < 64 * cpr; id += 512) { const int r = id / cpr, c = id - r * cpr; *(LDSP u32x4*)(dst + r * lpitch + c * 16) = __builtin_nontemporal_load((const u32x4*)(src + (size_t)r * gpitch + c * 8)); }
}
constexpr int RB_LOGIT_OFF = 34816;
constexpr int RB_HIST_OFF = 139264;
constexpr int RB_STAT_OFF = 64 * 2064;
__device__ __forceinline__ void phase_wout_ln(const Params& a, LDSP unsigned char* lds) {
    const bool cvf_ = convert_first();
    if (cvf_) convert_experts(a, lds, 128, 192);
    int lane = threadIdx.x & 63; const int w = __builtin_amdgcn_readfirstlane(threadIdx.x >> 6); int fr = lane & 15, fq = lane >> 4;
#define RB_FRESH() do { __builtin_amdgcn_sched_barrier(0); asm volatile("" : "+s"(m0), "+v"(fr), "+v"(fq), "+v"(lane)); } while (0)
    for (int tile = blockIdx.x; tile < NT / 64; tile += gridDim.x) {
        int m0 = tile * 64;
        asm volatile("" : "+s"(m0));
        __syncthreads();
#pragma unroll 1
        for (int tb = 0; tb < 8; tb += 4) {
            int ln = lane; asm volatile("" : "+v"(ln));
            const int h = ln >> 3;
            float ls[4][3]; u32x4 pv[4][3];
#pragma unroll
            for (int t = 0; t < 4; ++t) {
                const int tok = m0 + 8 * w + tb + t;
#pragma unroll
                for (int c = 0; c < 3; ++c) { ls[t][c] = a.lse[((size_t)c * NT + tok) * 8 + h]; pv[t][c] = __builtin_nontemporal_load((const u32x4*)(a.opart + ((size_t)c * NT + tok) * 512 + ln * 8)); }
            }
            const f32x4 ga0 = *(const f32x4*)(a.att_norm_g + ln * 8), ga1 = *(const f32x4*)(a.att_norm_g + ln * 8 + 4);
#pragma unroll
            for (int t = 0; t < 4; ++t) {
                const int row = 8 * w + tb + t;
                const float mx = fmaxf(ls[t][0], fmaxf(ls[t][1], ls[t][2]));
                float wg[3], ws = 0.f;
#pragma unroll
                for (int c = 0; c < 3; ++c) { wg[c] = __builtin_amdgcn_exp2f(ls[t][c] - mx); ws += wg[c]; }
                const float iw = __builtin_amdgcn_rcpf(ws);
                float o[8];
#pragma unroll
                for (int i = 0; i < 8; ++i) o[i] = 0.f;
#pragma unroll
                for (int c = 0; c < 3; ++c) {
                    const u32x4 v = pv[t][c]; const float wc = wg[c] * iw;
                    o[0] += wc * bf2f(v.x & 0xffff); o[1] += wc * bf2f(v.x >> 16); o[2] += wc * bf2f(v.y & 0xffff); o[3] += wc * bf2f(v.y >> 16);
                    o[4] += wc * bf2f(v.z & 0xffff); o[5] += wc * bf2f(v.z >> 16); o[6] += wc * bf2f(v.w & 0xffff); o[7] += wc * bf2f(v.w >> 16);
                }
                float sa = 0.f;
#pragma unroll
                for (int i = 0; i < 8; ++i) sa += o[i] * o[i];
                sa = wave_sum(sa);
                const float ra = rsqrtf(sa * (1.f / 512.f) + 1e-6f);
                u32x4 wa;
                wa.x = pk2(o[0] * ra * ga0[0], o[1] * ra * ga0[1]); wa.y = pk2(o[2] * ra * ga0[2], o[3] * ra * ga0[3]);
                wa.z = pk2(o[4] * ra * ga1[0], o[5] * ra * ga1[1]); wa.w = pk2(o[6] * ra * ga1[2], o[7] * ra * ga1[3]);
                *(LDSP u32x4*)(lds + row * 2064 + ln * 16) = wa;
            }
        }
        rb_stage_rows(lds + 1024, 2064, a.yss + (size_t)m0 * 512, 512, 512);
        __syncthreads();
        {
            f32x4 ga[4][4];
            rb_gemm<4>(ga, lds + 1024, 2064, a.w_gluT + (size_t)(64 * w) * 512, 512, lane);
            LDSP float* st = (LDSP float*)(lds + RB_STAT_OFF);
            RB_FRESH();
#pragma unroll
            for (int m = 0; m < 4; ++m) {
                float s2 = 0.f;
#pragma unroll
                for (int ni = 0; ni < 4; ++ni) {
                    const int col = 64 * w + 16 * ni + 4 * fq;
                    const u32x2 yw = *(const LDSP u32x2*)(lds + (16 * m + fr) * 2064 + 1024 + col * 2);
                    const f32x4 bb = *(const f32x4*)(a.b_glu + col);
                    f32x4 v = ga[m][ni];
                    v[0] = bf2f(yw.x & 0xffff) * __builtin_amdgcn_rcpf(1.f + __expf(-(v[0] + bb[0]))); v[1] = bf2f(yw.x >> 16) * __builtin_amdgcn_rcpf(1.f + __expf(-(v[1] + bb[1])));
                    v[2] = bf2f(yw.y & 0xffff) * __builtin_amdgcn_rcpf(1.f + __expf(-(v[2] + bb[2]))); v[3] = bf2f(yw.y >> 16) * __builtin_amdgcn_rcpf(1.f + __expf(-(v[3] + bb[3])));
                    ga[m][ni] = v; s2 += (v[0] * v[0] + v[1] * v[1]) + (v[2] * v[2] + v[3] * v[3]);
                }
                s2 += __shfl_xor(s2, 16); s2 += __shfl_xor(s2, 32);
                if (fq == 0) st[w * 64 + 16 * m + fr] = s2;
            }
            __syncthreads();
            RB_FRESH();
#pragma unroll
            for (int m = 0; m < 4; ++m) {
                float s2 = 0.f;
#pragma unroll
                for (int v = 0; v < 8; ++v) s2 += st[v * 64 + 16 * m + fr];
                const float rs = rsqrtf(s2 * (1.f / 512.f) + 1e-6f);
#pragma unroll
                for (int ni = 0; ni < 4; ++ni) {
                    const int col = 64 * w + 16 * ni + 4 * fq;
                    const f32x4 gs = *(const f32x4*)(a.ssm_norm_g + col);
                    const f32x4 v = ga[m][ni] * rs * gs;
                    u32x2 o2; o2.x = pk2(v[0], v[1]); o2.y = pk2(v[2], v[3]);
                    *(LDSP u32x2*)(lds + (16 * m + fr) * 2064 + 1024 + col * 2) = o2;
                }
            }
        }
        __syncthreads();
        f32x4 acc[4][8];
        const int n0 = 128 * w;
        rb_gemm<4, 8, 0>(acc, lds, 2064, a.w_outT + (size_t)n0 * 1024, 1024, lane);
        rb_gemm<4, 8, 4>(acc, lds, 2064, a.w_outT + (size_t)(n0 + 64) * 1024, 1024, lane);
        RB_FRESH();
        LDSP float* st = (LDSP float*)(lds + RB_STAT_OFF);
#pragma unroll
        for (int m = 0; m < 4; ++m) {
            const float* xr = a.x + (size_t)(m0 + 16 * m + fr) * 1024 + n0 + 4 * fq;
            float s1 = 0.f, s2 = 0.f;
#pragma unroll
            for (int ni = 0; ni < 8; ++ni) {
                const f32x4 xv = __builtin_nontemporal_load((const f32x4*)(xr + 16 * ni));
                const f32x4 v = xv * ALPHA + acc[m][ni]; acc[m][ni] = v;
                s1 += (v[0] + v[1]) + (v[2] + v[3]); s2 += (v[0] * v[0] + v[1] * v[1]) + (v[2] * v[2] + v[3] * v[3]);
            }
            s1 += __shfl_xor(s1, 16); s1 += __shfl_xor(s1, 32); s2 += __shfl_xor(s2, 16); s2 += __shfl_xor(s2, 32);
            if (fq == 0) { st[(w * 64 + 16 * m + fr) * 2] = s1; st[(w * 64 + 16 * m + fr) * 2 + 1] = s2; }
        }
        __syncthreads();
        RB_FRESH();
#pragma unroll
        for (int m = 0; m < 4; ++m) {
            float s1 = 0.f, s2 = 0.f;
#pragma unroll
            for (int v = 0; v < 8; ++v) { s1 += st[(v * 64 + 16 * m + fr) * 2]; s2 += st[(v * 64 + 16 * m + fr) * 2 + 1]; }
            const float mu = s1 * (1.f / 1024.f), var = s2 * (1.f / 1024.f) - mu * mu, rstd = rsqrtf(var + 1e-5f);
            LDSP unsigned char* hl = lds + (16 * m + fr) * 2064 + (n0 + 4 * fq) * 2;
#pragma unroll
            for (int ni = 0; ni < 8; ++ni) {
                const f32x4 gg = *(const f32x4*)(a.ln1_g + n0 + 16 * ni + 4 * fq), bb = *(const f32x4*)(a.ln1_b + n0 + 16 * ni + 4 * fq);
                const f32x4 y = (acc[m][ni] - mu) * rstd * gg + bb;
                u32x2 o; o.x = pk2(y[0], y[1]); o.y = pk2(y[2], y[3]);
                *(LDSP u32x2*)(hl + 32 * ni) = o;
            }
        }
        __syncthreads();
        RB_FRESH();
        f32x4 rl[4][2];
        rb_gemm<2>(rl, lds, 2064, a.rsT + (size_t)(32 * w) * 1024, 1024, lane);
        RB_FRESH();
        u32x2 actv[4][2];
        {
            f32x4 gu[4][4];
            rb_gemm<4>(gu, lds, 2064, a.rsT + (size_t)(256 + 64 * w) * 1024, 1024, lane);
#pragma unroll
            for (int m = 0; m < 4; ++m)
#pragma unroll
                for (int ni = 0; ni < 2; ++ni) {
                    const f32x4 g = gu[m][ni], up = gu[m][ni + 2];
                    actv[m][ni].x = pk2(silu_f(g[0]) * up[0], silu_f(g[1]) * up[1]); actv[m][ni].y = pk2(silu_f(g[2]) * up[2], silu_f(g[3]) * up[3]);
                }
        }
#pragma unroll
        for (int m = 0; m < 4; ++m) {
            const LDSP unsigned char* hl2 = lds + (16 * m + fr) * 2064 + (n0 + 4 * fq) * 2;
#pragma unroll
            for (int ni = 0; ni < 8; ++ni) {
                const u32x2 hw = *(const LDSP u32x2*)(hl2 + 32 * ni);
                acc[m][ni] = (f32x4){bf2f(hw.x & 0xffff), bf2f(hw.x >> 16), bf2f(hw.y & 0xffff), bf2f(hw.y >> 16)} * ALPHA;
            }
        }
        {
            int tid0 = threadIdx.x; asm volatile("" : "+v"(tid0));
#pragma unroll 2
            for (int id = tid0; id < 64 * 64; id += 512) {
                const int r = id >> 6, c = id & 63;
                const u32x4 ha = *(const LDSP u32x4*)(lds + r * 2064 + c * 32), hb = *(const LDSP u32x4*)(lds + r * 2064 + c * 32 + 16);
                u32x4 q8;
                q8.x = pk4f8(bf2f(ha.x & 0xffff) * F8_SH, bf2f(ha.x >> 16) * F8_SH, bf2f(ha.y & 0xffff) * F8_SH, bf2f(ha.y >> 16) * F8_SH);
                q8.y = pk4f8(bf2f(ha.z & 0xffff) * F8_SH, bf2f(ha.z >> 16) * F8_SH, bf2f(ha.w & 0xffff) * F8_SH, bf2f(ha.w >> 16) * F8_SH);
                q8.z = pk4f8(bf2f(hb.x & 0xffff) * F8_SH, bf2f(hb.x >> 16) * F8_SH, bf2f(hb.y & 0xffff) * F8_SH, bf2f(hb.y >> 16) * F8_SH);
                q8.w = pk4f8(bf2f(hb.z & 0xffff) * F8_SH, bf2f(hb.z >> 16) * F8_SH, bf2f(hb.w & 0xffff) * F8_SH, bf2f(hb.w >> 16) * F8_SH);
                *(u32x4*)(a.h1q + (size_t)(m0 + r) * 1024 + c * 16) = q8;
            }
        }
        if (threadIdx.x < 256) ((LDSP int*)(lds + RB_HIST_OFF))[threadIdx.x] = 0;
        __syncthreads();
#pragma unroll
        for (int m = 0; m < 4; ++m)
#pragma unroll
            for (int ni = 0; ni < 2; ++ni) *(LDSP u32x2*)(lds + (16 * m + fr) * 528 + (32 * w + 16 * ni + 4 * fq) * 2) = actv[m][ni];
#pragma unroll
        for (int m = 0; m < 4; ++m)
#pragma unroll
            for (int ni = 0; ni < 2; ++ni) *(LDSP f32x4*)(lds + RB_LOGIT_OFF + (16 * m + fr) * 1040 + (32 * w + 16 * ni + 4 * fq) * 4) = rl[m][ni];
        __syncthreads();
        RB_FRESH();
        {
            int e_my; route_tokens8(lds + RB_LOGIT_OFF + (8 * w) * 1040, a.router_bias, a.gate, m0 + 8 * w, lane, e_my);
            LDSP int* hist = (LDSP int*)(lds + RB_HIST_OFF); LDSP int* hbase = hist + 256;
            const int lpos = __hip_atomic_fetch_add(hist + e_my, 1, __ATOMIC_RELAXED, __HIP_MEMORY_SCOPE_WORKGROUP);
            __syncthreads();
            const int seg = blockIdx.x & (NSEG - 1);
            if (threadIdx.x < 256) { const int c = hist[threadIdx.x]; if (c > 0) hbase[threadIdx.x] = atomicAdd(&a.cntp[(size_t)(seg * 256 + threadIdx.x) * CNT_STRIDE], c); }
            __syncthreads();
            const int pos = hbase[e_my] + lpos, slot = (m0 + 8 * w) * TOPK + lane;
            a.list[(size_t)(e_my * NSEG + seg) * SEGCAP + pos] = slot;
            a.inv[slot] = (e_my << 16) | (seg << 11) | pos;
        }
        RB_FRESH();
        {
            rb_gemm<4, 8, 0, false>(acc, lds, 528, a.sdT + (size_t)n0 * 256, 256, lane);
            rb_gemm<4, 8, 4, false>(acc, lds, 528, a.sdT + (size_t)(n0 + 64) * 256, 256, lane);
            __syncthreads();
            RB_FRESH();
#pragma unroll
            for (int m = 0; m < 4; ++m) {
                const size_t ro = (size_t)(m0 + 16 * m + fr) * 1024 + n0 + 4 * fq;
                LDSP unsigned char* pl = lds + (16 * m + fr) * 2064 + (n0 + 4 * fq) * 2;
#pragma unroll
                for (int ni = 0; ni < 8; ++ni) {
                    const f32x4 y = acc[m][ni];
                    u32x2 o; o.x = pk2(y[0], y[1]); o.y = pk2(y[2], y[3]);
                    *(LDSP u32x2*)(pl + 32 * ni) = o;
                }
            }
            __syncthreads();
            {
                int tid0 = threadIdx.x; asm volatile("" : "+v"(tid0));
#pragma unroll 4
                for (int id = tid0; id < 64 * 128; id += 512) { const int r = id >> 7, c = id & 127; __builtin_nontemporal_store(*(const LDSP u32x4*)(lds + r * 2064 + c * 16), (u32x4*)(a.pre2b + (size_t)(m0 + r) * 1024 + c * 8)); }
            }
        }
    }
    if (!cvf_) convert_experts(a, lds, 128, 192);
#undef RB_FRESH
}
template <bool RAGGED, class RowPtr>
__device__ __forceinline__ void swiglu_epi_pg(const f32x4 (&acc)[2][2][4][2], int wr, int wc, int fr, int fq, int nvalid, const RowPtr& rowp) {
    constexpr float us = 1.f / (F8_SH * F8_SW);
    asm volatile("" : "+v"(fr));
#pragma unroll
    for (int ai = 0; ai < 2; ++ai)
#pragma unroll
        for (int m = 0; m < 4; ++m) {
            const int r = RAGGED ? 16 * (2 * (4 * ai + m) + wr) + fr : 128 * ai + 64 * wr + 16 * m + fr;
            if (r < nvalid) {
                f32x4 o0, o1;
#pragma unroll
                for (int j = 0; j < 4; ++j) { o0[j] = silu_f(acc[ai][0][m][0][j] * us) * (acc[ai][1][m][0][j] * (us * F8_SA)); o1[j] = silu_f(acc[ai][0][m][1][j] * us) * (acc[ai][1][m][1][j] * (us * F8_SA)); }
                u32x2 w; w.x = pk4f8(o0[0], o0[1], o0[2], o0[3]); w.y = pk4f8(o1[0], o1[1], o1[2], o1[3]);
                *(u32x2*)(rowp(r) + 32 * wc + 8 * fq) = w;
            }
        }
}
__device__ __forceinline__ void phase_moe_up(const Params& a, LDSP unsigned char* lds) {
    LDSP int* ts = (LDSP int*)(lds + LDS_TS); LDSP int* ud = (LDSP int*)(lds + LDS_TS + MOE_UD_OFF);
    moe_tile_table<false>(a.cntp, a.ctab, lds, ts, threadIdx.x);
    int first, last, step; unit_range(2 * ts[256], first, last, step);
    const int nun = moe_build_units(ts, (const LDSP int*)(lds + LDS_CT), first, last, step, 2, ud, threadIdx.x);
    pg::gemm_phase<true, true, true, true>(lds, 512  , pg::sched([&](int i, pg::Unit& u) {
        if (i >= nun) return false;
        const LDSP int* d = ud + i * 5; const int e = d[0], pn = d[1];
        u.A = (const char*)a.h1q; u.B = (const char*)(a.w_gu8 + ((size_t)e * 512 + pn * 256) * 1024);
        u.x0 = pn; u.x1 = d[3]; u.x2 = d[4]; u.x3 = (e << 16) | d[2]; return true;
    }, [&](const pg::Unit& u) {
        const pg::LaneRC l = pg::lane_rc_fresh(); const int e = u.x3 >> 16, row0 = u.x3 & 0xffff, nvalid = u.x1; pg::VA v;
        const int r00 = pg::ragged_row(0, l.R0), r01 = pg::ragged_row(0, l.R1), r10 = pg::ragged_row(1, l.R0), r11 = pg::ragged_row(1, l.R1);
        const LDSP int* spe = (const LDSP int*)(lds + LDS_SP) + e * NSEG;
        const i32x4_t sa = *(const LDSP i32x4_t*)spe, sb = *(const LDSP i32x4_t*)(spe + 4);
        const int* lste = a.list + (size_t)e * NSEG * SEGCAP;
        auto tok_of = [&](int r) -> unsigned {
            if (r >= nvalid) return 0u;
            const int rr = row0 + r;
            int sg = 0, base = 0;
            if (rr >= sa[1]) { sg = 1; base = sa[1]; } if (rr >= sa[2]) { sg = 2; base = sa[2]; } if (rr >= sa[3]) { sg = 3; base = sa[3]; }
            if (rr >= sb[0]) { sg = 4; base = sb[0]; } if (rr >= sb[1]) { sg = 5; base = sb[1]; } if (rr >= sb[2]) { sg = 6; base = sb[2]; } if (rr >= sb[3]) { sg = 7; base = sb[3]; }
            return (unsigned)(lste[sg * SEGCAP + (rr - base)] >> 3);
        };
        v.v00 = tok_of(r00) * 1024u + l.C0 * 2; v.v01 = tok_of(r01) * 1024u + l.C1 * 2;
        v.v10 = tok_of(r10) * 1024u + l.C0 * 2; v.v11 = tok_of(r11) * 1024u + l.C1 * 2;
        return v;
    }), [&](const f32x4 (&acc)[2][2][4][2], const pg::Unit& u, int wr, int wc, int fr, int fq) {
        unsigned char* base = a.act8 + (size_t)u.x2 * 256 + 128 * u.x0;
        swiglu_epi_pg<true>(acc, wr, wc, fr, fq, u.x1, [&](int r) { return base + (size_t)r * 256; });
    });
}
__device__ __forceinline__ void phase_moe_down(const Params& a, LDSP unsigned char* lds) {
    LDSP int* ts = (LDSP int*)(lds + LDS_TS); LDSP int* ud = (LDSP int*)(lds + LDS_TS + MOE_UD_OFF);
    if (a.ph_lo > 9) moe_tile_table<true>(a.cntp, a.ctab, lds, ts, threadIdx.x);
    else __syncthreads();
    int first, last, step; unit_range(4 * ts[256], first, last, step);
    const int nun = moe_build_units(ts, (const LDSP int*)(lds + LDS_CT), first, last, step, 4, ud, threadIdx.x);
    pg::gemm_phase<false, 2, true, true>(lds, 128  , pg::sched([&](int i, pg::Unit& u) {
        if (i >= nun) return false;
        const LDSP int* d = ud + i * 5; const int e = d[0], pn = d[1];
        u.A = (const char*)(a.act8 + (size_t)d[4] * 256); u.B = (const char*)(a.w_dn8 + ((size_t)e * 1024 + pn * 256) * 256);
        u.x0 = pn; u.x1 = d[3]; u.x2 = d[4]; u.x3 = 0; return true;
    }, [](const pg::Unit&) { const pg::LaneRC l = pg::lane_rc(); pg::VA v;
        v.v00 = pg::ragged_row(0, l.R0) * 256 + l.C0 * 2; v.v01 = pg::ragged_row(0, l.R1) * 256 + l.C1 * 2; v.v10 = pg::ragged_row(1, l.R0) * 256 + l.C0 * 2; v.v11 = pg::ragged_row(1, l.R1) * 256 + l.C1 * 2; return v;
    }), [&](const f32x4 (&acc)[2][2][4][2], const pg::Unit& u, int wr, int wc, int fr, int fq) {
        constexpr float cs = F8_SC / (F8_SA * F8_SW);
        asm volatile("" : "+v"(fr), "+v"(fq));
        const int nvalid = u.x1; unsigned char* base = a.contrib8 + (size_t)u.x2 * 1024 + u.x0 * 256 + 64 * wc + 16 * fq;
#pragma unroll
        for (int ai = 0; ai < 2; ++ai)
#pragma unroll
            for (int m = 0; m < 4; ++m) {
                const int r = 16 * (2 * (4 * ai + m) + wr) + fr;
                if (r < nvalid) {
                    const f32x4 c0 = acc[ai][0][m][0] * cs, c1 = acc[ai][0][m][1] * cs, c2 = acc[ai][1][m][0] * cs, c3 = acc[ai][1][m][1] * cs;
                    u32x4 w; w.x = pk4f8(c0[0], c0[1], c0[2], c0[3]); w.y = pk4f8(c1[0], c1[1], c1[2], c1[3]); w.z = pk4f8(c2[0], c2[1], c2[2], c2[3]); w.w = pk4f8(c3[0], c3[1], c3[2], c3[3]);
                    *(u32x4*)(base + (size_t)r * 1024) = w;
                }
            }
    });
}
__device__ __forceinline__ void phase_final(const Params& p, LDSP unsigned char* lds) {
    LDSP int* ts = (LDSP int*)(lds + LDS_TS);
    if (p.ph_lo > 9) moe_tile_table<true>(p.cntp, p.ctab, lds, ts, threadIdx.x);
    else __syncthreads();
    FinArgs fa{p.pre2b, p.contrib8, p.gate, p.inv, p.ln2_g, p.ln2_b, p.out};
    const int lane = threadIdx.x & 63, wid = threadIdx.x >> 6;
    final_tokens(fa, ts + 260, (const LDSP int*)(lds + LDS_SP), blockIdx.x * 8 + wid, gridDim.x * 8, lane);
}

__global__ void __launch_bounds__(512, 2) k_mega(Params p) {
    extern __shared__ __attribute__((aligned(16))) unsigned char smem[];
    LDSP unsigned char* lds = (LDSP unsigned char*)smem;
    if (threadIdx.x == 0) *(LDSP u32x4*)(lds + LDS_XB) = (u32x4){0u, 0u, 0u, 0u};
    __syncthreads();
    XcdBarrier bar = xcd_barrier_post(p.bar, (volatile LAS unsigned*)(lds + LDS_XB));
#define PHASE(i, body) if (p.ph_lo <= (i) && (i) < p.ph_hi) { body; if ((i) + 1 < p.ph_hi) xcd_barrier(bar); }
    PHASE(0, phase_prologue(p, lds))
    PHASE(1, phase_proj(p, lds))
    PHASE(2, phase_mixers(p, lds))
    PHASE(5, phase_wout_ln(p, lds))
    PHASE(9, phase_moe_up(p, lds))
    PHASE(10, phase_moe_down(p, lds))
    PHASE(11, phase_final(p, lds))
#undef PHASE
}
}

#ifndef MK_PER_PHASE
#define MK_PER_PHASE 0
#endif
extern "C" void kernel_launch(void* const* d_in, const int* in_sizes, int n_in, void* d_out, int out_size, void* d_ws, size_t ws_size, hipStream_t stream) {
    static int grid = 0;
    if (!grid) {
        int dev = 0, cus = 0;
        if (hipGetDevice(&dev) != hipSuccess || hipDeviceGetAttribute(&cus, hipDeviceAttributeMultiprocessorCount, dev) != hipSuccess || cus < 1) return;
        if (hipFuncSetAttribute((const void*)k_mega, hipFuncAttributeMaxDynamicSharedMemorySize, LDS_TOTAL) != hipSuccess) return;
        grid = cus;
    }
    Params p{};
    const float** inp = (const float**)&p.x;
    for (int i = 0; i < 25; ++i) inp[i] = (const float*)d_in[i];
    p.out = (float*)d_out;
    char* ws = (char*)d_ws; size_t off = 0;
    auto take = [&](size_t bytes) { char* q = ws + off; off += (bytes + 255) & ~(size_t)255; return q; };
    p.bar = (unsigned*)take(XCD_BAR_WORDS * 4);
    const size_t ctl_bytes = off;
    p.cntp = (int*)take((size_t)NSEG * NE * CNT_STRIDE * 4);
    p.list = (int*)take((size_t)NE * NSEG * SEGCAP * 4); p.ctab = (int*)take((size_t)NE * NSEG * 4);
    p.xb = (bf16_t*)take((size_t)NT * 1024 * 2); p.w_inT = (bf16_t*)take((size_t)2048 * 1024 * 2); p.rope = (float*)take(2048 * 8 * 2 * 4);
    p.q = (bf16_t*)take((size_t)NT * 512 * 2); p.k = (bf16_t*)take((size_t)NT * 512 * 2); p.v = (bf16_t*)take((size_t)NT * 512 * 2); p.u = (bf16_t*)take((size_t)NT * 512 * 2);
    p.opart = (bf16_t*)take((size_t)3 * NT * 512 * 2); p.lse = (float*)take((size_t)3 * NT * 8 * 4);
    p.wendT = (bf16_t*)take((size_t)32 * 128 * 256 * 2); p.wcarT = (bf16_t*)take((size_t)32 * 256 * 128 * 2); p.klagT = (bf16_t*)take((size_t)32 * 16 * 256 * 2); p.a16 = (float*)take((size_t)32 * 64 * 2 * 4);
    p.w_gluT = (bf16_t*)take((size_t)512 * 512 * 2); p.yss = (bf16_t*)take((size_t)NT * 512 * 2);
    p.w_outT = (bf16_t*)take((size_t)1024 * 1024 * 2); p.rsT = (bf16_t*)take((size_t)768 * 1024 * 2); p.sdT = (bf16_t*)take((size_t)1024 * 256 * 2);
    p.h1b = (bf16_t*)take((size_t)NT * 1024 * 2); p.logits = (float*)take((size_t)NT * 256 * 4);
    p.pre2b = (bf16_t*)take((size_t)NT * 1024 * 2); p.h1q = (unsigned char*)take((size_t)NT * 1024); p.gate = (float*)take((size_t)NT * 8 * 4); p.inv = (int*)take((size_t)NT * 8 * 4);
    p.w_gu8 = (unsigned char*)take((size_t)256 * 512 * 1024); p.w_dn8 = (unsigned char*)take((size_t)256 * 1024 * 256);
    p.act8 = (unsigned char*)take((size_t)(NT * 8 + 256 * 16 + 512) * 256); p.contrib8 = (unsigned char*)take((size_t)(NT * 8 + 256 * 16 + 512) * 1024);
    if (off > ws_size) return;
    (void)hipMemsetAsync(ws, 0, ctl_bytes, stream);
#if MK_PER_PHASE
    for (int i = 0; i < N_PHASES; ++i) { p.ph_lo = i; p.ph_hi = i + 1; hipLaunchKernelGGL(k_mega, dim3(grid), dim3(512), LDS_TOTAL, stream, p); }
#else
    p.ph_lo = 0; p.ph_hi = N_PHASES;
    hipLaunchKernelGGL(k_mega, dim3(grid), dim3(512), LDS_TOTAL, stream, p);
#ifdef PROBE_PHASE
    (void)hipMemsetAsync(ws, 0, XCD_BAR_WORDS * 4, stream);
    p.ph_lo = PROBE_PHASE; p.ph_hi = PROBE_PHASE + 1;
    hipLaunchKernelGGL(k_mega, dim3(grid), dim3(512), LDS_TOTAL, stream, p);
#endif
#endif
}
```
